# Optimizing an MI355X kernel written in HIP

```python
import math
import jax
import jax.numpy as jnp
from jax import lax
import numpy as np

D_MODEL = 2048
BATCH = 4
SEQ = 2048
DEPTH = 2
DEC_BATCH = 8
DEC_SEQ = 4
PAST_LEN = 16384
PAGE_SIZE = 128

SSM_WIDTH = D_MODEL // 2
ATTN_WIDTH = D_MODEL - SSM_WIDTH
SSM_CH = 16
SSM_GROUPS = SSM_WIDTH // SSM_CH
SSM_STATE = 64
DT_MIN = 1e-3
DT_MAX = 1e-1
HEAD_DIM = 128
N_HEADS = ATTN_WIDTH // HEAD_DIM
N_KV_HEADS = 2
GQA = N_HEADS // N_KV_HEADS
KV_WIDTH = N_KV_HEADS * HEAD_DIM
N_BRANCH = 3
CMP_LEN = 32
CMP_STRIDE = 16
CMP_HIDDEN = HEAD_DIM
SEL_LEN = 64
N_SEL = 16
WINDOW = 512
WIN_QBLK = 128
SEL_QBLK = 64
FORCED_SCORE = 1e4
D_FF = -(-8 * D_MODEL // (3 * 256)) * 256
NORM_EPS = 1e-6
IN_SPLITS = (SSM_WIDTH,) + tuple(SSM_WIDTH + ATTN_WIDTH + i * KV_WIDTH for i in range(7))
IN_WIDTH = SSM_WIDTH + ATTN_WIDTH + 6 * KV_WIDTH + N_HEADS * N_BRANCH

kernel_name = 'hymba_s5_nsa_decode_step'


def rmsnorm(x, g):
    xf = x.astype(jnp.float32)
    y = xf * lax.rsqrt(jnp.mean(xf * xf, axis=-1, keepdims=True) + NORM_EPS)
    return (y * g.astype(jnp.float32)).astype(x.dtype)


def alibi_slopes():
    h = jnp.arange(1, N_HEADS + 1, dtype=jnp.float32)
    return (2.0 ** (-8.0 * h / N_HEADS)).reshape(N_KV_HEADS, GQA)


def masked_softmax(s, valid):
    s = jnp.where(valid, s.astype(jnp.float32), -jnp.inf)
    m = jnp.max(s, axis=-1, keepdims=True)
    m = jnp.where(jnp.isfinite(m), m, 0.0)
    e = jnp.exp(s - m)
    den = jnp.sum(e, axis=-1, keepdims=True)
    return e / jnp.maximum(den, jnp.finfo(jnp.float32).tiny)


def dense_gqa(q, k, v, dist, valid):
    s = jnp.einsum('...tkgd,...skd->...kgts', q, k).astype(jnp.float32) * HEAD_DIM ** -0.5
    s = s - alibi_slopes()[:, :, None, None] * dist[..., None, None, :, :]
    p = masked_softmax(s, valid[..., None, None, :, :])
    o = jnp.einsum('...kgts,...skd->...tkgd', p.astype(v.dtype), v)
    return o, p


def _linear_combine(e1, e2):
    a1, b1 = e1
    a2, b2 = e2
    return a2 * a1, a2 * b1 + b2


def s5_mixer(u, h0, p):
    bsz, t_len, _ = u.shape
    uf = u.astype(jnp.float32).reshape(bsz, t_len, SSM_GROUPS, SSM_CH)
    lam = lax.complex(p['ssm_a_re'].astype(jnp.float32), p['ssm_a_im'].astype(jnp.float32))
    dt = jnp.exp(p['ssm_log_dt'].astype(jnp.float32))[:, None]
    lam_bar = jnp.exp(lam * dt)
    b = lax.complex(p['ssm_b_re'].astype(jnp.float32), p['ssm_b_im'].astype(jnp.float32))
    b_bar = ((lam_bar - 1.0) / lam)[..., None] * b
    bu = lax.complex(jnp.einsum('btgp,gnp->btgn', uf, b_bar.real),
                     jnp.einsum('btgp,gnp->btgn', uf, b_bar.imag))
    a = jnp.broadcast_to(lam_bar, bu.shape)
    a_cum, h = lax.associative_scan(_linear_combine, (a, bu), axis=1)
    h = h + a_cum * lax.complex(h0[..., 0].astype(jnp.float32), h0[..., 1].astype(jnp.float32))[:, None]
    y = (jnp.einsum('gpn,btgn->btgp', p['ssm_c_re'].astype(jnp.float32), h.real)
         - jnp.einsum('gpn,btgn->btgp', p['ssm_c_im'].astype(jnp.float32), h.imag))
    y = (y + p['ssm_d'].astype(jnp.float32) * uf).reshape(bsz, t_len, SSM_WIDTH)
    z = jax.nn.gelu(y)
    z = z * jax.nn.sigmoid(z @ p['ssm_w_glu'].astype(jnp.float32))
    h_last = jnp.stack([h[:, -1].real, h[:, -1].imag], axis=-1)
    return z.astype(u.dtype), h_last.astype(h0.dtype)


def project(xn, p):
    bsz, t_len, _ = xn.shape
    u, q, kc, vc, ks, vs, kw, vw, g = jnp.split(xn @ p['w_in'], IN_SPLITS, axis=-1)
    q = rmsnorm(q.reshape(bsz, t_len, N_KV_HEADS, GQA, HEAD_DIM), p['q_norm'])

    def heads(t):
        return t.reshape(bsz, t_len, N_KV_HEADS, HEAD_DIM)

    kv_cmp = jnp.stack([heads(kc), heads(vc)], axis=3)
    kv_slc = jnp.stack([rmsnorm(heads(ks), p['k_norm_slc']), heads(vs)], axis=3)
    kv_win = jnp.stack([rmsnorm(heads(kw), p['k_norm_win']), heads(vw)], axis=3)
    gates = jax.nn.sigmoid(g.astype(jnp.float32)).reshape(bsz, t_len, N_KV_HEADS, GQA, N_BRANCH)
    return u, q, kv_cmp, kv_slc, kv_win, gates


def compress(rows, w1, b1, w2):
    bsz, length = rows.shape[:2]
    n_chunk = length // CMP_STRIDE
    c = rows[:, :n_chunk * CMP_STRIDE].reshape(bsz, n_chunk, CMP_STRIDE, N_KV_HEADS, HEAD_DIM)
    c = c.transpose(0, 1, 3, 2, 4).reshape(bsz, n_chunk, N_KV_HEADS, CMP_STRIDE * HEAD_DIM)
    half = CMP_STRIDE * HEAD_DIM
    h = c[:, :-1] @ w1[:half] + c[:, 1:] @ w1[half:] + b1
    return jax.nn.gelu(h) @ w2


def compressed_kv(kv_rows, p):
    ck = rmsnorm(compress(kv_rows[..., 0, :], p['cmp_w1_k'], p['cmp_b1_k'], p['cmp_w2_k']), p['k_norm_cmp'])
    cv = compress(kv_rows[..., 1, :], p['cmp_w1_v'], p['cmp_b1_v'], p['cmp_w2_v'])
    return ck, cv


def cmp_attend(q, ck, cv, q_pos):
    nc = ck.shape[1]
    start = jnp.arange(nc) * CMP_STRIDE
    valid = (start + CMP_LEN - 1)[None, :] <= q_pos[:, None]
    dist = (q_pos[:, None] - start[None, :]).astype(jnp.float32) - (CMP_LEN - 1) / 2
    o, prob = dense_gqa(q, ck, cv, dist, valid)
    return o, prob.sum(axis=2)


def select_blocks(p_cmp, q_pos, n_blocks):
    nc = p_cmp.shape[-1]
    per = SEL_LEN // CMP_STRIDE
    ci = jnp.arange(nc)
    j = jnp.arange(n_blocks)
    overlap = ((ci // per)[None, :] == j[:, None]).astype(jnp.float32) + \
        (((ci + 1) // per)[None, :] == j[:, None]).astype(jnp.float32)
    score = jnp.einsum('bktc,jc->bktj', p_cmp, overlap)
    qb = q_pos // SEL_LEN
    forced = (j[None, :] == 0) | (j[None, :] == qb[:, None]) | (j[None, :] == qb[:, None] - 1)
    causal = j[None, :] * SEL_LEN <= q_pos[:, None]
    score = jnp.where(forced, FORCED_SCORE, jnp.where(causal, score, -1.0))
    _, idx = lax.top_k(score, min(N_SEL, n_blocks))
    return idx


def sel_attend(q, g, idx, q_pos):
    bsz, _, t_len, nsel = idx.shape
    nk = nsel * SEL_LEN
    g = g.reshape(bsz, N_KV_HEADS, t_len, nk, 2, HEAD_DIM)
    kpos = (idx[..., None] * SEL_LEN + jnp.arange(SEL_LEN)).reshape(bsz, N_KV_HEADS, t_len, nk)
    dist = q_pos[:, None] - kpos
    s = jnp.einsum('btkgd,bktsd->bkgts', q, g[..., 0, :]).astype(jnp.float32) * HEAD_DIM ** -0.5
    s = s - alibi_slopes()[None, :, :, None, None] * dist.astype(jnp.float32)[:, :, None]
    p = masked_softmax(s, (dist >= 0)[:, :, None])
    return jnp.einsum('bkgts,bktsd->btkgd', p.astype(g.dtype), g[..., 1, :])


def sel_prompt(q, kv_slc, idx):
    bsz, s_len = q.shape[:2]
    nq = s_len // SEL_QBLK
    kvb = kv_slc.reshape(bsz, s_len // SEL_LEN, SEL_LEN, N_KV_HEADS, 2, HEAD_DIM).transpose(0, 3, 1, 2, 4, 5)
    bi = jnp.arange(bsz)[:, None, None, None]
    ki = jnp.arange(N_KV_HEADS)[None, :, None, None]
    qc = q.reshape(bsz, nq, SEL_QBLK, N_KV_HEADS, GQA, HEAD_DIM).swapaxes(0, 1)
    ic = idx.reshape(bsz, N_KV_HEADS, nq, SEL_QBLK, -1).transpose(2, 0, 1, 3, 4)
    pc = jnp.arange(s_len).reshape(nq, SEL_QBLK)

    def block(args):
        qb, ib, pb = args
        return sel_attend(qb, kvb[bi, ki, ib], ib, pb)

    out = lax.map(block, (qc, ic, pc))
    return out.swapaxes(0, 1).reshape(bsz, s_len, N_KV_HEADS, GQA, HEAD_DIM)


def gather_selected_sample(cache_slc_kv, layer, page_table, new_kv, idx):
    bsz, _, t_len, _ = idx.shape
    past_blocks = PAST_LEN // SEL_LEN
    per_page = PAGE_SIZE // SEL_LEN
    bi = jnp.arange(bsz)[:, None, None, None]
    ki = jnp.arange(N_KV_HEADS)[None, :, None, None]
    jp = jnp.minimum(idx, past_blocks - 1)
    phys = page_table[bi, jp // per_page]
    rows = (jp % per_page)[..., None] * SEL_LEN + jnp.arange(SEL_LEN)
    g_past = cache_slc_kv[layer, phys[..., None], rows, ki[..., None]]
    nb_new = -(-t_len // SEL_LEN)
    newb = jnp.pad(new_kv, ((0, 0), (0, nb_new * SEL_LEN - t_len), (0, 0), (0, 0), (0, 0)))
    newb = newb.reshape(bsz, nb_new, SEL_LEN, N_KV_HEADS, 2, HEAD_DIM)
    jn = jnp.clip(idx - past_blocks, 0, nb_new - 1)
    g_new = newb[bi[..., None], jn[..., None], jnp.arange(SEL_LEN), ki[..., None]]
    return jnp.where((idx < past_blocks)[..., None, None, None], g_past, g_new.astype(g_past.dtype))


def win_prompt(q, kv_win):
    bsz, s_len = q.shape[:2]
    nb = s_len // WIN_QBLK
    wb = WINDOW // WIN_QBLK
    kvp = jnp.pad(kv_win, ((0, 0), (WINDOW, 0), (0, 0), (0, 0), (0, 0)))
    kvp = kvp.reshape(bsz, nb + wb, WIN_QBLK, N_KV_HEADS, 2, HEAD_DIM)
    band = jnp.concatenate([kvp[:, i:i + nb] for i in range(wb + 1)], axis=2)
    qpos = jnp.arange(s_len).reshape(nb, WIN_QBLK)
    kpos = (jnp.arange(nb) * WIN_QBLK - WINDOW)[:, None] + jnp.arange((wb + 1) * WIN_QBLK)
    d = qpos[:, :, None] - kpos[:, None, :]
    valid = (d >= 0) & (d < WINDOW) & (kpos[:, None, :] >= 0)
    qb = q.reshape(bsz, nb, WIN_QBLK, N_KV_HEADS, GQA, HEAD_DIM)
    o, _ = dense_gqa(qb, band[..., 0, :], band[..., 1, :], d.astype(jnp.float32), valid)
    return o.reshape(bsz, s_len, N_KV_HEADS, GQA, HEAD_DIM)


def mix_output(ssm_y, gates, o_cmp, o_slc, o_win, p):
    bsz, t_len = ssm_y.shape[:2]
    attn = gates[..., 0:1] * o_cmp + gates[..., 1:2] * o_slc + gates[..., 2:3] * o_win
    attn = attn.reshape(bsz, t_len, ATTN_WIDTH).astype(ssm_y.dtype)
    h = jnp.concatenate([rmsnorm(ssm_y, p['norm_ssm_out']), rmsnorm(attn, p['norm_attn_out'])], axis=-1)
    return h @ p['w_out']


def swiglu_ffn(x, p):
    h = rmsnorm(x, p['norm_ffn'])
    return (jax.nn.silu(h @ p['w_ffn_gate']) * (h @ p['w_ffn_up'])) @ p['w_ffn_down']


def prompt_mixer(x, p):
    bsz, s_len, _ = x.shape
    u, q, kv_cmp, kv_slc, kv_win, gates = project(rmsnorm(x, p['norm_mix']), p)
    h0 = jnp.zeros((bsz, SSM_GROUPS, SSM_STATE, 2), jnp.float32)
    ssm_y, h_last = s5_mixer(u, h0, p)
    pos = jnp.arange(s_len)
    ck, cv = compressed_kv(kv_cmp, p)
    o_cmp, p_cmp = cmp_attend(q, ck, cv, pos)
    idx = select_blocks(p_cmp, pos, s_len // SEL_LEN)
    o_slc = sel_prompt(q, kv_slc, idx)
    o_win = win_prompt(q, kv_win)
    y = mix_output(ssm_y, gates, o_cmp, o_slc, o_win, p)
    wbuf = min(WINDOW, PAST_LEN)
    win_state = jnp.pad(kv_win, ((0, 0), (max(wbuf - s_len, 0), 0), (0, 0), (0, 0), (0, 0)))[:, -wbuf:]
    return y, kv_cmp, kv_slc, win_state, h_last


def sample_mixer(x, p, cache_cmp_kv, cache_slc_kv, layer, page_table, win_buf, h0):
    bsz, t_len, _ = x.shape
    u, q, kv_cmp, kv_slc, kv_win, gates = project(rmsnorm(x, p['norm_mix']), p)
    ssm_y, h_last = s5_mixer(u, h0, p)
    pos = PAST_LEN + jnp.arange(t_len)
    past_cmp = cache_cmp_kv[layer, page_table].reshape(bsz, PAST_LEN, N_KV_HEADS, 2, HEAD_DIM)
    ck, cv = compressed_kv(jnp.concatenate([past_cmp, kv_cmp.astype(past_cmp.dtype)], axis=1), p)
    o_cmp, p_cmp = cmp_attend(q, ck, cv, pos)
    idx = select_blocks(p_cmp, pos, -(-(PAST_LEN + t_len) // SEL_LEN))
    o_slc = sel_attend(q, gather_selected_sample(cache_slc_kv, layer, page_table, kv_slc, idx), idx, pos)
    wbuf = win_buf.shape[1]
    kv_all = jnp.concatenate([win_buf, kv_win.astype(win_buf.dtype)], axis=1)
    kpos = PAST_LEN - wbuf + jnp.arange(wbuf + t_len)
    d = pos[:, None] - kpos[None, :]
    o_win, _ = dense_gqa(q, kv_all[..., 0, :], kv_all[..., 1, :], d.astype(jnp.float32), (d >= 0) & (d < WINDOW))
    y = mix_output(ssm_y, gates, o_cmp, o_slc, o_win, p)
    return y, kv_cmp, kv_slc, kv_all[:, -wbuf:], h_last


def setup_inputs(seed: int = 0) -> dict:
    key = jax.random.key(seed)
    ks = iter(jax.random.split(key, 48))

    def nrm(shape, scale=1.0):
        return jax.random.normal(next(ks), shape, jnp.float32) * scale

    def gain(n):
        return 1.0 + 0.02 * nrm((DEPTH, n))

    n_pages = PAST_LEN // PAGE_SIZE
    n_used = DEC_BATCH * n_pages
    n_pool = n_used + n_used // 4
    wbuf = min(WINDOW, PAST_LEN)
    n_idx = jnp.arange(SSM_STATE, dtype=jnp.float32)
    cache_shape = (DEPTH, n_pool, PAGE_SIZE, N_KV_HEADS, 2, HEAD_DIM)
    return {
        'x_prompt': nrm((BATCH, SEQ, D_MODEL)),
        'x_sample': nrm((DEC_BATCH, DEC_SEQ, D_MODEL)),
        'cache_cmp_kv': nrm(cache_shape),
        'cache_slc_kv': nrm(cache_shape),
        'state_win_kv': nrm((DEPTH, DEC_BATCH, wbuf, N_KV_HEADS, 2, HEAD_DIM)),
        'state_ssm': nrm((DEPTH, DEC_BATCH, SSM_GROUPS, SSM_STATE, 2), 0.1),
        'page_table': jax.random.permutation(next(ks), n_pool)[:n_used].reshape(DEC_BATCH, n_pages).astype(jnp.int32),
        'norm_mix': gain(D_MODEL),
        'w_in': nrm((DEPTH, D_MODEL, IN_WIDTH), D_MODEL ** -0.5),
        'ssm_a_re': -0.5 + 0.01 * nrm((DEPTH, SSM_GROUPS, SSM_STATE)),
        'ssm_a_im': math.pi * n_idx + 0.01 * nrm((DEPTH, SSM_GROUPS, SSM_STATE)),
        'ssm_log_dt': jax.random.uniform(next(ks), (DEPTH, SSM_GROUPS), jnp.float32, math.log(DT_MIN), math.log(DT_MAX)),
        'ssm_b_re': nrm((DEPTH, SSM_GROUPS, SSM_STATE, SSM_CH), (2 * SSM_CH) ** -0.5),
        'ssm_b_im': nrm((DEPTH, SSM_GROUPS, SSM_STATE, SSM_CH), (2 * SSM_CH) ** -0.5),
        'ssm_c_re': nrm((DEPTH, SSM_GROUPS, SSM_CH, SSM_STATE), SSM_STATE ** -0.5),
        'ssm_c_im': nrm((DEPTH, SSM_GROUPS, SSM_CH, SSM_STATE), SSM_STATE ** -0.5),
        'ssm_d': nrm((DEPTH, SSM_GROUPS, SSM_CH)),
        'ssm_w_glu': nrm((DEPTH, SSM_WIDTH, SSM_WIDTH), SSM_WIDTH ** -0.5),
        'q_norm': gain(HEAD_DIM),
        'k_norm_cmp': gain(HEAD_DIM),
        'k_norm_slc': gain(HEAD_DIM),
        'k_norm_win': gain(HEAD_DIM),
        'cmp_w1_k': nrm((DEPTH, CMP_LEN * HEAD_DIM, CMP_HIDDEN), (CMP_LEN * HEAD_DIM) ** -0.5),
        'cmp_b1_k': nrm((DEPTH, CMP_HIDDEN), 0.02),
        'cmp_w2_k': nrm((DEPTH, CMP_HIDDEN, HEAD_DIM), CMP_HIDDEN ** -0.5),
        'cmp_w1_v': nrm((DEPTH, CMP_LEN * HEAD_DIM, CMP_HIDDEN), (CMP_LEN * HEAD_DIM) ** -0.5),
        'cmp_b1_v': nrm((DEPTH, CMP_HIDDEN), 0.02),
        'cmp_w2_v': nrm((DEPTH, CMP_HIDDEN, HEAD_DIM), CMP_HIDDEN ** -0.5),
        'norm_ssm_out': gain(SSM_WIDTH),
        'norm_attn_out': gain(ATTN_WIDTH),
        'w_out': nrm((DEPTH, D_MODEL, D_MODEL), D_MODEL ** -0.5),
        'norm_ffn': gain(D_MODEL),
        'w_ffn_gate': nrm((DEPTH, D_MODEL, D_FF), D_MODEL ** -0.5),
        'w_ffn_up': nrm((DEPTH, D_MODEL, D_FF), D_MODEL ** -0.5),
        'w_ffn_down': nrm((DEPTH, D_FF, D_MODEL), D_FF ** -0.5),
    }


def reference(x_prompt, x_sample, cache_cmp_kv, cache_slc_kv, state_win_kv, state_ssm, page_table,
              norm_mix, w_in, ssm_a_re, ssm_a_im, ssm_log_dt, ssm_b_re, ssm_b_im, ssm_c_re, ssm_c_im,
              ssm_d, ssm_w_glu, q_norm, k_norm_cmp, k_norm_slc, k_norm_win,
              cmp_w1_k, cmp_b1_k, cmp_w2_k, cmp_w1_v, cmp_b1_v, cmp_w2_v,
              norm_ssm_out, norm_attn_out, w_out, norm_ffn, w_ffn_gate, w_ffn_up, w_ffn_down):
    y_prompt, y_sample = x_prompt, x_sample
    cmp_p, slc_p, win_p, ssm_p = [], [], [], []
    cmp_s, slc_s, win_s, ssm_s = [], [], [], []
    for l in range(DEPTH):
        p = {
            'norm_mix': norm_mix[l], 'w_in': w_in[l],
            'ssm_a_re': ssm_a_re[l], 'ssm_a_im': ssm_a_im[l], 'ssm_log_dt': ssm_log_dt[l],
            'ssm_b_re': ssm_b_re[l], 'ssm_b_im': ssm_b_im[l], 'ssm_c_re': ssm_c_re[l], 'ssm_c_im': ssm_c_im[l],
            'ssm_d': ssm_d[l], 'ssm_w_glu': ssm_w_glu[l],
            'q_norm': q_norm[l], 'k_norm_cmp': k_norm_cmp[l], 'k_norm_slc': k_norm_slc[l], 'k_norm_win': k_norm_win[l],
            'cmp_w1_k': cmp_w1_k[l], 'cmp_b1_k': cmp_b1_k[l], 'cmp_w2_k': cmp_w2_k[l],
            'cmp_w1_v': cmp_w1_v[l], 'cmp_b1_v': cmp_b1_v[l], 'cmp_w2_v': cmp_w2_v[l],
            'norm_ssm_out': norm_ssm_out[l], 'norm_attn_out': norm_attn_out[l], 'w_out': w_out[l],
            'norm_ffn': norm_ffn[l], 'w_ffn_gate': w_ffn_gate[l], 'w_ffn_up': w_ffn_up[l], 'w_ffn_down': w_ffn_down[l],
        }
        m, kc, ksl, kw, hs = prompt_mixer(y_prompt, p)
        y_prompt = y_prompt + m
        y_prompt = y_prompt + swiglu_ffn(y_prompt, p)
        cmp_p.append(kc)
        slc_p.append(ksl)
        win_p.append(kw)
        ssm_p.append(hs)
        m, kc, ksl, kw, hs = sample_mixer(y_sample, p, cache_cmp_kv, cache_slc_kv, l, page_table,
                                          state_win_kv[l], state_ssm[l])
        y_sample = y_sample + m
        y_sample = y_sample + swiglu_ffn(y_sample, p)
        cmp_s.append(kc)
        slc_s.append(ksl)
        win_s.append(kw)
        ssm_s.append(hs)
    new_cmp_kv_prompt = jnp.stack(cmp_p)
    new_slc_kv_prompt = jnp.stack(slc_p)
    new_win_kv_prompt = jnp.stack(win_p)
    new_ssm_prompt = jnp.stack(ssm_p)
    new_cmp_kv_sample = jnp.stack(cmp_s)
    new_slc_kv_sample = jnp.stack(slc_s)
    new_win_kv_sample = jnp.stack(win_s)
    new_ssm_sample = jnp.stack(ssm_s)
    return (y_prompt, y_sample, new_cmp_kv_prompt, new_slc_kv_prompt, new_win_kv_prompt, new_ssm_prompt,
            new_cmp_kv_sample, new_slc_kv_sample, new_win_kv_sample, new_ssm_sample)
```

```cpp
#include <hip/hip_runtime.h>
#include <cstdio>
#include <cstdint>

#ifndef MK_MULTI
#define MK_MULTI 0
#endif

namespace pg8 {
#define PG8_LAS __attribute__((address_space(3)))
typedef unsigned short bf16_t;
typedef short bf16x8 __attribute__((ext_vector_type(8)));
typedef float f32x4 __attribute__((ext_vector_type(4)));
typedef unsigned u32x4 __attribute__((ext_vector_type(4)));
constexpr int BM = 256, BK = 64, HALF = 128, HTB = HALF * BK * 2  , STAGE_BYTES = 8 * HTB, NXCD = 8, WGM = 8;

__host__ __device__ __forceinline__ int lds_byte(int r, int c) { const int st = (r >> 4) * 2 + (c >> 5), rr = r & 15, cc = c & 31, ob = rr * 64 + cc * 2; return st * 1024 + (ob ^ (((ob >> 9) & 1) << 5)); }
__host__ __device__ __forceinline__ void stage_rc(int b, int& R, int& C) { const int st = b / 1024, sb = b % 1024, swz = sb ^ (((sb >> 9) & 1) << 5); R = (st >> 1) * 16 + swz / 64; C = (st & 1) * 32 + (swz % 64) / 2; }
__host__ __device__ __forceinline__ int perm32(int rho) { const int n = rho >> 4, i = rho & 15; return 8 * (i >> 2) + 4 * n + (i & 3); }

struct Unit { int pm, pn; };
struct Gemm { const bf16_t* A; const bf16_t* Bt; int M, N, K; };

struct StaticOrder {
    int nM, nN, nwg, G, c;
    __host__ __device__ void init(int M, int N, int G_, int c_) { nM = M / BM; nN = N / BM; nwg = nM * nN; G = G_; c = c_; }
    __host__ __device__ bool next(int i, Unit& u) const {
        const long L = (long)i * G + c; if (L >= nwg) return false;
        int wgid = (int)L; { const int q = nwg / NXCD, r = nwg % NXCD, xcd = wgid % NXCD, off = wgid / NXCD; wgid = (xcd < r ? xcd * (q + 1) : r * (q + 1) + (xcd - r) * q) + off; }
        const int nig = WGM * nN, gid = wgid / nig, fm = gid * WGM, gsz = (nM - fm) < WGM ? (nM - fm) : WGM;
        u.pm = fm + ((wgid % nig) % gsz); u.pn = (wgid % nig) / gsz; return true;
    }
    __device__ __forceinline__ void a_ready(const Unit&) const {}
    __device__ __forceinline__ void done(const Unit&) const {}
};
__device__ __forceinline__ unsigned cvt_pk_bf16(float lo, float hi) { unsigned r; asm volatile("v_cvt_pk_bf16_f32 %0, %1, %2" : "=v"(r) : "v"(lo), "v"(hi)); return r; }
typedef float f32x2 __attribute__((ext_vector_type(2)));
typedef unsigned u32x2 __attribute__((ext_vector_type(2)));
__device__ __forceinline__ float fast_sigmoid(float x) { return __builtin_amdgcn_rcpf(1.0f + __builtin_amdgcn_exp2f(-1.4426950408889634f * x)); }
__device__ __forceinline__ float gelu_tanh(float x) { const float a = 1.5957691216057308f * (x + 0.044715f * x * x * x); return x * fast_sigmoid(a); }

struct GroupOrder {
    int n, G, c, per;
    __device__ bool next(int i, Unit& u) const { const int L = i * G + c; if (c < 0 || L >= n) return false; u.pm = L; u.pn = L / per; return true; }
    __device__ __forceinline__ void a_ready(const Unit&) const {}
    __device__ __forceinline__ void done(const Unit&) const {}
};

struct OneUnitOrder {
    StaticOrder S; int i;
    __device__ bool next(int k, Unit& u) const { return k == 0 ? S.next(i, u) : false; }
    __device__ __forceinline__ void a_ready(const Unit&) const {}
    __device__ __forceinline__ void done(const Unit&) const {}
};
struct EpiIn {
    static constexpr bool PERM = true, AFTER_DRAIN = false;
    bf16_t* U; bf16_t* Us; bf16_t* Q; float* KVraw; float* Gt; bf16_t* KVC; const PG8_LAS float* RS; mutable int slot;
    __device__ __forceinline__ void operator()(const f32x4 (&acc)[2][2][4][2], const Unit& u, int wr, int wc, int fr, int fq) const {
        const int pn = u.pn, cw = wc * 32 + 8 * fq; const PG8_LAS float* rsp = RS + slot * 256 + wr * 64 + fr; ++slot;
#pragma unroll
        for (int ai = 0; ai < 2; ++ai)
#pragma unroll
            for (int m = 0; m < 4; ++m) {
                const int row = u.pm * BM + ai * HALF + wr * 64 + m * 16 + fr; const float rs = rsp[ai * HALF + m * 16];
                if (row < 8224) {
#pragma unroll
                    for (int bj = 0; bj < 2; ++bj) {
                        const int col = pn * BM + bj * HALF + cw; const f32x4 v0 = acc[ai][bj][m][0] * rs, v1 = acc[ai][bj][m][1] * rs;
                        if (pn < 8) {
                            u32x4 w; w.x = cvt_pk_bf16(v0[0], v0[1]); w.y = cvt_pk_bf16(v0[2], v0[3]); w.z = cvt_pk_bf16(v1[0], v1[1]); w.w = cvt_pk_bf16(v1[2], v1[3]);
                            if (pn < 4) {
                                if (row < 8192) { const int b = row >> 11, t = row & 2047, g = col >> 4, p0 = col & 15;
                                    *(u32x4*)(U + ((size_t)((b * 64 + g) * 2048 + t) * 16 + p0)) = w; }
                                else *(u32x4*)(Us + (size_t)(row - 8192) * 1024 + col) = w;
                            } else *(u32x4*)(Q + (size_t)row * 1024 + (col - 1024)) = w;
                        } else if (pn < 14) {
                            float* d = KVraw + (size_t)row * 1536 + (col - 2048); *(f32x4*)d = v0; *(f32x4*)(d + 4) = v1;
                            if (pn < 10 && row < 8192) {
                                u32x4 w; w.x = cvt_pk_bf16(v0[0], v0[1]); w.y = cvt_pk_bf16(v0[2], v0[3]); w.z = cvt_pk_bf16(v1[0], v1[1]); w.w = cvt_pk_bf16(v1[2], v1[3]);
                                const int b = row >> 11, t = row & 2047; *(u32x4*)(KVC + ((size_t)(((pn - 8) * 4 + b) * 2 + bj) * 2048 + t) * 128 + cw) = w; }
                        } else {
                            const int cc = col - 3584;
                            if (cc < 24) { f32x4 a, b2;
#pragma unroll
                                for (int j = 0; j < 4; ++j) { a[j] = fast_sigmoid(v0[j]); b2[j] = fast_sigmoid(v1[j]); }
                                float* d = Gt + (size_t)row * 32 + cc; *(f32x4*)d = a; *(f32x4*)(d + 4) = b2; }
                        }
                    }
                }
            }
    }
};
struct EpiTB {
    static constexpr bool PERM = false, AFTER_DRAIN = false;
    float* C;
    __device__ __forceinline__ void operator()(const f32x4 (&acc)[2][2][4][2], const Unit& u, int wr, int wc, int fr, int fq) const {
#pragma unroll
        for (int ai = 0; ai < 2; ++ai)
#pragma unroll
            for (int m = 0; m < 4; ++m) { float* rowp = C + (size_t)(u.pm * BM + ai * HALF + wr * 64 + m * 16 + fr) * 256 + wc * 32 + 4 * fq;
#pragma unroll
                for (int bj = 0; bj < 2; ++bj)
#pragma unroll
                    for (int n = 0; n < 2; ++n) *(f32x4*)(rowp + bj * HALF + n * 16) = acc[ai][bj][m][n]; }
    }
};
struct EpiGlu {
    static constexpr bool PERM = true, AFTER_DRAIN = false;
    const bf16_t* Z; bf16_t* Y;
    __device__ __forceinline__ void operator()(const f32x4 (&acc)[2][2][4][2], const Unit& u, int wr, int wc, int fr, int fq) const {
#pragma unroll
        for (int ai = 0; ai < 2; ++ai) { u32x4 zz[4][2];
#pragma unroll
            for (int m = 0; m < 4; ++m) { const size_t off = (size_t)(u.pm * BM + ai * HALF + wr * 64 + m * 16 + fr) * 1024 + u.pn * BM + wc * 32 + 8 * fq; zz[m][0] = *(const u32x4*)(Z + off); zz[m][1] = *(const u32x4*)(Z + off + HALF); }
#pragma unroll
            for (int m = 0; m < 4; ++m) { const size_t off = (size_t)(u.pm * BM + ai * HALF + wr * 64 + m * 16 + fr) * 1024 + u.pn * BM + wc * 32 + 8 * fq;
#pragma unroll
                for (int bj = 0; bj < 2; ++bj) { const u32x4 z = zz[m][bj]; const f32x4 v0 = acc[ai][bj][m][0], v1 = acc[ai][bj][m][1];
                    float zf[8];
#pragma unroll
                    for (int j = 0; j < 4; ++j) { zf[2 * j] = __uint_as_float(z[j] << 16); zf[2 * j + 1] = __uint_as_float(z[j] & 0xffff0000u); }
                    u32x4 w; w.x = cvt_pk_bf16(zf[0] * fast_sigmoid(v0[0]), zf[1] * fast_sigmoid(v0[1])); w.y = cvt_pk_bf16(zf[2] * fast_sigmoid(v0[2]), zf[3] * fast_sigmoid(v0[3]));
                    w.z = cvt_pk_bf16(zf[4] * fast_sigmoid(v1[0]), zf[5] * fast_sigmoid(v1[1])); w.w = cvt_pk_bf16(zf[6] * fast_sigmoid(v1[2]), zf[7] * fast_sigmoid(v1[3]));
                    *(u32x4*)(Y + off + bj * HALF) = w; } } }
    }
};
template <bool BF32, bool OF32> struct EpiRes {
    static constexpr bool PERM = true, AFTER_DRAIN = false;
    const void* base; void* out; float* PS;
    __device__ __forceinline__ void operator()(const f32x4 (&acc)[2][2][4][2], const Unit& u, int wr, int wc, int fr, int fq) const {
        const int col0 = u.pn * BM + wc * 32 + 8 * fq;
        constexpr int MG = BF32 ? 2 : 4;
#pragma unroll
        for (int ai = 0; ai < 2; ++ai)
#pragma unroll
            for (int m0 = 0; m0 < 4; m0 += MG) {
                f32x4 bf[MG][2][2]; u32x4 bh[MG][2];
#pragma unroll
                for (int mm = 0; mm < MG; ++mm) { const size_t off = (size_t)(u.pm * BM + ai * HALF + wr * 64 + (m0 + mm) * 16 + fr) * 2048 + col0;
#pragma unroll
                    for (int bj = 0; bj < 2; ++bj) { if (BF32) { bf[mm][bj][0] = *(const f32x4*)((const float*)base + off + bj * HALF); bf[mm][bj][1] = *(const f32x4*)((const float*)base + off + bj * HALF + 4); }
                                                     else bh[mm][bj] = *(const u32x4*)((const bf16_t*)base + off + bj * HALF); } }
#pragma unroll
                for (int mm = 0; mm < MG; ++mm) { const int m = m0 + mm; const int row = u.pm * BM + ai * HALF + wr * 64 + m * 16 + fr; const size_t off = (size_t)row * 2048 + col0; float ss = 0.f;
#pragma unroll
                    for (int bj = 0; bj < 2; ++bj) { f32x4 b0, b1;
                        if (BF32) { b0 = bf[mm][bj][0]; b1 = bf[mm][bj][1]; }
                        else { const u32x4 w = bh[mm][bj];
                            b0 = (f32x4){__uint_as_float(w.x << 16), __uint_as_float(w.x & 0xffff0000u), __uint_as_float(w.y << 16), __uint_as_float(w.y & 0xffff0000u)};
                            b1 = (f32x4){__uint_as_float(w.z << 16), __uint_as_float(w.z & 0xffff0000u), __uint_as_float(w.w << 16), __uint_as_float(w.w & 0xffff0000u)}; }
                        const f32x4 v0 = b0 + acc[ai][bj][m][0], v1 = b1 + acc[ai][bj][m][1];
                        if (OF32) { *(f32x4*)((float*)out + off + bj * HALF) = v0; *(f32x4*)((float*)out + off + bj * HALF + 4) = v1; }
                        else { u32x4 w; w.x = cvt_pk_bf16(v0[0], v0[1]); w.y = cvt_pk_bf16(v0[2], v0[3]); w.z = cvt_pk_bf16(v1[0], v1[1]); w.w = cvt_pk_bf16(v1[2], v1[3]); *(u32x4*)((bf16_t*)out + off + bj * HALF) = w; }
                        if (PS) ss += ((v0[0] * v0[0] + v0[1] * v0[1]) + (v0[2] * v0[2] + v0[3] * v0[3])) + ((v1[0] * v1[0] + v1[1] * v1[1]) + (v1[2] * v1[2] + v1[3] * v1[3])); }
                    if (PS) { ss += __shfl_xor(ss, 16); ss += __shfl_xor(ss, 32); if (fq == 0) PS[(size_t)row * 32 + u.pn * 4 + wc] = ss; } }
                asm volatile("" ::: "memory"); }
    }
};
struct EpiSwiGLU {
    static constexpr bool PERM = true, AFTER_DRAIN = false;
    bf16_t* Hm; const PG8_LAS float* RS; mutable int slot;
    __device__ __forceinline__ void operator()(const f32x4 (&acc)[2][2][4][2], const Unit& u, int wr, int wc, int fr, int fq) const {
        const PG8_LAS float* rsp = RS + slot * 256 + wr * 64 + fr; ++slot;
#pragma unroll
        for (int ai = 0; ai < 2; ++ai)
#pragma unroll
            for (int m = 0; m < 4; ++m) { const float rs = rsp[ai * HALF + m * 16]; bf16_t* d = Hm + (size_t)(u.pm * BM + ai * HALF + wr * 64 + m * 16 + fr) * 5632 + u.pn * HALF + wc * 32 + 8 * fq;
                float h[8];
#pragma unroll
                for (int n = 0; n < 2; ++n)
#pragma unroll
                    for (int j = 0; j < 4; ++j) { const float gt = acc[ai][0][m][n][j] * rs, up = acc[ai][1][m][n][j] * rs;
#ifdef DBG_NOSIG
                        h[4 * n + j] = gt + 0.5f * up; }
#else
                        h[4 * n + j] = gt * fast_sigmoid(gt) * up; }
#endif

                u32x4 w; w.x = cvt_pk_bf16(h[0], h[1]); w.y = cvt_pk_bf16(h[2], h[3]); w.z = cvt_pk_bf16(h[4], h[5]); w.w = cvt_pk_bf16(h[6], h[7]);
                *(u32x4*)d = w; }
    }
};
template <class Epi, class Sched, bool ALIGN_EPI = false, bool SP2 = false>
__device__ __forceinline__ void gemm_phase(PG8_LAS unsigned char* lds, const Gemm g, const Sched& S, const Epi& E) {
    int tid = threadIdx.x; asm volatile("" : "+v"(tid));
    const int wid = __builtin_amdgcn_readfirstlane(tid >> 6), lane = tid & 63, wr = wid >> 2, wc = wid & 3, fr = lane & 15, fq = lane >> 4;
    const int K = g.K, nt = K / BK;
    unsigned voffA[2], voffB[2];
#pragma unroll
    for (int i = 0; i < 2; ++i) { int R, C; stage_rc(tid * 16 + i * 8192, R, C); const int Rb = Epi::PERM ? ((R & ~31) + perm32(R & 31)) : R;
        voffA[i] = (unsigned)(R * K + C) * 2u; voffB[i] = (unsigned)(Rb * K + C) * 2u; }
    const size_t kstep = (size_t)(BK * 2);
    const size_t hstep = (size_t)HALF * K * 2;
    const size_t tstep = 2 * hstep;
    const unsigned ldsw = (unsigned)wid * 1024u;
    const int aoff = lds_byte(wr * 64 + fr, fq * 8), boff = lds_byte(wc * 32 + fr, fq * 8);
#define PG8_SA(b, h) (((b) * 2 + (h)) * HTB)
#define PG8_SB(b, h) ((4 + (b) * 2 + (h)) * HTB)
#define PG8_STAGE(bufoff, gbase, voff) do { _Pragma("unroll") for (int _i = 0; _i < 2; ++_i) \
        __builtin_amdgcn_global_load_lds((const unsigned*)((const char*)(gbase) + (voff)[_i]), (PG8_LAS unsigned*)(lds + (bufoff) + ldsw + _i * 8192), 16, 0, 0); } while (0)
#define PG8_LDA(dst, b, h) do { _Pragma("unroll") for (int m = 0; m < 4; ++m) _Pragma("unroll") for (int k = 0; k < 2; ++k) dst[m][k] = *(const PG8_LAS bf16x8*)(lds + PG8_SA(b, h) + aoff + m * 2048 + k * 1024); } while (0)
#define PG8_LDB(dst, b, h) do { _Pragma("unroll") for (int n = 0; n < 2; ++n) _Pragma("unroll") for (int k = 0; k < 2; ++k) dst[n][k] = *(const PG8_LAS bf16x8*)(lds + PG8_SB(b, h) + boff + n * 2048 + k * 1024); } while (0)
#define PG8_MMA(ai, bj, At, Bt) do { __builtin_amdgcn_s_setprio(1); _Pragma("unroll") for (int m = 0; m < 4; ++m) _Pragma("unroll") for (int n = 0; n < 2; ++n) _Pragma("unroll") for (int k = 0; k < 2; ++k) \
        acc[ai][bj][m][n] = __builtin_amdgcn_mfma_f32_16x16x32_bf16(Bt[n][k], At[m][k], acc[ai][bj][m][n], 0, 0, 0); __builtin_amdgcn_s_setprio(0); } while (0)
#define PG8_WAIT_V(n) asm volatile("s_waitcnt vmcnt(" #n ")" ::: "memory")
#define PG8_WAIT_L(n) asm volatile("s_waitcnt lgkmcnt(" #n ")" ::: "memory")
#define PG8_BAR __builtin_amdgcn_s_barrier()
#define PG8_SCHED __builtin_amdgcn_sched_barrier(0)
    Unit cur, nxt; int ui = 0;
    if (!S.next(0, cur)) return;
    f32x4 acc[2][2][4][2];
#pragma unroll
    for (int a = 0; a < 2; ++a)
#pragma unroll
        for (int b = 0; b < 2; ++b)
#pragma unroll
            for (int m = 0; m < 4; ++m)
#pragma unroll
                for (int n = 0; n < 2; ++n) acc[a][b][m][n] = (f32x4){0.f, 0.f, 0.f, 0.f};
    bf16x8 At[4][2], B0[2][2], B1[2][2];
    const char* cA = (const char*)g.A + (size_t)cur.pm * tstep; const char* cB = (const char*)g.Bt + (size_t)cur.pn * tstep;
    S.a_ready(cur);
    if constexpr (SP2) {
        PG8_STAGE(PG8_SB(0, 0), cB, voffB); PG8_STAGE(PG8_SB(0, 1), cB + hstep, voffB); PG8_STAGE(PG8_SA(0, 0), cA, voffA); PG8_STAGE(PG8_SA(0, 1), cA + hstep, voffA);
        if (wr == 1) PG8_BAR;
        PG8_WAIT_V(2); PG8_BAR;
        PG8_STAGE(PG8_SB(1, 0), cB + kstep, voffB); PG8_STAGE(PG8_SA(1, 0), cA + kstep, voffA); PG8_STAGE(PG8_SB(1, 1), cB + hstep + kstep, voffB);
        PG8_WAIT_V(6); PG8_BAR;
    } else {
        PG8_STAGE(PG8_SB(0, 0), cB, voffB); PG8_STAGE(PG8_SA(0, 0), cA, voffA); PG8_STAGE(PG8_SB(0, 1), cB + hstep, voffB); PG8_STAGE(PG8_SA(0, 1), cA + hstep, voffA);
        if (wr == 1) PG8_BAR;
        PG8_WAIT_V(4); PG8_BAR;
        PG8_STAGE(PG8_SB(1, 0), cB + kstep, voffB); PG8_STAGE(PG8_SA(1, 0), cA + kstep, voffA); PG8_STAGE(PG8_SB(1, 1), cB + hstep + kstep, voffB);
        PG8_WAIT_V(6); PG8_BAR;
    }
    for (;;) {
        const bool has_next = S.next(ui + 1, nxt);
        const char* nA = has_next ? (const char*)g.A + (size_t)nxt.pm * tstep : cA; const char* nB = has_next ? (const char*)g.Bt + (size_t)nxt.pn * tstep : cB;
        for (int t = 0; t < nt; t += 2) {
            const bool last = (t == nt - 2);
            const char* a1 = cA + (size_t)(t + 1) * kstep;
            const char* a2 = last ? nA : cA + (size_t)(t + 2) * kstep; const char* b2 = last ? nB : cB + (size_t)(t + 2) * kstep;
            const char* a3 = a2 + kstep; const char* b3 = b2 + kstep;
            if (last && has_next) S.a_ready(nxt);
            if constexpr (SP2) {
            PG8_LDB(B0, 0, 0); PG8_LDB(B1, 0, 1); PG8_SCHED; PG8_LDA(At, 0, 0); PG8_STAGE(PG8_SA(1, 1), a1 + hstep, voffA);
            PG8_WAIT_V(8); PG8_WAIT_L(0); PG8_BAR; PG8_MMA(0, 0, At, B0); PG8_MMA(0, 1, At, B1); PG8_BAR; PG8_SCHED;
            PG8_LDA(At, 0, 1); PG8_STAGE(PG8_SB(0, 0), b2, voffB); PG8_STAGE(PG8_SB(0, 1), b2 + hstep, voffB); PG8_STAGE(PG8_SA(0, 0), a2, voffA);
            PG8_WAIT_V(8); PG8_WAIT_L(0); PG8_BAR; PG8_MMA(1, 0, At, B0); PG8_MMA(1, 1, At, B1); PG8_BAR; PG8_SCHED;
            PG8_LDB(B0, 1, 0); PG8_LDB(B1, 1, 1); PG8_SCHED; PG8_LDA(At, 1, 0); PG8_STAGE(PG8_SA(0, 1), a2 + hstep, voffA);
            PG8_WAIT_V(8); PG8_WAIT_L(0); PG8_BAR; PG8_MMA(0, 0, At, B0); PG8_MMA(0, 1, At, B1); PG8_BAR; PG8_SCHED;
            PG8_LDA(At, 1, 1); PG8_STAGE(PG8_SB(1, 0), b3, voffB); PG8_STAGE(PG8_SB(1, 1), b3 + hstep, voffB); PG8_STAGE(PG8_SA(1, 0), a3, voffA);
            PG8_WAIT_V(8); PG8_WAIT_L(0); PG8_BAR; PG8_MMA(1, 0, At, B0); PG8_MMA(1, 1, At, B1); PG8_BAR; PG8_SCHED;
            } else {
            PG8_LDB(B0, 0, 0); PG8_SCHED; PG8_LDA(At, 0, 0); PG8_STAGE(PG8_SA(1, 1), a1 + hstep, voffA);
            PG8_WAIT_L(8); PG8_BAR; PG8_WAIT_L(0); PG8_MMA(0, 0, At, B0); PG8_BAR; PG8_SCHED;
            PG8_LDB(B1, 0, 1); PG8_STAGE(PG8_SB(0, 0), b2, voffB);
            PG8_BAR; PG8_WAIT_L(0); PG8_MMA(0, 1, At, B1); PG8_BAR;
            PG8_LDA(At, 0, 1); PG8_STAGE(PG8_SA(0, 0), a2, voffA);
            PG8_BAR; PG8_WAIT_L(0); PG8_MMA(1, 0, At, B0); PG8_BAR; PG8_SCHED;
            PG8_STAGE(PG8_SB(0, 1), b2 + hstep, voffB);
            PG8_WAIT_V(6); PG8_BAR; PG8_MMA(1, 1, At, B1); PG8_BAR;
            PG8_LDB(B0, 1, 0); PG8_SCHED; PG8_LDA(At, 1, 0); PG8_STAGE(PG8_SA(0, 1), a2 + hstep, voffA);
            PG8_WAIT_L(8); PG8_BAR; PG8_WAIT_L(0); PG8_MMA(0, 0, At, B0); PG8_BAR; PG8_SCHED;
            PG8_LDB(B1, 1, 1); PG8_STAGE(PG8_SB(1, 0), b3, voffB);
            PG8_BAR; PG8_WAIT_L(0); PG8_MMA(0, 1, At, B1); PG8_BAR;
            PG8_LDA(At, 1, 1); PG8_STAGE(PG8_SA(1, 0), a3, voffA);
            PG8_BAR; PG8_WAIT_L(0); PG8_MMA(1, 0, At, B0); PG8_BAR; PG8_SCHED;
            PG8_STAGE(PG8_SB(1, 1), b3 + hstep, voffB);
            PG8_WAIT_V(6); PG8_BAR; PG8_MMA(1, 1, At, B1); PG8_BAR;
            }
        }
        if constexpr (ALIGN_EPI) { if (wr == 0) PG8_BAR; }
        if constexpr (!Epi::AFTER_DRAIN) { E(acc, cur, wr, wc, fr, fq); S.done(cur); }
        if (!has_next) break;
#pragma unroll
        for (int a = 0; a < 2; ++a)
#pragma unroll
            for (int b = 0; b < 2; ++b)
#pragma unroll
                for (int m = 0; m < 4; ++m)
#pragma unroll
                    for (int n = 0; n < 2; ++n) acc[a][b][m][n] = (f32x4){0.f, 0.f, 0.f, 0.f};
        cur = nxt; cA = nA; cB = nB; ++ui;
        if constexpr (ALIGN_EPI) { if (wr == 1) PG8_BAR; }
    }
    PG8_WAIT_V(0);
    if constexpr (!ALIGN_EPI) { if (wr == 0) PG8_BAR; }
    PG8_BAR;
    if constexpr (Epi::AFTER_DRAIN) { E.fused(acc, cur, wr, wc, fr, fq, lds, wid, lane); S.done(cur); }
#undef PG8_SA
#undef PG8_SB
#undef PG8_STAGE
#undef PG8_LDA
#undef PG8_LDB
#undef PG8_MMA
#undef PG8_WAIT_V
#undef PG8_WAIT_L
#undef PG8_BAR
#undef PG8_SCHED
}
}
#define GAS __attribute__((address_space(1)))
typedef unsigned short bf16;
typedef short bf16x8 __attribute__((ext_vector_type(8)));
typedef short s16x4 __attribute__((ext_vector_type(4)));
typedef float f32x2 __attribute__((ext_vector_type(2)));
typedef float f32x4 __attribute__((ext_vector_type(4)));
typedef float f32x16 __attribute__((ext_vector_type(16)));
typedef unsigned u32x2 __attribute__((ext_vector_type(2)));
typedef unsigned u32x4 __attribute__((ext_vector_type(4)));
using pg8::cvt_pk_bf16; using pg8::fast_sigmoid; using pg8::gelu_tanh;
#define LDS_WAIT() asm volatile("s_waitcnt lgkmcnt(0)" ::: "memory")
#define VM_WAIT() asm volatile("s_waitcnt vmcnt(0)" ::: "memory")

constexpr int DM = 2048, NB = 4, SEQ = 2048, MP = NB * SEQ  , SB = 8, ST = 4, MS = SB * ST  , MR = MP + MS  , MPAD = 8448;
constexpr int PAST = 16384, NPOOL = 1280, INW = 3608, INWP = 3840, DFF = 5632, NG = 64  ;
constexpr float EPS = 1e-6f, SM_SCALE = 0.08838834764831845f;
constexpr int NIN = 35;
enum { I_XP = 0, I_XS, I_CCMP, I_CSLC, I_SWIN, I_SSSM, I_PT, I_NMIX, I_WIN, I_ARE, I_AIM, I_LDT, I_BRE, I_BIM, I_CRE, I_CIM, I_D, I_WGLU, I_QN, I_KNC, I_KNS, I_KNW,
       I_W1K, I_B1K, I_W2K, I_W1V, I_B1V, I_W2V, I_NSSM, I_NATT, I_WOUT, I_NFFN, I_WG, I_WU, I_WD };
constexpr size_t O_YP = 0, O_YS = O_YP + (size_t)MP * DM, O_CMPP = O_YS + (size_t)MS * DM, O_SLCP = O_CMPP + 2ull * MP * 512, O_WINP = O_SLCP + 2ull * MP * 512,
                 O_SSMP = O_WINP + 2ull * NB * 512 * 512, O_CMPS = O_SSMP + 2ull * NB * 64 * 128, O_SLCS = O_CMPS + 2ull * MS * 512, O_WINS = O_SLCS + 2ull * MS * 512,
                 O_SSMS = O_WINS + 2ull * SB * 512 * 512, O_END = O_SSMS + 2ull * SB * 64 * 128;
constexpr size_t WS_CTL = 0, CTL_BYTES = 1u << 20;
constexpr size_t WS_WIN = CTL_BYTES;
constexpr size_t WS_WGLU = WS_WIN + 2ull * INWP * DM * 2;
constexpr size_t WS_WOUT = WS_WGLU + 2ull * 1024 * 1024 * 2;
constexpr size_t WS_WGU = WS_WOUT + 2ull * DM * DM * 2;
constexpr size_t WS_WDN = WS_WGU + 2ull * 2 * DFF * DM * 2;
constexpr size_t WS_W1C = WS_WDN + 2ull * DM * DFF * 2;
constexpr size_t WS_W2T = WS_W1C + 2ull * 2 * 256 * 2048 * 2;
constexpr size_t WS_TG = WS_W2T + 2ull * 2 * 128 * 128 * 2;
constexpr size_t WS_EG = WS_TG + 2ull * 64 * 256 * 256 * 2;
constexpr size_t WS_FG = WS_EG + 2ull * 64 * 128 * 256 * 2;
constexpr size_t WS_LAM1 = WS_FG + 2ull * 64 * 256 * 128 * 2;
constexpr size_t WS_LAM16 = WS_LAM1 + 2ull * 64 * 64 * 2 * 4;
constexpr size_t WS_BBAR = WS_LAM16 + 2ull * 64 * 64 * 2 * 4;
constexpr size_t WS_CA = WS_BBAR + 2ull * 64 * 64 * 16 * 2 * 4;
constexpr size_t WS_TBS = WS_CA + 2ull * 2 * 8 * 2 * 16384 * 128 * 2;
constexpr size_t WS_TBP = WS_TBS + 4ull * 16384 * 256 * 4;
constexpr size_t WS_CKVS = WS_TBP + 2048ull * 256 * 4;
constexpr size_t WS_CKVP = WS_CKVS + 2ull * 2 * 8 * 2 * 1024 * 128 * 2;
constexpr size_t WS_XN = WS_CKVP + 2ull * 4 * 2 * 128 * 128 * 2;
constexpr size_t WS_U = WS_XN + (size_t)MPAD * DM * 2;
constexpr size_t WS_US = WS_U + 4ull * 64 * 2048 * 16 * 2;
constexpr size_t WS_Q = WS_US + 32ull * 1024 * 2;
constexpr size_t WS_KVRAW = WS_Q + (size_t)MPAD * 1024 * 2;
constexpr size_t WS_KVC = WS_KVRAW + (size_t)MPAD * 1536 * 4;
constexpr size_t WS_KVS = WS_KVC + 2ull * 4 * 2 * 2048 * 128 * 2;
constexpr size_t WS_KVW = WS_KVS + 2ull * 4 * 2 * 2048 * 128 * 2;
constexpr size_t WS_GT = WS_KVW + 2ull * 4 * 2 * 2048 * 128 * 2;
constexpr size_t WS_Z = WS_GT + (size_t)MPAD * 32 * 4;
constexpr size_t WS_SSMY = WS_Z + (size_t)MPAD * 1024 * 2;
constexpr size_t WS_ATT = WS_SSMY + (size_t)MPAD * 1024 * 2;
constexpr size_t WS_H = WS_ATT + (size_t)MPAD * 1024 * 4;
constexpr size_t WS_YA = WS_H + (size_t)MPAD * DM * 2;
constexpr size_t WS_YB = WS_YA + (size_t)MPAD * DM * 4;
constexpr size_t WS_HN = WS_YB + (size_t)MPAD * DM * 4;
constexpr size_t WS_HMID = WS_HN + (size_t)MPAD * DM * 2;
constexpr size_t WS_PS = WS_HMID + (size_t)MPAD * DFF * 2;
constexpr size_t WS_PSS = WS_PS + (size_t)MPAD * 32 * 4;
constexpr size_t WS_END = WS_PSS + 32ull * 128 * 4;
static_assert(WS_END < 1500ull * 1024 * 1024, "ws map");
constexpr int CW_BAR = 4096;
constexpr int LDS_BYTES = 159744, MISC_OFF = LDS_BYTES - 64, LDS_RS = 131072;

#define LAS __attribute__((address_space(3)))
#define XB_TMO      128
#define XB_XCNT(j)  (256  + 64 * (j))
#define XB_XSUB(j)  (1280 + 64 * (j))
#define XB_XGEN(j)  (2304 + 64 * (j))
#define XB_TOP      3328
#define XB_TOPGEN   3392
#define XCD_BAR_WORDS 3456
#define XB_SPIN_CAP (1u << 18)
#define LAS __attribute__((address_space(3)))

__device__ __forceinline__ unsigned xb_ld(unsigned* p)              { return __hip_atomic_load(p, __ATOMIC_RELAXED, __HIP_MEMORY_SCOPE_AGENT); }
__device__ __forceinline__ unsigned xb_add(unsigned* p, unsigned v) { return __hip_atomic_fetch_add(p, v, __ATOMIC_RELAXED, __HIP_MEMORY_SCOPE_AGENT); }
__device__ __forceinline__ unsigned xb_xcc_id() { return (unsigned)__builtin_amdgcn_s_getreg((3 << 11) | 20) & 0xFu; }
#define XB_SPIN(cond, bar) do { unsigned _sp = 0; while (cond) { __builtin_amdgcn_s_sleep(1); \
    if ((++_sp & 255u) == 0u) { if (xb_ld(&(bar)[XB_TMO])) break; if (_sp > XB_SPIN_CAP) { atomicAdd(&(bar)[XB_TMO], 1u); break; } } } } while (0)

struct XcdBarrier {
    unsigned* bar; unsigned x;
    volatile LAS unsigned* st;
};

__device__ __forceinline__ XcdBarrier xcd_barrier_post(unsigned* bar, volatile LAS unsigned* st) {
    XcdBarrier b; b.bar = bar; b.x = xb_xcc_id(); b.st = st;
    if (threadIdx.x == 0) (void)xb_add(&bar[XB_XCNT(b.x)], 1u);
    return b;
}
__device__ __forceinline__ void xcd_barrier_complete(unsigned* bar, unsigned x, unsigned& nloc, unsigned& nx) {
    const unsigned G = gridDim.x * gridDim.y * gridDim.z;
    unsigned sum, cnt, mine, sp = 0u;
    for (;;) {
        sum = 0u; cnt = 0u; mine = 0u;
#pragma unroll
        for (unsigned j = 0; j < 16; ++j) { const unsigned c = xb_ld(&bar[XB_XCNT(j)]); sum += c; cnt += (c > 0u) ? 1u : 0u; mine = (j == x) ? c : mine; }
        if (sum == G) break;
        __builtin_amdgcn_s_sleep(1);
        if ((++sp & 255u) == 0u) { if (xb_ld(&bar[XB_TMO])) break; if (sp > XB_SPIN_CAP) { atomicAdd(&bar[XB_TMO], 1u); break; } }
    }
    nloc = mine > 0u ? mine : 1u; nx = cnt > 0u ? cnt : 1u;
}

__device__ __forceinline__ void xcd_barrier(const XcdBarrier& b) {
    asm volatile("s_waitcnt vmcnt(0)" ::: "memory");
    __syncthreads();
    if (threadIdx.x == 0) {
        unsigned* bar = b.bar;
        __builtin_amdgcn_s_waitcnt(0);
        unsigned nloc = b.st[0], nx = b.st[1];
        if (nloc == 0u) { xcd_barrier_complete(bar, b.x, nloc, nx); b.st[0] = nloc; b.st[1] = nx; }
        const unsigned old = xb_add(&bar[XB_XSUB(b.x)], 1u);
        const unsigned gen = old / nloc;
        if (old + 1u == (gen + 1u) * nloc) {
            __builtin_amdgcn_fence(__ATOMIC_RELEASE, "agent");
            asm volatile("s_waitcnt vmcnt(0)" ::: "memory");
            const unsigned og = xb_add(&bar[XB_TOP], 1u);
            const unsigned tg = og / nx;
            if (og + 1u == (tg + 1u) * nx) xb_add(&bar[XB_TOPGEN], 1u);
            else XB_SPIN(xb_ld(&bar[XB_TOPGEN]) == tg, bar);
            __builtin_amdgcn_fence(__ATOMIC_ACQUIRE, "agent");
            xb_add(&bar[XB_XGEN(b.x)], 1u);
            asm volatile("s_waitcnt vmcnt(0)" ::: "memory");
        } else {
            XB_SPIN(xb_ld(&bar[XB_XGEN(b.x)]) == gen, bar);
            __builtin_amdgcn_fence(__ATOMIC_ACQUIRE, "agent");
            asm volatile("s_waitcnt vmcnt(0)" ::: "memory");
        }
    }
    __syncthreads();
}


struct Args { const float* in[NIN]; float* out; unsigned char* ws; int ph_lo, ph_hi; };
typedef const GAS float* cfp_t; typedef const cfp_t __attribute__((address_space(4)))* InArr;
struct InTab { InArr p; __device__ __forceinline__ const float* operator[](int i) const { return (const float*)p[i]; } };
struct Ctx {
    LAS unsigned char* lds; int tid, lane, wid, G, wg;
    InTab in; float* out; unsigned char* ws;
};
__device__ __forceinline__ float wave_sum(float v) {
#pragma unroll
    for (int o = 1; o < 64; o <<= 1) v += __shfl_xor(v, o);
    return v;
}
__device__ __forceinline__ float wave_max(float v) {
#pragma unroll
    for (int o = 1; o < 64; o <<= 1) v = fmaxf(v, __shfl_xor(v, o));
    return v;
}
__device__ __forceinline__ float bf2f(unsigned short b) { return __uint_as_float(((unsigned)b) << 16); }
__device__ __forceinline__ float bflo(unsigned w) { return __uint_as_float(w << 16); }
__device__ __forceinline__ float bfhi(unsigned w) { return __uint_as_float(w & 0xffff0000u); }
__device__ __forceinline__ unsigned short f2bf(float f) { return (unsigned short)(cvt_pk_bf16(f, 0.f) & 0xffffu); }

__device__ __forceinline__ void transpose_item(const float* W, int ldw, int nvalid, bf16* WT, int ldt, int k0, int n0, int drow0, LAS float* scr, int lane, const float* kg = nullptr) {
    const int nn = lane & 31;
    float wv[32];
#pragma unroll
    for (int i = 0; i < 32; ++i) { const int kk = 2 * i + (lane >> 5); wv[i] = (nn < nvalid) ? W[(size_t)(k0 + kk) * ldw + n0 + nn] : 0.f; }
#pragma unroll
    for (int i = 0; i < 32; ++i) { const int kk = 2 * i + (lane >> 5); scr[kk * 33 + nn] = kg ? wv[i] * kg[k0 + kk] : wv[i]; }
    LDS_WAIT(); asm volatile("" ::: "memory");
    const int c = lane & 7;
#pragma unroll
    for (int j = 0; j < 4; ++j) { const int n = (lane >> 3) + 8 * j; const LAS float* s = scr + (8 * c) * 33 + n;
        u32x4 o; o.x = cvt_pk_bf16(s[0 * 33], s[1 * 33]); o.y = cvt_pk_bf16(s[2 * 33], s[3 * 33]); o.z = cvt_pk_bf16(s[4 * 33], s[5 * 33]); o.w = cvt_pk_bf16(s[6 * 33], s[7 * 33]);
        *(u32x4*)(WT + (size_t)(drow0 + n) * ldt + k0 + 8 * c) = o; }
    LDS_WAIT(); asm volatile("" ::: "memory");
}
constexpr int TI_IN = 32 * 113, TI_GLU = 16 * 32, TI_OUT = 32 * 64, TI_G = 32 * 176, TI_DN = 88 * 64, TI_W1 = 4 * 32 * 4, TI_W2 = 2 * 2 * 4;
constexpr int TI_LAYER = TI_IN + TI_GLU + TI_OUT + 2 * TI_G + TI_DN + TI_W1 + TI_W2;
constexpr int TI_GU_DEF = 2176;
constexpr int TI_IN_DEF = 2048;
__device__ __forceinline__ void weight_item(const Ctx& C, int item, LAS float* scr) {
    const int l = item / TI_LAYER; int r = item % TI_LAYER; unsigned char* ws = C.ws; const int lane = C.lane;
    if (r < TI_IN) { const int kb = r / 113, nb = r % 113, n0 = 32 * nb; const int nv = (INW - n0) < 32 ? (INW - n0) : 32;
        transpose_item(C.in[I_WIN] + (size_t)l * DM * INW, INW, nv, (bf16*)(ws + WS_WIN) + (size_t)l * INWP * DM, DM, 64 * kb, n0, n0, scr, lane, l == 1 ? C.in[I_NMIX] + DM : nullptr); return; } r -= TI_IN;
    if (r < TI_GLU) { const int kb = r / 32, nb = r % 32;
        transpose_item(C.in[I_WGLU] + (size_t)l * 1024 * 1024, 1024, 32, (bf16*)(ws + WS_WGLU) + (size_t)l * 1024 * 1024, 1024, 64 * kb, 32 * nb, 32 * nb, scr, lane); return; } r -= TI_GLU;
    if (r < TI_OUT) { const int kb = r / 64, nb = r % 64;
        transpose_item(C.in[I_WOUT] + (size_t)l * DM * DM, DM, 32, (bf16*)(ws + WS_WOUT) + (size_t)l * DM * DM, DM, 64 * kb, 32 * nb, 32 * nb, scr, lane); return; } r -= TI_OUT;
    if (r < 2 * TI_G) { const int up = r / TI_G; r %= TI_G; const int kb = r / 176, nb = r % 176, n0 = 32 * nb;
        transpose_item(C.in[up ? I_WU : I_WG] + (size_t)l * DM * DFF, DFF, 32, (bf16*)(ws + WS_WGU) + (size_t)l * 2 * DFF * DM, DM, 64 * kb, n0, 256 * (n0 >> 7) + (n0 & 127) + 128 * up, scr, lane, C.in[I_NFFN] + l * DM); return; } r -= 2 * TI_G;
    if (r < TI_DN) { const int kb = r / 64, nb = r % 64;
        transpose_item(C.in[I_WD] + (size_t)l * DFF * DM, DM, 32, (bf16*)(ws + WS_WDN) + (size_t)l * DM * DFF, DFF, 64 * kb, 32 * nb, 32 * nb, scr, lane); return; } r -= TI_DN;
    if (r < TI_W1) { const int which = r / 128, rr = r % 128, kb = rr / 4, nb = rr % 4;
        transpose_item(C.in[which < 2 ? I_W1K : I_W1V] + (size_t)l * 4096 * 128 + (size_t)(which & 1) * 2048 * 128, 128, 32,
                       (bf16*)(ws + WS_W1C) + (size_t)(l * 2 + (which >> 1)) * 256 * 2048, 2048, 64 * kb, 32 * nb, (which & 1) * 128 + 32 * nb, scr, lane); return; } r -= TI_W1;
    { const int which = r / 8, rr = r % 8, kb = rr / 4, nb = rr % 4;
        transpose_item(C.in[which ? I_W2V : I_W2K] + (size_t)l * 128 * 128, 128, 32, (bf16*)(ws + WS_W2T) + (size_t)(l * 2 + which) * 128 * 128, 128, 64 * kb, 32 * nb, 32 * nb, scr, lane); }
}
__device__ __forceinline__ void norm_row_2048(const float* x, const float* g, bf16* o, int lane) {
    f32x4 v[8], gv[8]; float s = 0.f;
#pragma unroll
    for (int j = 0; j < 8; ++j) { v[j] = *(const f32x4*)(x + 4 * lane + 256 * j); gv[j] = *(const f32x4*)(g + 4 * lane + 256 * j); }
#pragma unroll
    for (int j = 0; j < 8; ++j) s += (v[j][0] * v[j][0] + v[j][1] * v[j][1]) + (v[j][2] * v[j][2] + v[j][3] * v[j][3]);
    const float rstd = 1.0f / sqrtf(wave_sum(s) * (1.0f / 2048.0f) + EPS);
#pragma unroll
    for (int j = 0; j < 8; ++j) { const f32x4 gg = gv[j]; u32x2 w; w.x = cvt_pk_bf16(v[j][0] * rstd * gg[0], v[j][1] * rstd * gg[1]); w.y = cvt_pk_bf16(v[j][2] * rstd * gg[2], v[j][3] * rstd * gg[3]);
        *(u32x2*)(o + 4 * lane + 256 * j) = w; }
}
__device__ __forceinline__ void norm_pass(const Ctx& C, const float* xp, const float* xs, const float* g, bf16* XO) {
    const int gw = C.wg * 8 + C.wid, NGW = C.G * 8;
    for (int r = gw; r < MR; r += NGW) norm_row_2048(r < MP ? xp + (size_t)r * DM : xs + (size_t)(r - MP) * DM, g, XO + (size_t)r * DM, C.lane);
}
__device__ __forceinline__ double exp_d(double x) {
    int m = 0; while (fabs(x) > 0.5) { x *= 0.5; ++m; }
    double t = 1.0, s = 1.0;
#pragma unroll
    for (int i = 1; i <= 18; ++i) { t *= x * (1.0 / (double)i); s += t; }
    for (int i = 0; i < m; ++i) s *= s;
    return s;
}
__device__ __forceinline__ void sincos_d(double x, double& sn, double& cs) {
    const double k = rint(x * 0.63661977236758134308);
    double r = fma(-k, 1.57079632679489655800, x); r = fma(-k, 6.12323399573676603587e-17, r);
    const int q = (int)((long long)k & 3ll);
    const double r2 = r * r;
    double sp = 1.0 / 6227020800.0; sp = sp * r2 - 1.0 / 39916800.0; sp = sp * r2 + 1.0 / 362880.0; sp = sp * r2 - 1.0 / 5040.0; sp = sp * r2 + 1.0 / 120.0; sp = sp * r2 - 1.0 / 6.0; sp = sp * r2 + 1.0; sp *= r;
    double cp = -1.0 / 87178291200.0; cp = cp * r2 + 1.0 / 479001600.0; cp = cp * r2 - 1.0 / 3628800.0; cp = cp * r2 + 1.0 / 40320.0; cp = cp * r2 - 1.0 / 720.0; cp = cp * r2 + 1.0 / 24.0; cp = cp * r2 - 0.5; cp = cp * r2 + 1.0;
    sn = (q == 0) ? sp : (q == 1) ? cp : (q == 2) ? -sp : -cp;
    cs = (q == 0) ? cp : (q == 1) ? -sp : (q == 2) ? -cp : sp;
}
__device__ __forceinline__ void ssm_precompute(const Ctx& C, int l, int g) {
    LAS float* lpr = (LAS float*)C.lds;
    LAS float* lpi = lpr + 17 * 64;
    LAS float* Bbr = lpi + 17 * 64;
    LAS float* Bbi = Bbr + 1024;
    LAS float* Ccr = Bbi + 1024;
    LAS float* Cci = Ccr + 1024;
    LAS float* Kt = Cci + 1024;
    LAS float* CTr = Kt + 4096;
    LAS float* CTi = CTr + 1024;
    const int tid = C.tid; const int lg = l * NG + g;
    for (int idx = tid; idx < 17 * 64; idx += 512) { const int tau = idx >> 6, n = idx & 63;
        const double are = (double)C.in[I_ARE][lg * 64 + n], aim = (double)C.in[I_AIM][lg * 64 + n], dt = exp_d((double)C.in[I_LDT][lg]);
        const double mag = exp_d(are * dt * tau), ang = aim * dt * tau; double sn, cs; sincos_d(ang, sn, cs);
        lpr[tau * 64 + n] = (float)(mag * cs); lpi[tau * 64 + n] = (float)(mag * sn); }
    if (tid < 64) { const int n = tid;
        const double are = (double)C.in[I_ARE][lg * 64 + n], aim = (double)C.in[I_AIM][lg * 64 + n], dt = exp_d((double)C.in[I_LDT][lg]);
        f32x4 brv[4], biv[4];
#pragma unroll
        for (int q = 0; q < 4; ++q) { brv[q] = *(const f32x4*)(C.in[I_BRE] + (size_t)(lg * 64 + n) * 16 + 4 * q); biv[q] = *(const f32x4*)(C.in[I_BIM] + (size_t)(lg * 64 + n) * 16 + 4 * q); }
        const double mag = exp_d(are * dt), ang = aim * dt; double sn, cs; sincos_d(ang, sn, cs); const double l1r = mag * cs, l1i = mag * sn;
        const double nr = l1r - 1.0, ni = l1i, den = are * are + aim * aim; const double cfr = (nr * are + ni * aim) / den, cfi = (ni * are - nr * aim) / den;
        float* bb = (float*)(C.ws + WS_BBAR) + (size_t)(lg * 64 + n) * 32;
#pragma unroll
        for (int p = 0; p < 16; ++p) { const double br = (double)brv[p >> 2][p & 3], bi = (double)biv[p >> 2][p & 3];
            const float xr = (float)(cfr * br - cfi * bi), xi = (float)(cfr * bi + cfi * br); Bbr[n * 16 + p] = xr; Bbi[n * 16 + p] = xi; bb[2 * p] = xr; bb[2 * p + 1] = xi; }
        float* o1 = (float*)(C.ws + WS_LAM1) + (size_t)(lg * 64 + n) * 2; o1[0] = (float)l1r; o1[1] = (float)l1i;
        { const double m16 = exp_d(are * dt * 16.0), a16 = aim * dt * 16.0; double s16, c16; sincos_d(a16, s16, c16); float* o16 = (float*)(C.ws + WS_LAM16) + (size_t)(lg * 64 + n) * 2; o16[0] = (float)(m16 * c16); o16[1] = (float)(m16 * s16); }
    }
    for (int i = tid; i < 1024; i += 512) { const float cr = C.in[I_CRE][(size_t)lg * 1024 + i], ci = C.in[I_CIM][(size_t)lg * 1024 + i]; Ccr[i] = cr; Cci[i] = ci; CTr[(i & 63) * 16 + (i >> 6)] = cr; CTi[(i & 63) * 16 + (i >> 6)] = ci; }
    __syncthreads();
    {
        const int tau = tid >> 5, p = (tid >> 1) & 15, h = tid & 1; float s8[8];
#pragma unroll
        for (int j = 0; j < 8; ++j) s8[j] = 0.f;
        for (int n = 0; n < 64; ++n) { const float cr = CTr[n * 16 + p], ci = CTi[n * 16 + p], lr = lpr[tau * 64 + n], li = lpi[tau * 64 + n]; const float wr = cr * lr - ci * li, wi = cr * li + ci * lr;
            const f32x4 b0 = *(const LAS f32x4*)(Bbr + n * 16 + 8 * h), b1 = *(const LAS f32x4*)(Bbr + n * 16 + 8 * h + 4), c0 = *(const LAS f32x4*)(Bbi + n * 16 + 8 * h), c1 = *(const LAS f32x4*)(Bbi + n * 16 + 8 * h + 4);
#pragma unroll
            for (int j = 0; j < 4; ++j) { s8[j] += wr * b0[j] - wi * c0[j]; s8[4 + j] += wr * b1[j] - wi * c1[j]; } }
        const float dsk = C.in[I_D][lg * 16 + p];
#pragma unroll
        for (int j = 0; j < 8; ++j) { if (tau == 0 && p == 8 * h + j) s8[j] += dsk; }
        *(LAS f32x4*)(Kt + (tau << 8) + p * 16 + 8 * h) = (f32x4){s8[0], s8[1], s8[2], s8[3]}; *(LAS f32x4*)(Kt + (tau << 8) + p * 16 + 8 * h + 4) = (f32x4){s8[4], s8[5], s8[6], s8[7]};
    }
    __syncthreads();
    bf16* TG = (bf16*)(C.ws + WS_TG) + (size_t)lg * 65536; bf16* EG = (bf16*)(C.ws + WS_EG) + (size_t)lg * 32768; bf16* FG = (bf16*)(C.ws + WS_FG) + (size_t)lg * 32768;
    for (int i8 = tid; i8 < 8192; i8 += 512) { const int row = i8 >> 5, c8 = i8 & 31, tq = row >> 4, p = row & 15, s = c8 >> 1, pp0 = (c8 & 1) * 8; u32x4 w = (u32x4){0u, 0u, 0u, 0u};
        if (tq >= s) { const LAS float* kp = Kt + ((tq - s) << 8) + p * 16 + pp0; const f32x4 k0 = *(const LAS f32x4*)kp, k1 = *(const LAS f32x4*)(kp + 4);
            w.x = cvt_pk_bf16(k0[0], k0[1]); w.y = cvt_pk_bf16(k0[2], k0[3]); w.z = cvt_pk_bf16(k1[0], k1[1]); w.w = cvt_pk_bf16(k1[2], k1[3]); }
        *(u32x4*)(TG + (size_t)i8 * 8) = w; }
    for (int i8 = tid; i8 < 4096; i8 += 512) { const int n2 = i8 >> 5, c8 = i8 & 31, s = c8 >> 1, pp0 = (c8 & 1) * 8, n = n2 & 63; const int tau = 15 - s;
        const float lr = lpr[tau * 64 + n], li = lpi[tau * 64 + n]; const LAS float* bp = Bbr + n * 16 + pp0; const LAS float* cp = Bbi + n * 16 + pp0;
        const f32x4 b0 = *(const LAS f32x4*)bp, b1 = *(const LAS f32x4*)(bp + 4), c0 = *(const LAS f32x4*)cp, c1 = *(const LAS f32x4*)(cp + 4); float e[8];
#pragma unroll
        for (int j = 0; j < 4; ++j) { e[j] = n2 < 64 ? (lr * b0[j] - li * c0[j]) : (lr * c0[j] + li * b0[j]); e[4 + j] = n2 < 64 ? (lr * b1[j] - li * c1[j]) : (lr * c1[j] + li * b1[j]); }
        u32x4 w; w.x = cvt_pk_bf16(e[0], e[1]); w.y = cvt_pk_bf16(e[2], e[3]); w.z = cvt_pk_bf16(e[4], e[5]); w.w = cvt_pk_bf16(e[6], e[7]);
        *(u32x4*)(EG + (size_t)i8 * 8) = w; }
    for (int i8 = tid; i8 < 4096; i8 += 512) { const int row = i8 >> 4, q0 = (i8 & 15) * 8, n0 = q0 & 63, tq = row >> 4, p = row & 15; const int tau = tq + 1;
        const LAS float* a0 = Ccr + p * 64 + n0; const LAS float* a1 = Cci + p * 64 + n0; const LAS float* a2 = lpr + tau * 64 + n0; const LAS float* a3 = lpi + tau * 64 + n0;
        const f32x4 cr0 = *(const LAS f32x4*)a0, cr1 = *(const LAS f32x4*)(a0 + 4), ci0 = *(const LAS f32x4*)a1, ci1 = *(const LAS f32x4*)(a1 + 4), lr0 = *(const LAS f32x4*)a2, lr1 = *(const LAS f32x4*)(a2 + 4), li0 = *(const LAS f32x4*)a3, li1 = *(const LAS f32x4*)(a3 + 4); float e[8];
#pragma unroll
        for (int j = 0; j < 4; ++j) { e[j] = q0 < 64 ? (cr0[j] * lr0[j] - ci0[j] * li0[j]) : -(cr0[j] * li0[j] + ci0[j] * lr0[j]); e[4 + j] = q0 < 64 ? (cr1[j] * lr1[j] - ci1[j] * li1[j]) : -(cr1[j] * li1[j] + ci1[j] * lr1[j]); }
        u32x4 w; w.x = cvt_pk_bf16(e[0], e[1]); w.y = cvt_pk_bf16(e[2], e[3]); w.z = cvt_pk_bf16(e[4], e[5]); w.w = cvt_pk_bf16(e[6], e[7]);
        *(u32x4*)(FG + (size_t)i8 * 8) = w; }
    __syncthreads();
}
__device__ __forceinline__ void window_copy(const Ctx& C, int part, int nparts) {
    const size_t gt = (size_t)part * 512 + C.tid, NT = (size_t)nparts * 512; const size_t per = 508ull * 512 / 4;
    const float* swin = C.in[I_SWIN];
    for (size_t i0 = gt; i0 < 2ull * SB * per; i0 += 8 * NT) { f32x4 v[8];
#pragma unroll
        for (int k = 0; k < 8; ++k) { const size_t i = i0 + (size_t)k * NT; if (i < 2ull * SB * per) { const size_t ls = i / per, j = i % per; v[k] = *(const f32x4*)(swin + ls * 512 * 512 + 4 * 512 + 4 * j); } }
#pragma unroll
        for (int k = 0; k < 8; ++k) { const size_t i = i0 + (size_t)k * NT; if (i < 2ull * SB * per) { const size_t ls = i / per, j = i % per; *(f32x4*)(C.out + O_WINS + ls * 512 * 512 + 4 * j) = v[k]; } } }
}
__device__ __forceinline__ void p0_prologue(const Ctx& C) {
    const int gw = C.wg * 8 + C.wid, NGW = C.G * 8, lane = C.lane;
    for (int u = C.wg; u < 2 * NG; u += C.G) ssm_precompute(C, u / NG, u % NG);
    __syncthreads();
    LAS float* scr = (LAS float*)(C.lds + C.wid * 16384);
    if (C.G == 256) {
        constexpr int LA = TI_IN - TI_IN_DEF, LB = 2 * TI_G - TI_GU_DEF;
        for (int idx = gw; idx < TI_LAYER + LA + LB + TI_W1 + TI_W2; idx += NGW) { int it = idx;
            if (idx >= TI_LAYER) { const int j = idx - TI_LAYER;
                it = TI_LAYER + (j < LA ? TI_IN_DEF + j : (j < LA + LB ? TI_IN + TI_GLU + TI_OUT + TI_GU_DEF + (j - LA) : TI_IN + TI_GLU + TI_OUT + 2 * TI_G + TI_DN + (j - LA - LB))); }
            weight_item(C, it, scr); }
    } else
    for (int it = gw; it < 2 * TI_LAYER; it += NGW) weight_item(C, it, scr);
    norm_pass(C, C.in[I_XP], C.in[I_XS], C.in[I_NMIX], (bf16*)(C.ws + WS_XN));
    if (C.G != 256) window_copy(C, C.wg, C.G);
}

__device__ __forceinline__ void cmp1_sample_unit(const Ctx& C, int u, int variant = 0) {
    constexpr int BP = 136;
    const int blk = u & 7, kvh = (u >> 3) & 1, sb = (u >> 4) & 7, kv = (u >> 7) & 1, l = u >> 8;
    int tid = C.tid; asm volatile("" : "+v"(tid)); const int lane = tid & 63, wid = C.wid, fr = lane & 15, fq = lane >> 4;
    LAS bf16* Bl = (LAS bf16*)C.lds;
    const bf16* W = (const bf16*)(C.ws + WS_W1C) + (size_t)(l * 2 + kv) * 256 * 2048;
    const int* pt = (const int*)C.in[I_PT];
    const int irow = blk * 128 + 8 * fr + wid;
    const float* rp = C.in[I_CCMP] + ((((size_t)l * NPOOL + pt[sb * 128 + (irow >> 3)]) * 128 + ((16 * irow) & 127)) * 2 + kvh) * 256 + kv * 128 + 8 * fq;
    f32x4 acc[16];
#pragma unroll
    for (int nb = 0; nb < 16; ++nb) acc[nb] = (f32x4){0.f, 0.f, 0.f, 0.f};
    u32x4 breg[8];
#pragma unroll
    for (int j = 0; j < 8; ++j) { const int p = tid + 512 * j; breg[j] = *(const u32x4*)(W + (size_t)(p >> 4) * 2048 + (p & 15) * 8); }
#pragma unroll
    for (int j = 0; j < 8; ++j) { const int p = tid + 512 * j; *(LAS u32x4*)(Bl + (p >> 4) * BP + (p & 15) * 8) = breg[j]; }
    __syncthreads();
    f32x4 arA[4][2], arB[4][2]; bf16x8 acur[4];
#define CMP1_LOADA(S_, r_) do { if (variant != 7) { _Pragma("unroll") for (int ks = 0; ks < 4; ++ks) { const float* p = rp + (size_t)(r_) * 512 + 32 * ks; S_[ks][0] = *(const f32x4*)p; S_[ks][1] = *(const f32x4*)(p + 4); } } } while (0)
#define CMP1_CVTA(S_) do { _Pragma("unroll") for (int ks = 0; ks < 4; ++ks) { const f32x4 v0 = S_[ks][0], v1 = S_[ks][1]; u32x4 w; \
        w.x = cvt_pk_bf16(v0[0], v0[1]); w.y = cvt_pk_bf16(v0[2], v0[3]); w.z = cvt_pk_bf16(v1[0], v1[1]); w.w = cvt_pk_bf16(v1[2], v1[3]); acur[ks] = __builtin_bit_cast(bf16x8, w); } } while (0)
#define CMP1_STEP(r_, SNEXT_, rload_) do { const int buf = (r_) & 1; \
        if ((r_) + 1 < 16 && variant != 8) { _Pragma("unroll") for (int j = 0; j < 8; ++j) { const int p = tid + 512 * j; breg[j] = *(const u32x4*)(W + (size_t)(p >> 4) * 2048 + ((r_) + 1) * 128 + (p & 15) * 8); } } \
        if (variant != 8) { _Pragma("unroll") for (int ks = 0; ks < 4; ++ks) { _Pragma("unroll") for (int nb = 0; nb < 16; ++nb) { \
            const bf16x8 x = *(const LAS bf16x8*)(Bl + (size_t)buf * 256 * BP + (16 * nb + fr) * BP + 32 * ks + 8 * fq); acc[nb] = __builtin_amdgcn_mfma_f32_16x16x32_bf16(x, acur[ks], acc[nb], 0, 0, 0); \
            if ((nb & 7) == 7) asm volatile("" ::: "memory"); } } } \
        if ((r_) + 1 < 16) { _Pragma("unroll") for (int j = 0; j < 8; ++j) { const int p = tid + 512 * j; *(LAS u32x4*)(Bl + (size_t)(buf ^ 1) * 256 * BP + (p >> 4) * BP + (p & 15) * 8) = breg[j]; } \
            CMP1_CVTA(SNEXT_); if ((rload_) < 16) CMP1_LOADA(SNEXT_, (rload_)); } \
        __syncthreads(); } while (0)
    if (variant == 7) { _Pragma("unroll") for (int ks = 0; ks < 4; ++ks) { arA[ks][0] = (f32x4){0.f, 0.f, 0.f, 0.f}; arA[ks][1] = arA[ks][0]; arB[ks][0] = arA[ks][0]; arB[ks][1] = arA[ks][0]; } }
    CMP1_LOADA(arA, 0); CMP1_CVTA(arA); CMP1_LOADA(arA, 1); CMP1_LOADA(arB, 2);
#pragma unroll 1
    for (int r = 0; r < 16; r += 2) {
        CMP1_STEP(r, arA, r + 3);
        CMP1_STEP(r + 1, arB, r + 4);
    }
#undef CMP1_LOADA
#undef CMP1_CVTA
#undef CMP1_STEP
    float* TB = (float*)(C.ws + WS_TBS) + ((size_t)((((l * 2 + kv) * 8 + sb) * 2 + kvh) * 1024) + irow) * 256 + 4 * fq;
#pragma unroll
    for (int nb = 0; nb < 16; ++nb) *(f32x4*)(TB + 16 * nb) = acc[nb];
}
__device__ __forceinline__ void cmp_stage2_unit(const Ctx& C, const float* TB, size_t tb0, int i0, int imax, const float* b1, const bf16* W2t, const float* gain  , bf16* out0) {
    LAS bf16* Hs = (LAS bf16*)C.lds;
    LAS bf16* Ws = Hs + 128 * 136;
    int tid = C.tid; asm volatile("" : "+v"(tid)); const int lane = tid & 63, wid = C.wid, fr = lane & 15, fq = lane >> 4;
    {   const int c4 = (tid & 31) * 4; const f32x4 bb = *(const f32x4*)(b1 + c4);
        f32x4 tp[8], bt[8];
#pragma unroll
        for (int k = 0; k < 8; ++k) { const int i = i0 + (tid >> 5) + 16 * k; const int i1 = (i + 1 < imax) ? i + 1 : imax;
            tp[k] = *(const f32x4*)(TB + (tb0 + (i < imax ? i : imax)) * 256 + c4); bt[k] = *(const f32x4*)(TB + (tb0 + i1) * 256 + 128 + c4); }
#pragma unroll
        for (int k = 0; k < 8; ++k) { const int r = (tid >> 5) + 16 * k; const f32x4 a = tp[k], b = bt[k];
            u32x2 w; w.x = cvt_pk_bf16(gelu_tanh(a[0] + b[0] + bb[0]), gelu_tanh(a[1] + b[1] + bb[1])); w.y = cvt_pk_bf16(gelu_tanh(a[2] + b[2] + bb[2]), gelu_tanh(a[3] + b[3] + bb[3]));
            *(LAS u32x2*)(Hs + r * 136 + c4) = w; } }
    {   u32x4 wv[4];
#pragma unroll
        for (int k = 0; k < 4; ++k) { const int idx = tid + 512 * k; wv[k] = *(const u32x4*)(W2t + (idx >> 4) * 128 + (idx & 15) * 8); }
#pragma unroll
        for (int k = 0; k < 4; ++k) { const int idx = tid + 512 * k; *(LAS u32x4*)(Ws + (idx >> 4) * 136 + (idx & 15) * 8) = wv[k]; } }
    __syncthreads();
    f32x4 acc[8];
#pragma unroll
    for (int n = 0; n < 8; ++n) acc[n] = (f32x4){0.f, 0.f, 0.f, 0.f};
#pragma unroll
    for (int ks = 0; ks < 4; ++ks) { const bf16x8 y = *(const LAS bf16x8*)(Hs + (16 * wid + fr) * 136 + 32 * ks + 8 * fq);
#pragma unroll
        for (int n = 0; n < 8; ++n) { const bf16x8 x = *(const LAS bf16x8*)(Ws + (16 * n + fr) * 136 + 32 * ks + 8 * fq); acc[n] = __builtin_amdgcn_mfma_f32_16x16x32_bf16(x, y, acc[n], 0, 0, 0); } }
    float rstd = 1.f;
    if (gain) { float ss = 0.f;
#pragma unroll
        for (int n = 0; n < 8; ++n) ss += (acc[n][0] * acc[n][0] + acc[n][1] * acc[n][1]) + (acc[n][2] * acc[n][2] + acc[n][3] * acc[n][3]);
        ss += __shfl_xor(ss, 16); ss += __shfl_xor(ss, 32); rstd = 1.0f / sqrtf(ss * (1.0f / 128.0f) + EPS); }
    bf16* orow = out0 + (size_t)(16 * wid + fr) * 128;
    f32x4 ggv[8];
#pragma unroll
    for (int n = 0; n < 8; ++n) ggv[n] = gain ? *(const f32x4*)(gain + 16 * n + 4 * fq) : (f32x4){1.f, 1.f, 1.f, 1.f};
#pragma unroll
    for (int n = 0; n < 8; ++n) { f32x4 v = acc[n] * rstd; if (gain) { v = v * ggv[n]; }
        u32x2 w; w.x = cvt_pk_bf16(v[0], v[1]); w.y = cvt_pk_bf16(v[2], v[3]); *(u32x2*)(orow + 16 * n + 4 * fq) = w; }
    __syncthreads();
}

__device__ __forceinline__ void kvfix_row(const Ctx& C, int l, int row) {
    const int lane = C.lane; const float* src = (const float*)(C.ws + WS_KVRAW) + (size_t)row * 1536 + 2 * lane;
    const float* gs = C.in[I_KNS] + l * 128 + 2 * lane; const float* gwn = C.in[I_KNW] + l * 128 + 2 * lane;
    bf16* KVS = (bf16*)(C.ws + WS_KVS); bf16* KVW = (bf16*)(C.ws + WS_KVW);
    const bool prompt = row < MP; const int b = row >> 11, t = row & 2047, sb = (row - MP) >> 2, st = (row - MP) & 3;
    f32x2 vin[6][2];
#pragma unroll
    for (int part = 0; part < 6; ++part)
#pragma unroll
        for (int kvh = 0; kvh < 2; ++kvh) vin[part][kvh] = *(const f32x2*)(src + part * 256 + kvh * 128);
    const f32x2 ggs = *(const f32x2*)gs, ggw = *(const f32x2*)gwn;
#pragma unroll
    for (int part = 0; part < 6; ++part)
#pragma unroll
        for (int kvh = 0; kvh < 2; ++kvh) {
            f32x2 v = vin[part][kvh]; const int kv = part & 1, br = part >> 1;
            if (part == 2 || part == 4) { const float ss = wave_sum(v[0] * v[0] + v[1] * v[1]); const float rstd = 1.0f / sqrtf(ss * (1.0f / 128.0f) + EPS); const f32x2 gg = (br == 1) ? ggs : ggw; v = v * rstd * gg; }
            const size_t o512 = (size_t)kvh * 256 + kv * 128 + 2 * lane;
            if (prompt) {
                if (br != 0) { bf16* kb = (br == 1 ? KVS : KVW) + ((size_t)((kv * 4 + b) * 2 + kvh) * 2048 + t) * 128 + 2 * lane; *(unsigned*)kb = cvt_pk_bf16(v[0], v[1]); }
                if (br == 0) *(f32x2*)(C.out + O_CMPP + ((size_t)(l * NB + b) * 2048 + t) * 512 + o512) = v;
                else if (br == 1) *(f32x2*)(C.out + O_SLCP + ((size_t)(l * NB + b) * 2048 + t) * 512 + o512) = v;
                else if (t >= 1536) *(f32x2*)(C.out + O_WINP + ((size_t)(l * NB + b) * 512 + (t - 1536)) * 512 + o512) = v;
            } else {
                if (br == 0) *(f32x2*)(C.out + O_CMPS + ((size_t)(l * SB + sb) * 4 + st) * 512 + o512) = v;
                else if (br == 1) *(f32x2*)(C.out + O_SLCS + ((size_t)(l * SB + sb) * 4 + st) * 512 + o512) = v;
                else *(f32x2*)(C.out + O_WINS + ((size_t)(l * SB + sb) * 512 + 508 + st) * 512 + o512) = v;
            }
        }
}
template <int NR>
__device__ __forceinline__ void mixnorm_rows(const Ctx& C, int l, int row0, int rstride, int nvalid) {
    const int lane = C.lane; const float* g1 = C.in[I_NSSM] + l * 1024; const float* g2 = C.in[I_NATT] + l * 1024;
    f32x4 a[NR][4]; u32x2 sw[NR][4];
#pragma unroll
    for (int i = 0; i < NR; ++i) { const int row = row0 + (i < nvalid ? i : 0) * rstride; const bf16* sy = (const bf16*)(C.ws + WS_SSMY) + (size_t)row * 1024; const float* at = (const float*)(C.ws + WS_ATT) + (size_t)row * 1024;
#pragma unroll
        for (int j = 0; j < 4; ++j) { sw[i][j] = *(const u32x2*)(sy + 4 * lane + 256 * j); a[i][j] = *(const f32x4*)(at + 4 * lane + 256 * j); } }
    f32x4 ga[4], gb[4];
#pragma unroll
    for (int j = 0; j < 4; ++j) { ga[j] = *(const f32x4*)(g1 + 4 * lane + 256 * j); gb[j] = *(const f32x4*)(g2 + 4 * lane + 256 * j); }
#pragma unroll
    for (int i = 0; i < NR; ++i) { if (i < nvalid) { const int row = row0 + i * rstride; bf16* H = (bf16*)(C.ws + WS_H) + (size_t)row * DM; f32x4 s[4]; float s1 = 0.f, s2 = 0.f;
#pragma unroll
        for (int j = 0; j < 4; ++j) { const u32x2 w = sw[i][j]; s[j] = (f32x4){bflo(w.x), bfhi(w.x), bflo(w.y), bfhi(w.y)};
            s1 += (s[j][0] * s[j][0] + s[j][1] * s[j][1]) + (s[j][2] * s[j][2] + s[j][3] * s[j][3]); s2 += (a[i][j][0] * a[i][j][0] + a[i][j][1] * a[i][j][1]) + (a[i][j][2] * a[i][j][2] + a[i][j][3] * a[i][j][3]); }
        const float r1 = 1.0f / sqrtf(wave_sum(s1) * (1.0f / 1024.0f) + EPS), r2 = 1.0f / sqrtf(wave_sum(s2) * (1.0f / 1024.0f) + EPS);
#pragma unroll
        for (int j = 0; j < 4; ++j) { u32x2 w; w.x = cvt_pk_bf16(s[j][0] * r1 * ga[j][0], s[j][1] * r1 * ga[j][1]); w.y = cvt_pk_bf16(s[j][2] * r1 * ga[j][2], s[j][3] * r1 * ga[j][3]); *(u32x2*)(H + 4 * lane + 256 * j) = w;
            w.x = cvt_pk_bf16(a[i][j][0] * r2 * gb[j][0], a[i][j][1] * r2 * gb[j][1]); w.y = cvt_pk_bf16(a[i][j][2] * r2 * gb[j][2], a[i][j][3] * r2 * gb[j][3]); *(u32x2*)(H + 1024 + 4 * lane + 256 * j) = w; } } }
}
template <bool BF32, bool OF32>
__device__ __forceinline__ void sample_gemm_res(const Ctx& C, const bf16* A, const bf16* Bt, int K, const void* base, void* out, int first, int stride, float* PSS) {
    LAS f32x4* red = (LAS f32x4*)C.lds;
    const int lane = C.lane, wid = C.wid, fr = lane & 15, fq = lane >> 4, kw = K / 8;
    for (int cb = first; cb < DM / 16; cb += stride) {
        f32x4 acc0 = (f32x4){0.f, 0.f, 0.f, 0.f}, acc1 = acc0;
        const bf16* bp = Bt + (size_t)(16 * cb + fr) * K + wid * kw + 8 * fq; const bf16* ap0 = A + (size_t)fr * K + wid * kw + 8 * fq; const bf16* ap1 = ap0 + (size_t)16 * K;
        int k = 0;
        for (; k + 128 <= kw; k += 128) { bf16x8 x[4], y0[4], y1[4];
#pragma unroll
            for (int j = 0; j < 4; ++j) { x[j] = *(const bf16x8*)(bp + k + 32 * j); y0[j] = *(const bf16x8*)(ap0 + k + 32 * j); y1[j] = *(const bf16x8*)(ap1 + k + 32 * j); }
#pragma unroll
            for (int j = 0; j < 4; ++j) { acc0 = __builtin_amdgcn_mfma_f32_16x16x32_bf16(x[j], y0[j], acc0, 0, 0, 0); acc1 = __builtin_amdgcn_mfma_f32_16x16x32_bf16(x[j], y1[j], acc1, 0, 0, 0); } }
        for (; k < kw; k += 32) { const bf16x8 x = *(const bf16x8*)(bp + k), y0 = *(const bf16x8*)(ap0 + k), y1 = *(const bf16x8*)(ap1 + k);
            acc0 = __builtin_amdgcn_mfma_f32_16x16x32_bf16(x, y0, acc0, 0, 0, 0); acc1 = __builtin_amdgcn_mfma_f32_16x16x32_bf16(x, y1, acc1, 0, 0, 0); }
        red[(wid * 2 + 0) * 64 + lane] = acc0; red[(wid * 2 + 1) * 64 + lane] = acc1;
        __syncthreads();
        if (C.tid < 128) { const int mb = C.tid >> 6; f32x4 s = red[mb * 64 + lane];
#pragma unroll
            for (int w = 1; w < 8; ++w) s = s + red[(w * 2 + mb) * 64 + lane];
            const size_t off = (size_t)(16 * mb + fr) * DM + 16 * cb + 4 * fq; f32x4 b;
            if (BF32) b = *(const f32x4*)((const float*)base + off); else { const u32x2 w = *(const u32x2*)((const bf16*)base + off); b = (f32x4){bflo(w.x), bfhi(w.x), bflo(w.y), bfhi(w.y)}; }
            const f32x4 v = b + s;
            if (OF32) *(f32x4*)((float*)out + off) = v; else { u32x2 w; w.x = cvt_pk_bf16(v[0], v[1]); w.y = cvt_pk_bf16(v[2], v[3]); *(u32x2*)((bf16*)out + off) = w; }
            if (PSS) { float ss = (v[0] * v[0] + v[1] * v[1]) + (v[2] * v[2] + v[3] * v[3]); ss += __shfl_xor(ss, 16); ss += __shfl_xor(ss, 32); if (fq == 0) PSS[(16 * mb + fr) * 128 + cb] = ss; } }
        __syncthreads();
    }
}

__device__ __forceinline__ void ssm_unit(const Ctx& C, int l, int b, int g) {
    constexpr int UP = 264, SP = 132;
    LAS bf16* Ul = (LAS bf16*)C.lds;
    LAS float* Sl = (LAS float*)(C.lds + 128 * UP * 2);
    int tid = C.tid; asm volatile("" : "+v"(tid)); const int lane = tid & 63, wid = C.wid, fr = lane & 15, fq = lane >> 4, lg = l * NG + g;
    const bf16* Ug = (const bf16*)(C.ws + WS_U) + (size_t)(b * NG + g) * 2048 * 16;
    for (int idx = tid; idx < 4096; idx += 512) { const int c = idx >> 5, o = (idx & 31) * 8; *(LAS u32x4*)(Ul + c * UP + o) = *(const u32x4*)(Ug + c * 256 + o); }
    __syncthreads();
    const bf16* EG = (const bf16*)(C.ws + WS_EG) + (size_t)lg * 32768; const bf16* TG = (const bf16*)(C.ws + WS_TG) + (size_t)lg * 65536; const bf16* FG = (const bf16*)(C.ws + WS_FG) + (size_t)lg * 32768;
    bf16x8 tg0[8], tg1[8];
#pragma unroll
    for (int ks = 0; ks < 8; ++ks) { if (ks <= wid) { tg0[ks] = *(const bf16x8*)(TG + (size_t)(32 * wid + fr) * 256 + 32 * ks + 8 * fq); tg1[ks] = *(const bf16x8*)(TG + (size_t)(32 * wid + 16 + fr) * 256 + 32 * ks + 8 * fq); }
                                     else { tg0[ks] = (bf16x8){0, 0, 0, 0, 0, 0, 0, 0}; tg1[ks] = tg0[ks]; } }
    {
        f32x4 acc[8];
#pragma unroll
        for (int nb = 0; nb < 8; ++nb) acc[nb] = (f32x4){0.f, 0.f, 0.f, 0.f};
#pragma unroll
        for (int ks = 0; ks < 8; ++ks) { const bf16x8 x = *(const bf16x8*)(EG + (size_t)(16 * wid + fr) * 256 + 32 * ks + 8 * fq);
#pragma unroll
            for (int nb = 0; nb < 8; ++nb) { const bf16x8 y = *(const LAS bf16x8*)(Ul + (16 * nb + fr) * UP + 32 * ks + 8 * fq); acc[nb] = __builtin_amdgcn_mfma_f32_16x16x32_bf16(x, y, acc[nb], 0, 0, 0); } }
#pragma unroll
        for (int nb = 0; nb < 8; ++nb) *(LAS f32x4*)(Sl + (16 * nb + fr) * SP + 16 * wid + 4 * fq) = acc[nb];
    }
    __syncthreads();
#ifdef DBG_DUMP_S
    { float* dbg = (float*)(C.ws + WS_ATT) + (size_t)((l * 0 + b) * NG + g) * 16384;
      for (int i = tid; i < 16384; i += 512) dbg[i] = Sl[(i >> 7) * SP + (i & 127)];
      __syncthreads(); }
#endif
    if (wid == 0) {
        const float* lm = (const float*)(C.ws + WS_LAM16) + (size_t)(lg * 64 + lane) * 2; const float lr = lm[0], li = lm[1]; float hr = 0.f, hi = 0.f;
#pragma unroll 1
        for (int c0 = 0; c0 < 128; c0 += 8) {
            float sr[8], si[8], pr[8], pi[8];
#pragma unroll
            for (int j = 0; j < 8; ++j) { sr[j] = Sl[(c0 + j) * SP + lane]; si[j] = Sl[(c0 + j) * SP + 64 + lane]; }
            LDS_WAIT();
#pragma unroll
            for (int j = 0; j < 8; ++j) { pr[j] = hr; pi[j] = hi; float nr = __builtin_fmaf(lr, hr, -(li * hi)) + sr[j], ni = __builtin_fmaf(lr, hi, li * hr) + si[j]; asm volatile("" : "+v"(nr), "+v"(ni)); hr = nr; hi = ni; }
#pragma unroll
            for (int j = 0; j < 8; ++j) { Sl[(c0 + j) * SP + lane] = pr[j]; Sl[(c0 + j) * SP + 64 + lane] = pi[j]; }
            LDS_WAIT();
        }
        float* ho = C.out + O_SSMP + ((size_t)(l * NB + b) * NG + g) * 128 + 2 * lane; ho[0] = hr; ho[1] = hi;
#ifdef DBG_DUMP_S
        { float* d2 = (float*)(C.ws + WS_ATT) + 4194304 + ((size_t)(b) * NG + g) * 128 + 2 * lane; d2[0] = hr; d2[1] = hi; }
#endif
    }
    f32x4 ya[2][8];
#pragma unroll
    for (int mb = 0; mb < 2; ++mb)
#pragma unroll
        for (int nb = 0; nb < 8; ++nb) ya[mb][nb] = (f32x4){0.f, 0.f, 0.f, 0.f};
#pragma unroll
    for (int ks = 0; ks < 8; ++ks) { if (ks <= wid) {
#pragma unroll
        for (int nb = 0; nb < 8; ++nb) { const bf16x8 y = *(const LAS bf16x8*)(Ul + (16 * nb + fr) * UP + 32 * ks + 8 * fq);
            ya[0][nb] = __builtin_amdgcn_mfma_f32_16x16x32_bf16(tg0[ks], y, ya[0][nb], 0, 0, 0); ya[1][nb] = __builtin_amdgcn_mfma_f32_16x16x32_bf16(tg1[ks], y, ya[1][nb], 0, 0, 0); } } }
    __syncthreads();
#ifndef DBG_NOCARRY
#pragma unroll
    for (int ks = 0; ks < 4; ++ks) {
        const bf16x8 x0 = *(const bf16x8*)(FG + (size_t)(32 * wid + fr) * 128 + 32 * ks + 8 * fq), x1 = *(const bf16x8*)(FG + (size_t)(32 * wid + 16 + fr) * 128 + 32 * ks + 8 * fq);
#pragma unroll
        for (int nb = 0; nb < 8; ++nb) { const LAS float* hp = Sl + (16 * nb + fr) * SP + 32 * ks + 8 * fq; const f32x4 h0 = *(const LAS f32x4*)hp, h1 = *(const LAS f32x4*)(hp + 4);
            u32x4 w; w.x = cvt_pk_bf16(h0[0], h0[1]); w.y = cvt_pk_bf16(h0[2], h0[3]); w.z = cvt_pk_bf16(h1[0], h1[1]); w.w = cvt_pk_bf16(h1[2], h1[3]); const bf16x8 y = __builtin_bit_cast(bf16x8, w);
            ya[0][nb] = __builtin_amdgcn_mfma_f32_16x16x32_bf16(x0, y, ya[0][nb], 0, 0, 0); ya[1][nb] = __builtin_amdgcn_mfma_f32_16x16x32_bf16(x1, y, ya[1][nb], 0, 0, 0); } }
#endif
    bf16* Z = (bf16*)(C.ws + WS_Z);
#pragma unroll
    for (int mb = 0; mb < 2; ++mb)
#pragma unroll
        for (int nb = 0; nb < 8; ++nb) { const f32x4 y = ya[mb][nb]; u32x2 w; w.x = cvt_pk_bf16(gelu_tanh(y[0]), gelu_tanh(y[1])); w.y = cvt_pk_bf16(gelu_tanh(y[2]), gelu_tanh(y[3]));
            *(u32x2*)(Z + (size_t)(b * 2048 + 16 * (16 * nb + fr) + 2 * wid + mb) * 1024 + 16 * g + 4 * fq) = w; }
    __syncthreads();
}
__device__ __forceinline__ void ssm_sample_item(const Ctx& C, int l, int sb, int g) {
    const int lane = C.lane, lg = l * NG + g;
    const float* lm = (const float*)(C.ws + WS_LAM1) + (size_t)(lg * 64 + lane) * 2; const float lr = lm[0], li = lm[1];
    const float* h0 = C.in[I_SSSM] + (((size_t)(l * SB + sb) * NG + g) * 64 + lane) * 2; float hr = h0[0], hi = h0[1];
    const float* bb = (const float*)(C.ws + WS_BBAR) + (size_t)(lg * 64 + lane) * 32;
    f32x4 bq[8];
#pragma unroll
    for (int j = 0; j < 8; ++j) bq[j] = *(const f32x4*)(bb + 4 * j);
    const float* cre = C.in[I_CRE] + (size_t)lg * 1024 + lane; const float* cim = C.in[I_CIM] + (size_t)lg * 1024 + lane;
    const float dsk = (lane < 16) ? C.in[I_D][lg * 16 + lane] : 0.f;
    bf16* Z = (bf16*)(C.ws + WS_Z);
    float crv[16], civ[16];
#pragma unroll
    for (int p = 0; p < 16; ++p) { crv[p] = cre[p * 64]; civ[p] = cim[p * 64]; }
    for (int st = 0; st < ST; ++st) {
        const bf16* up = (const bf16*)(C.ws + WS_US) + (size_t)(sb * ST + st) * 1024 + 16 * g;
        const u32x4 u0 = *(const u32x4*)up, u1 = *(const u32x4*)(up + 8); float uf[16];
#pragma unroll
        for (int j = 0; j < 4; ++j) { uf[2 * j] = bflo(u0[j]); uf[2 * j + 1] = bfhi(u0[j]); uf[8 + 2 * j] = bflo(u1[j]); uf[8 + 2 * j + 1] = bfhi(u1[j]); }
        float br = 0.f, bi = 0.f;
#pragma unroll
        for (int j = 0; j < 8; ++j) { br += bq[j][0] * uf[2 * j] + bq[j][2] * uf[2 * j + 1]; bi += bq[j][1] * uf[2 * j] + bq[j][3] * uf[2 * j + 1]; }
        const float nr = lr * hr - li * hi + br, ni = lr * hi + li * hr + bi; hr = nr; hi = ni;
        float ymine = 0.f;
#pragma unroll
        for (int p = 0; p < 16; ++p) { const float y = wave_sum(crv[p] * hr - civ[p] * hi); if (lane == p) ymine = y + dsk * uf[p]; }
        if (lane < 16) Z[(size_t)(MP + sb * ST + st) * 1024 + 16 * g + lane] = f2bf(gelu_tanh(ymine));
    }
    float* ho = C.out + O_SSMS + (((size_t)(l * SB + sb) * NG + g) * 64 + lane) * 2; ho[0] = hr; ho[1] = hi;
}

#define KSWZ(row, colB) ((row) * 256 + ((colB) ^ (((row) & 7) << 4)))
#define SBAR() __builtin_amdgcn_sched_barrier(0)
constexpr int AL_V = 0, AL_K = 32768, AL_WS = 65536, AL_PC = 67584, AL_SC = 133120, AL_SM = 141312;
constexpr float CL2 = SM_SCALE * 1.4426950408889634f;
__device__ __forceinline__ int crow(int r, int hi) { return (r & 3) + 8 * (r >> 2) + 4 * hi; }
__device__ __forceinline__ int v_st(int k, int c) { const int kk = (k & ~0xC) | ((k & 4) << 1) | ((k & 8) >> 1); return ((kk >> 3) * 4 + (c >> 5)) * 512 + ((kk & 7) * 32 + (c & 31)) * 2; }
__device__ __forceinline__ int v_rd_base(int lane) { return ((lane & 3) << 3) | (((lane >> 2) & 3) << 6) | (((lane >> 4) & 1) << 5) | (((lane >> 5) & 1) << 8); }
constexpr int v_rd_off(int d0, int ks, int half) { return d0 * 512 + ks * 4096 + half * 2048; }
template <int OFF> __device__ __forceinline__ s16x4 tr_read(int vb) {
    s16x4 r; asm volatile("ds_read_b64_tr_b16 %0, %1 offset:%2" : "=&v"(r) : "v"(vb), "i"(OFF) : "memory"); return r;
}
template <int D0> __device__ __forceinline__ void pv_one(f32x16& od, int vb, bf16x8 pa0, bf16x8 pa1, bf16x8 pa2, bf16x8 pa3) {
    const s16x4 l0 = tr_read<v_rd_off(D0, 0, 0)>(vb), h0 = tr_read<v_rd_off(D0, 0, 1)>(vb), l1 = tr_read<v_rd_off(D0, 1, 0)>(vb), h1 = tr_read<v_rd_off(D0, 1, 1)>(vb);
    const s16x4 l2 = tr_read<v_rd_off(D0, 2, 0)>(vb), h2 = tr_read<v_rd_off(D0, 2, 1)>(vb), l3 = tr_read<v_rd_off(D0, 3, 0)>(vb), h3 = tr_read<v_rd_off(D0, 3, 1)>(vb);
    asm volatile("s_waitcnt lgkmcnt(0)" ::: "memory"); SBAR();
#define PKV(L, H) (bf16x8){L[0], L[1], L[2], L[3], H[0], H[1], H[2], H[3]}
    od = __builtin_amdgcn_mfma_f32_32x32x16_bf16(pa0, PKV(l0, h0), od, 0, 0, 0);
    od = __builtin_amdgcn_mfma_f32_32x32x16_bf16(pa1, PKV(l1, h1), od, 0, 0, 0);
    od = __builtin_amdgcn_mfma_f32_32x32x16_bf16(pa2, PKV(l2, h2), od, 0, 0, 0);
    od = __builtin_amdgcn_mfma_f32_32x32x16_bf16(pa3, PKV(l3, h3), od, 0, 0, 0);
#undef PKV
}
__device__ __forceinline__ void pv_d0(f32x16* o, int vb, bf16x8 pa0, bf16x8 pa1, bf16x8 pa2, bf16x8 pa3) {
    pv_one<0>(o[0], vb, pa0, pa1, pa2, pa3); pv_one<1>(o[1], vb, pa0, pa1, pa2, pa3); pv_one<2>(o[2], vb, pa0, pa1, pa2, pa3); pv_one<3>(o[3], vb, pa0, pa1, pa2, pa3);
}
__device__ __forceinline__ void qkt(f32x16& p0, f32x16& p1, const LAS unsigned char* Ks, const bf16x8* qr, int r32, int hi) {
    p0 = f32x16{}; p1 = f32x16{};
#pragma unroll
    for (int d0 = 0; d0 < 8; ++d0) { const int cb = (d0 * 16 + hi * 8) * 2;
        const bf16x8 b0 = *(const LAS bf16x8*)(Ks + KSWZ(r32, cb)); const bf16x8 b1 = *(const LAS bf16x8*)(Ks + KSWZ(32 + r32, cb));
        p0 = __builtin_amdgcn_mfma_f32_32x32x16_bf16(b0, qr[d0], p0, 0, 0, 0); p1 = __builtin_amdgcn_mfma_f32_32x32x16_bf16(b1, qr[d0], p1, 0, 0, 0); }
}
__device__ __forceinline__ float softmax_tile(f32x16& p0, f32x16& p1, float bc, float a2, int mode, int lim, int hi_in, float& m_reg, float& l_reg, bf16x8& pa0, bf16x8& pa1, bf16x8& pa2, bf16x8& pa3) {
    const float ninf = -__builtin_inff();
    int hi = hi_in; asm volatile("" : "+v"(lim), "+v"(hi));
    const float a2l = a2 + bc * (float)(4 * hi);
#pragma unroll
    for (int r = 0; r < 16; ++r) { const float cr = (float)((r & 3) + 8 * (r >> 2)); p0[r] = fmaf(bc, cr, p0[r]); p1[r] = fmaf(bc, cr, p1[r]); }
    if (mode != 0) {
#pragma unroll
        for (int r = 0; r < 16; ++r) { const int kk = (r & 3) + 8 * (r >> 2) + 4 * hi; const bool v0 = (mode == 1) ? (kk <= lim) : (kk > lim), v1 = (mode == 1) ? (kk + 32 <= lim) : (kk + 32 > lim);
            p0[r] = v0 ? p0[r] : ninf; p1[r] = v1 ? p1[r] : ninf; }
    }
    float m0 = p0[0], m1 = p1[0];
#pragma unroll
    for (int r = 1; r < 16; ++r) { m0 = fmaxf(m0, p0[r]); m1 = fmaxf(m1, p1[r]); }
    float pm = fmaxf(m0 + a2l, m1 + (a2l + 32.f * bc));
    { auto rr = __builtin_amdgcn_permlane32_swap(__float_as_uint(pm), __float_as_uint(pm), false, false); pm = fmaxf(__uint_as_float(rr[0]), __uint_as_float(rr[1])); }
    const float mn = fmaxf(m_reg, pm); const float alpha = __builtin_amdgcn_exp2f((m_reg - mn) * CL2); m_reg = mn;
    const float o0 = (a2l - mn) * CL2, o1 = (a2l + 32.f * bc - mn) * CL2;
#pragma unroll
    for (int r = 0; r < 16; ++r) { p0[r] = __builtin_amdgcn_exp2f(fmaf(p0[r], CL2, o0)); p1[r] = __builtin_amdgcn_exp2f(fmaf(p1[r], CL2, o1)); }
    float ps = 0.f;
#pragma unroll
    for (int r = 0; r < 16; ++r) ps += p0[r] + p1[r];
    { auto rr = __builtin_amdgcn_permlane32_swap(__float_as_uint(ps), __float_as_uint(ps), false, false); ps = __uint_as_float(rr[0]) + __uint_as_float(rr[1]); }
    l_reg = l_reg * alpha + ps;
#define PK4(P, BASE, OUT) do { unsigned a0 = cvt_pk_bf16(P[BASE + 0], P[BASE + 1]), a1 = cvt_pk_bf16(P[BASE + 2], P[BASE + 3]);   \
    unsigned b0 = cvt_pk_bf16(P[BASE + 4], P[BASE + 5]), b1 = cvt_pk_bf16(P[BASE + 6], P[BASE + 7]);                              \
    auto r0 = __builtin_amdgcn_permlane32_swap(a0, b0, false, false); auto r1 = __builtin_amdgcn_permlane32_swap(a1, b1, false, false); \
    u32x4 w = {r0[0], r1[0], r0[1], r1[1]}; OUT = __builtin_bit_cast(bf16x8, w); } while (0)
    PK4(p0, 0, pa0); PK4(p0, 8, pa1); PK4(p1, 0, pa2); PK4(p1, 8, pa3);
#undef PK4
    return alpha;
}
struct AttnSt { bf16x8 v0, v1, k0, k1; };
#define ATT_SLOAD(S, Kp, Vp, krow) do { (S).v0 = *(const bf16x8*)((Vp) + (size_t)((krow) + sr) * 128 + sc); (S).v1 = *(const bf16x8*)((Vp) + (size_t)((krow) + 32 + sr) * 128 + sc); \
    (S).k0 = *(const bf16x8*)((Kp) + (size_t)((krow) + sr) * 128 + sc); (S).k1 = *(const bf16x8*)((Kp) + (size_t)((krow) + 32 + sr) * 128 + sc); } while (0)
#define ATT_SWRITE(S, b) do { *(LAS bf16x8*)(lds + AL_V + (b) * 16384 + vst0) = (S).v0; *(LAS bf16x8*)(lds + AL_V + (b) * 16384 + vst1) = (S).v1; \
    *(LAS bf16x8*)(lds + AL_K + (b) * 16384 + KSWZ(sr, sc * 2)) = (S).k0; *(LAS bf16x8*)(lds + AL_K + (b) * 16384 + KSWZ(32 + sr, sc * 2)) = (S).k1; } while (0)
#define ATT_RESC(a) do { if (__any((a) < 1.f)) { if (hi == 0) al_l[r32] = (a); LDS_WAIT(); int hf = hi; asm volatile("" : "+v"(hf)); \
    _Pragma("unroll") for (int r = 0; r < 16; ++r) { const float f = al_l[crow(r, hf)]; _Pragma("unroll") for (int d = 0; d < 4; ++d) o[d][r] *= f; } } } while (0)
#define ATT_FINAL(gate_, first_) do { const float scl = (gate_) / fmaxf(l_reg, 1e-30f); if (hi == 0) li_l[r32] = scl; LDS_WAIT(); \
    int hf = hi, rf = r32; asm volatile("" : "+v"(hf), "+v"(rf)); \
    _Pragma("unroll") for (int rg = 0; rg < 4; ++rg) { \
    _Pragma("unroll") for (int r2 = 0; r2 < 4; ++r2) { const int r = 4 * rg + r2; const float f = li_l[crow(r, hf)]; float* op = ATTw + (size_t)crow(r, hf) * 1024 + rf; \
        _Pragma("unroll") for (int d = 0; d < 4; ++d) { const float val = o[d][r] * f; op[32 * d] = (first_) ? val : op[32 * d] + val; } } \
    if (rg & 1) asm volatile("" ::: "memory"); } } while (0)

__device__ __forceinline__ void attn_prompt_unit(const Ctx& C, int l, int b, int kvh, int qb) {
    LAS unsigned char* lds = C.lds;
    int lane = C.lane; asm volatile("" : "+v"(lane));
    const int tid = C.tid, wid = C.wid, r32 = lane & 31, hi = lane >> 5;
    const int head = kvh * 4 + (wid >> 1), qloc = 32 * (wid & 1) + r32, t = 64 * qb + qloc, row = b * 2048 + t;
    LAS float* al_l = (LAS float*)(lds + AL_WS) + wid * 64; LAS float* li_l = al_l + 32;
    LAS _Float16* Pst = (LAS _Float16*)(lds + AL_PC); LAS float* Sc = (LAS float*)(lds + AL_SC); LAS unsigned* Sm = (LAS unsigned*)(lds + AL_SM);
    const float slope = __builtin_amdgcn_exp2f(-(float)(head + 1)), bck = slope * (1.0f / SM_SCALE);
    bf16x8 qr[8];
    {   const bf16* Qp = (const bf16*)(C.ws + WS_Q) + (size_t)row * 1024 + head * 128 + hi * 8; const float* qg = C.in[I_QN] + l * 128 + hi * 8;
        u32x4 raw[8]; float ss = 0.f;
#pragma unroll
        for (int d0 = 0; d0 < 8; ++d0) { raw[d0] = *(const u32x4*)(Qp + d0 * 16);
#pragma unroll
            for (int j = 0; j < 4; ++j) { const float a = bflo(raw[d0][j]), c = bfhi(raw[d0][j]); ss += a * a + c * c; } }
        ss += __shfl_xor(ss, 32); const float rstd = 1.0f / sqrtf(ss * (1.0f / 128.0f) + EPS);
#pragma unroll
        for (int d0 = 0; d0 < 8; ++d0) { const f32x4 g0 = *(const f32x4*)(qg + d0 * 16), g1 = *(const f32x4*)(qg + d0 * 16 + 4); u32x4 w;
            w.x = cvt_pk_bf16(bflo(raw[d0][0]) * rstd * g0[0], bfhi(raw[d0][0]) * rstd * g0[1]); w.y = cvt_pk_bf16(bflo(raw[d0][1]) * rstd * g0[2], bfhi(raw[d0][1]) * rstd * g0[3]);
            w.z = cvt_pk_bf16(bflo(raw[d0][2]) * rstd * g1[0], bfhi(raw[d0][2]) * rstd * g1[1]); w.w = cvt_pk_bf16(bflo(raw[d0][3]) * rstd * g1[2], bfhi(raw[d0][3]) * rstd * g1[3]);
            qr[d0] = __builtin_bit_cast(bf16x8, w); } }
    const float* grow = (const float*)(C.ws + WS_GT) + (size_t)row * 32 + head * 3;
    const float g_cmp = grow[0], g_slc = grow[1], g_win = grow[2];
    float* ATTw = (float*)(C.ws + WS_ATT) + (size_t)(b * 2048 + 64 * qb + 32 * (wid & 1)) * 1024 + head * 128;
    const int sr = tid >> 4, sc = (tid & 15) * 8, vst0 = v_st(sr, sc), vst1 = v_st(32 + sr, sc);
    const int vb0 = (int)(uintptr_t)(lds + AL_V) + v_rd_base(lane);
    if (tid < 64) Sm[tid] = 0u;
    f32x16 o[4]; float m_reg, l_reg; bf16x8 pa0, pa1, pa2, pa3; AttnSt stg;
    {   const bf16* Kp = (const bf16*)(C.ws + WS_CKVP) + (size_t)((0 * 4 + b) * 2 + kvh) * 128 * 128; const bf16* Vp = (const bf16*)(C.ws + WS_CKVP) + (size_t)((1 * 4 + b) * 2 + kvh) * 128 * 128;
        ATT_SLOAD(stg, Kp, Vp, 0); ATT_SWRITE(stg, 0); ATT_SLOAD(stg, Kp, Vp, 64); ATT_SWRITE(stg, 1);
        __syncthreads();
        m_reg = -1e30f; l_reg = 0.f;
        const int cmax = (t - 31) >> 4; const float bcc = 16.f * bck;
        {   f32x16 pA0, pA1, pB0, pB1; bf16x8 pb0, pb1, pb2, pb3;
            qkt(pA0, pA1, lds + AL_K, qr, r32, hi);
            (void)softmax_tile(pA0, pA1, bcc, 0.f, 1, cmax, hi, m_reg, l_reg, pa0, pa1, pa2, pa3);
            qkt(pB0, pB1, lds + AL_K + 16384, qr, r32, hi);
            const float al1 = softmax_tile(pB0, pB1, bcc, 64.f * bcc, 1, cmax - 64, hi, m_reg, l_reg, pb0, pb1, pb2, pb3);
            const float il = 1.0f / fmaxf(l_reg, 1e-30f), ia = al1 * il;
            LAS _Float16* prow = Pst + ((wid >> 1) * 64 + qloc) * 128;
#pragma unroll
            for (int r = 0; r < 16; ++r) { const int kk = crow(r, hi);
                prow[kk] = (_Float16)(pA0[r] * ia); prow[32 + kk] = (_Float16)(pA1[r] * ia); prow[64 + kk] = (_Float16)(pB0[r] * il); prow[96 + kk] = (_Float16)(pB1[r] * il); }
#pragma unroll
            for (int d = 0; d < 4; ++d) o[d] = f32x16{};
            pv_d0(o, vb0, pa0, pa1, pa2, pa3);
            ATT_RESC(al1);
            pv_d0(o, vb0 + 16384, pb0, pb1, pb2, pb3);
        }
        ATT_FINAL(g_cmp, true);
    }
    __syncthreads();
    {   int tid2 = tid; asm volatile("" : "+v"(tid2)); const int qi = tid2 >> 3, sub = tid2 & 7; const LAS _Float16* pq = Pst + qi * 128;
        float pc[17];
#pragma unroll
        for (int i = 0; i < 17; ++i) { const int c = 16 * sub - 1 + i; float v = 0.f; if (c >= 0) v = ((float)pq[c] + (float)pq[64 * 128 + c]) + ((float)pq[2 * 64 * 128 + c] + (float)pq[3 * 64 * 128 + c]); pc[i] = v; }
#pragma unroll
        for (int jj = 0; jj < 4; ++jj) { const int j = 4 * sub + jj; Sc[qi * 32 + j] = pc[4 * jj] + 2.f * (pc[4 * jj + 1] + pc[4 * jj + 2] + pc[4 * jj + 3]) + pc[4 * jj + 4]; }
        __syncthreads();
        if (qb >= 16) {
            for (int jj = 0; jj < 4; ++jj) { const int j = 4 * sub + jj; bool sel;
                if (j == 0 || j == qb || j == qb - 1) sel = true; else if (j > qb) sel = false;
                else { const float v = Sc[qi * 32 + j]; int rank = 0; for (int jp = 1; jp <= qb - 2; ++jp) { const float vp = Sc[qi * 32 + jp]; rank += (vp > v || (vp == v && jp < j)) ? 1 : 0; } sel = rank < 13; }
                if (sel) __hip_atomic_fetch_or(Sm + qi, 1u << j, __ATOMIC_RELAXED, __HIP_MEMORY_SCOPE_WORKGROUP); }
        } else if (sub == 0) Sm[qi] = (2u << qb) - 1u;
        __syncthreads();
    }
    const unsigned rowmask = Sm[qloc];
    const float ninf = -__builtin_inff();
    {   const bf16* Kp = (const bf16*)(C.ws + WS_KVS) + (size_t)((0 * 4 + b) * 2 + kvh) * 2048 * 128; const bf16* Vp = (const bf16*)(C.ws + WS_KVS) + (size_t)((1 * 4 + b) * 2 + kvh) * 2048 * 128;
#pragma unroll
        for (int d = 0; d < 4; ++d) o[d] = f32x16{};
        m_reg = -1e30f; l_reg = 0.f;
        ATT_SLOAD(stg, Kp, Vp, 64 * qb); ATT_SWRITE(stg, 0); __syncthreads();
        for (int j = qb; j >= 0; --j) { const int bf = (qb - j) & 1;
            if (j > 0) ATT_SLOAD(stg, Kp, Vp, 64 * (j - 1));
            if (__any((rowmask >> j) & 1u)) {
                f32x16 p0, p1; qkt(p0, p1, lds + AL_K + bf * 16384, qr, r32, hi);
                const float a2 = ((rowmask >> j) & 1u) ? bck * (float)(64 * (j - qb)) : ninf;
                const float al = softmax_tile(p0, p1, bck, a2, (j == qb) ? 1 : 0, qloc, hi, m_reg, l_reg, pa0, pa1, pa2, pa3);
                ATT_RESC(al);
                pv_d0(o, vb0 + bf * 16384, pa0, pa1, pa2, pa3); }
            if (j > 0) ATT_SWRITE(stg, bf ^ 1);
            __syncthreads(); }
        ATT_FINAL(g_slc, false);
    }
    {   const bf16* Kp = (const bf16*)(C.ws + WS_KVW) + (size_t)((0 * 4 + b) * 2 + kvh) * 2048 * 128; const bf16* Vp = (const bf16*)(C.ws + WS_KVW) + (size_t)((1 * 4 + b) * 2 + kvh) * 2048 * 128;
#pragma unroll
        for (int d = 0; d < 4; ++d) o[d] = f32x16{};
        m_reg = -1e30f; l_reg = 0.f;
        const int jlo = qb > 8 ? qb - 8 : 0;
        ATT_SLOAD(stg, Kp, Vp, 64 * qb); ATT_SWRITE(stg, 0); __syncthreads();
        for (int j = qb; j >= jlo; --j) { const int bf = (qb - j) & 1;
            if (j > jlo) ATT_SLOAD(stg, Kp, Vp, 64 * (j - 1));
            f32x16 p0, p1; qkt(p0, p1, lds + AL_K + bf * 16384, qr, r32, hi);
            const int mode = (j == qb) ? 1 : ((j == qb - 8) ? 2 : 0);
            const float al = softmax_tile(p0, p1, bck, bck * (float)(64 * (j - qb)), mode, qloc, hi, m_reg, l_reg, pa0, pa1, pa2, pa3);
            ATT_RESC(al);
            pv_d0(o, vb0 + bf * 16384, pa0, pa1, pa2, pa3);
            if (j > jlo) ATT_SWRITE(stg, bf ^ 1);
            __syncthreads(); }
        ATT_FINAL(g_win, false);
    }
    __syncthreads();
}

constexpr int SA_SCP = 2576;
constexpr int SA_Q = 0, SA_SC = 2048, SA_PC = SA_SC + 4 * SA_SCP * 4, SA_BS = SA_PC + 4096, SA_RED = SA_BS + 1088, SA_SEL = SA_RED + 128, SA_KOFF = SA_SEL + 64, SA_PV = SA_KOFF + 8192, SA_END = SA_PV + 8 * 4 * 128 * 4;
static_assert(SA_END <= MISC_OFF, "sample attention LDS map");
__device__ __forceinline__ void dot4_f32(const float* k, const LAS float* qs, float (&s)[4]) {
    s[0] = s[1] = s[2] = s[3] = 0.f;
#pragma unroll 8
    for (int d = 0; d < 128; d += 4) { const f32x4 kv = *(const f32x4*)(k + d);
#pragma unroll
        for (int h = 0; h < 4; ++h) { const f32x4 q = *(const LAS f32x4*)(qs + h * 128 + d); s[h] += (kv[0] * q[0] + kv[1] * q[1]) + (kv[2] * q[2] + kv[3] * q[3]); } }
}
__device__ __forceinline__ void dot4_bf16(const bf16* k, const LAS float* qs, float (&s)[4]) {
    s[0] = s[1] = s[2] = s[3] = 0.f;
#pragma unroll 8
    for (int d = 0; d < 128; d += 8) { const u32x4 kw = *(const u32x4*)(k + d); float kf[8];
#pragma unroll
        for (int j = 0; j < 4; ++j) { kf[2 * j] = bflo(kw[j]); kf[2 * j + 1] = bfhi(kw[j]); }
#pragma unroll
        for (int h = 0; h < 4; ++h) { const f32x4 q0 = *(const LAS f32x4*)(qs + h * 128 + d), q1 = *(const LAS f32x4*)(qs + h * 128 + d + 4);
            s[h] += (kf[0] * q0[0] + kf[1] * q0[1]) + (kf[2] * q0[2] + kf[3] * q0[3]) + (kf[4] * q1[0] + kf[5] * q1[1]) + (kf[6] * q1[2] + kf[7] * q1[3]); } }
}
__device__ __forceinline__ void sample_softmax(int wid, int lane, LAS float* sc, LAS float* red, int n) {
    const int h = wid >> 1, c0 = (wid & 1) * 64 + lane; LAS float* row = sc + h * SA_SCP;
    float mx = -__builtin_inff(); for (int c = c0; c < n; c += 128) mx = fmaxf(mx, row[c]);
    mx = wave_max(mx); if (lane == 0) red[wid] = mx;
    __syncthreads();
    float m = fmaxf(red[2 * h], red[2 * h + 1]); if (!(m > -1e37f)) m = 0.f;
    float sm = 0.f; for (int c = c0; c < n; c += 128) { const float e = __builtin_amdgcn_exp2f((row[c] - m) * 1.4426950408889634f); row[c] = e; sm += e; }
    sm = wave_sum(sm); if (lane == 0) red[8 + wid] = sm;
    __syncthreads();
    const float inv = 1.0f / fmaxf(red[8 + 2 * h] + red[8 + 2 * h + 1], 1e-37f);
    for (int c = c0; c < n; c += 128) row[c] *= inv;
    __syncthreads();
}
__device__ __forceinline__ void attn_sample_unit(const Ctx& C, int l, int sb, int kvh, int st) {
    LAS unsigned char* lds = C.lds; int tid = C.tid; asm volatile("" : "+v"(tid)); const int lane = tid & 63, wid = C.wid;
    LAS float* qs = (LAS float*)(lds + SA_Q); LAS float* sc = (LAS float*)(lds + SA_SC); LAS float* pc = (LAS float*)(lds + SA_PC); LAS float* bs = (LAS float*)(lds + SA_BS);
    LAS float* red = (LAS float*)(lds + SA_RED); LAS int* selj = (LAS int*)(lds + SA_SEL); LAS unsigned long long* koff = (LAS unsigned long long*)(lds + SA_KOFF); LAS float* pvr = (LAS float*)(lds + SA_PV);
    const int pos = PAST + st, row = MP + sb * ST + st; const int* pt = (const int*)C.in[I_PT];
    if (wid < 4) { const int h = wid; const unsigned w = *(const unsigned*)((const bf16*)(C.ws + WS_Q) + (size_t)row * 1024 + (kvh * 4 + h) * 128 + 2 * lane); const float x0 = bflo(w), x1 = bfhi(w);
        const float rstd = 1.0f / sqrtf(wave_sum(x0 * x0 + x1 * x1) * (1.0f / 128.0f) + EPS); const f32x2 g = *(const f32x2*)(C.in[I_QN] + l * 128 + 2 * lane);
        qs[h * 128 + 2 * lane] = x0 * rstd * g[0]; qs[h * 128 + 2 * lane + 1] = x1 * rstd * g[1]; }
    __syncthreads();
    float slope[4];
#pragma unroll
    for (int h = 0; h < 4; ++h) slope[h] = __builtin_amdgcn_exp2f(-(float)(kvh * 4 + h + 1));
    const bf16* CK = (const bf16*)(C.ws + WS_CKVS) + (size_t)(((l * 2 + 0) * 8 + sb) * 2 + kvh) * 1024 * 128; const bf16* CV = (const bf16*)(C.ws + WS_CKVS) + (size_t)(((l * 2 + 1) * 8 + sb) * 2 + kvh) * 1024 * 128;
    const float* WB = C.in[I_SWIN] + ((((size_t)l * SB + sb) * 512) * 2 + kvh) * 256;
    const float* WN = C.out + O_WINS + ((((size_t)l * SB + sb) * 512 + 508) * 2 + kvh) * 256;
    for (int c = tid; c < 1023; c += 512) { float s[4]; dot4_bf16(CK + (size_t)c * 128, qs, s); const float dist = (float)(pos - 16 * c) - 15.5f;
#pragma unroll
        for (int h = 0; h < 4; ++h) sc[h * SA_SCP + c] = s[h] * SM_SCALE - slope[h] * dist; }
    __syncthreads();
    sample_softmax(wid, lane, sc, red, 1023);
    for (int c = tid; c < 1024; c += 512) pc[c] = (c < 1023) ? (sc[c] + sc[SA_SCP + c]) + (sc[2 * SA_SCP + c] + sc[3 * SA_SCP + c]) : 0.f;
    __syncthreads();
    for (int j = tid; j < 257; j += 512) { float s = 0.f; if (j < 256) s = 2.f * (pc[4 * j] + pc[4 * j + 1] + pc[4 * j + 2]) + pc[4 * j + 3]; if (j > 0) s += pc[4 * j - 1]; bs[j] = s; }
    if (tid == 0) { selj[0] = 0; selj[1] = 255; selj[2] = 256; }
    __syncthreads();
    if (tid < 254) { const int j = tid + 1; const float v = bs[j]; int rank = 0; for (int jp = 1; jp <= 254; ++jp) { const float vp = bs[jp]; rank += (vp > v || (vp == v && jp < j)) ? 1 : 0; } if (rank < 13) selj[3 + rank] = j; }
    __syncthreads();
    for (int idx = tid; idx < 1024 + 516; idx += 512) {
        const float* base; bool valid = true; int kpos;
        if (idx < 1024) { const int j = selj[idx >> 6], r = idx & 63; kpos = 64 * j + r;
            if (j < 256) { const int page = pt[sb * 128 + (j >> 1)]; base = C.in[I_CSLC] + ((((size_t)l * NPOOL + page) * 128 + (j & 1) * 64 + r) * 2 + kvh) * 256; }
            else { valid = (r <= st); base = C.out + O_SLCS + ((((size_t)l * SB + sb) * 4 + (r < 4 ? r : 0)) * 2 + kvh) * 256; }
            koff[idx] = (unsigned long long)(uintptr_t)base;
        } else { const int i = idx - 1024;
            if (i < 512) { base = WB + (size_t)i * 512; valid = i > st; kpos = PAST - 512 + i; } else { const int r = i - 512; base = WN + (size_t)r * 512; valid = r <= st; kpos = PAST + r; } }
        float s[4]; dot4_f32(base, qs, s); const float dist = (float)(pos - kpos);
#pragma unroll
        for (int h = 0; h < 4; ++h) sc[h * SA_SCP + 1024 + idx] = valid ? (s[h] * SM_SCALE - slope[h] * dist) : -__builtin_inff(); }
    __syncthreads();
    sample_softmax(wid, lane, sc + 1024, red, 1024);
    sample_softmax(wid, lane, sc + 2048, red, 516);
    float acc[3][4][2];
#pragma unroll
    for (int b3 = 0; b3 < 3; ++b3)
#pragma unroll
        for (int h = 0; h < 4; ++h) { acc[b3][h][0] = 0.f; acc[b3][h][1] = 0.f; }
    {
        const bf16* vp = CV + 2 * lane;
#pragma unroll 1
        for (int i0 = 0; i0 < 128; i0 += 16) { unsigned v[16];
#pragma unroll
            for (int j = 0; j < 16; ++j) { const int c = wid + 8 * (i0 + j); v[j] = *(const unsigned*)(vp + (size_t)(c < 1023 ? c : 1022) * 128); }
#pragma unroll
            for (int j = 0; j < 16; ++j) { const int c = wid + 8 * (i0 + j); const float v0 = (c < 1023) ? bflo(v[j]) : 0.f, v1 = (c < 1023) ? bfhi(v[j]) : 0.f;
#pragma unroll
                for (int h = 0; h < 4; ++h) { const float p = sc[h * SA_SCP + (c < 1023 ? c : 1022)]; acc[0][h][0] += p * v0; acc[0][h][1] += p * v1; } } }
    }
    {
#pragma unroll 1
        for (int i0 = 0; i0 < 128; i0 += 16) { f32x2 v[16];
#pragma unroll
            for (int j = 0; j < 16; ++j) { const int k = wid + 8 * (i0 + j); v[j] = *(const GAS f32x2*)((const GAS float*)(uintptr_t)koff[k] + 128 + 2 * lane); }
#pragma unroll
            for (int j = 0; j < 16; ++j) { const int k = wid + 8 * (i0 + j);
#pragma unroll
                for (int h = 0; h < 4; ++h) { const float p = sc[h * SA_SCP + 1024 + k]; acc[1][h][0] += p * v[j][0]; acc[1][h][1] += p * v[j][1]; } } }
    }
    {
#pragma unroll 1
        for (int i0 = 0; i0 < 65; i0 += 13) { f32x2 v[13];
#pragma unroll
            for (int j = 0; j < 13; ++j) { const int i = wid + 8 * (i0 + j); const int ic = i < 516 ? i : 515; const float* p = (ic < 512) ? WB + (size_t)ic * 512 : WN + (size_t)(ic - 512) * 512; v[j] = *(const f32x2*)(p + 128 + 2 * lane); }
#pragma unroll
            for (int j = 0; j < 13; ++j) { const int i = wid + 8 * (i0 + j); const int ic = i < 516 ? i : 515; const float m = i < 516 ? 1.f : 0.f;
#pragma unroll
                for (int h = 0; h < 4; ++h) { const float p = sc[h * SA_SCP + 2048 + ic] * m; acc[2][h][0] += p * v[j][0]; acc[2][h][1] += p * v[j][1]; } } }
    }
    const float* grow = (const float*)(C.ws + WS_GT) + (size_t)row * 32 + kvh * 12;
#pragma unroll
    for (int h = 0; h < 4; ++h) { const float g0 = grow[h * 3], g1 = grow[h * 3 + 1], g2 = grow[h * 3 + 2];
        *(LAS f32x2*)(pvr + (wid * 4 + h) * 128 + 2 * lane) = (f32x2){g0 * acc[0][h][0] + g1 * acc[1][h][0] + g2 * acc[2][h][0], g0 * acc[0][h][1] + g1 * acc[1][h][1] + g2 * acc[2][h][1]}; }
    __syncthreads();
    { float t = 0.f;
#pragma unroll
      for (int w = 0; w < 8; ++w) t += pvr[w * 512 + tid];
      ((float*)(C.ws + WS_ATT))[(size_t)row * 1024 + kvh * 512 + tid] = t; }
    __syncthreads();
}
template <class Sched>
__device__ __forceinline__ void prenorm_prologue(const Ctx& C, const Sched& S, const float* PS, const float* PSS) {
    LAS float* RS = (LAS float*)(C.lds + LDS_RS);
    const int rr = C.tid >> 1, half = C.tid & 1;
    int pms[8];
#pragma unroll
    for (int i = 0; i < 8; ++i) { pg8::Unit u; pms[i] = S.next(i, u) ? u.pm : -1; }
#pragma unroll 4
    for (int i = 0; i < 8; ++i) { if (pms[i] >= 0) { float rs = 1.0f;
        if (PS) { const int grow = pms[i] * 256 + rr;
            if (grow < MP) { const float* p = PS + (size_t)grow * 32 + half * 16; float s = 0.f;
#pragma unroll
                for (int k = 0; k < 4; ++k) { const f32x4 v = *(const f32x4*)(p + 4 * k); s += (v[0] + v[1]) + (v[2] + v[3]); }
                s += __shfl_xor(s, 1); rs = 1.0f / sqrtf(s * (1.0f / 2048.0f) + EPS); }
            else if (grow < MR) { const float* p = PSS + (size_t)(grow - MP) * 128 + half * 64; float s = 0.f;
#pragma unroll
                for (int k = 0; k < 16; ++k) { const f32x4 v = *(const f32x4*)(p + 4 * k); s += (v[0] + v[1]) + (v[2] + v[3]); }
                s += __shfl_xor(s, 1); rs = 1.0f / sqrtf(s * (1.0f / 2048.0f) + EPS); } }
        if (half == 0) RS[i * 256 + rr] = rs; } }
    __syncthreads();
}

#ifndef PHMASK
#define PHMASK 0x1fff
#endif
#define SITE(i) ((PHMASK >> (i)) & 1)
#ifndef DBG_GU_A
#define DBG_GU_A WS_HN
#endif
constexpr int NPH = 16;
__global__ void __launch_bounds__(512, 2) hymba_fwd(Args a) {
    extern __shared__ __attribute__((aligned(16))) unsigned char lds_raw[];
    Ctx C0; C0.lds = (LAS unsigned char*)lds_raw; C0.tid = threadIdx.x; C0.lane = C0.tid & 63; C0.wid = __builtin_amdgcn_readfirstlane(C0.tid >> 6); C0.G = gridDim.x; C0.wg = blockIdx.x;
    C0.in.p = (InArr)__builtin_amdgcn_kernarg_segment_ptr(); C0.out = a.out; C0.ws = a.ws;
    LAS unsigned char* lds = C0.lds;
    volatile LAS unsigned* misc = (volatile LAS unsigned*)(lds + MISC_OFF);
    if (C0.tid < 4) misc[C0.tid] = 0u;
    __syncthreads();
#if !MK_MULTI
    XcdBarrier bar = xcd_barrier_post((unsigned*)(a.ws + WS_CTL) + CW_BAR, misc);
#endif
    const int lo = a.ph_lo, hi = a.ph_hi % 1000, variant = a.ph_hi / 1000;
#define IN(k) (lo <= (k) && (k) < hi)
#if MK_MULTI
#define SEAM(k) do { } while (0)
#else
#define SEAM(k) do { if (IN(k) && IN((k) + 1)) xcd_barrier(bar); } while (0)
#endif
#define SITE_BEGIN() Ctx Cs = C0; GAS unsigned char* wsg_ = (GAS unsigned char*)C0.ws; GAS float* outg_ = (GAS float*)C0.out; asm volatile("" : "+s"(wsg_), "+s"(outg_), "+s"(Cs.in.p), "+s"(Cs.G), "+s"(Cs.wg), "+s"(Cs.wid), "+v"(Cs.tid), "+v"(Cs.lane)); Cs.ws = (unsigned char*)wsg_; Cs.out = (float*)outg_; unsigned char* ws = Cs.ws; const Ctx& C = Cs; const int G = Cs.G, wg = Cs.wg, NGW = G * 8, gw = wg * 8 + C.wid; (void)gw; (void)ws; (void)NGW

    if (SITE(0) && IN(0)) { SITE_BEGIN(); p0_prologue(C); }
    SEAM(0);
    if (SITE(1) && IN(1)) { SITE_BEGIN();
        for (int u = wg; u < 512; u += G) cmp1_sample_unit(C, u, variant);
    }
    SEAM(1);
    {
        constexpr int l = 0, pb = 2 + 7 * l;
        if (SITE(3) && IN(pb + 0)) { SITE_BEGIN();
            if (l == 0) {
            for (int u = wg; u < 512; u += G) { const int seq = u >> 3, blk = u & 7, lk = seq >> 4, l = lk >> 1, kv = lk & 1;
                cmp_stage2_unit(C, (const float*)(ws + WS_TBS), (size_t)seq * 1024, blk * 128, 1023, C.in[kv ? I_B1V : I_B1K] + l * 128, (const bf16*)(ws + WS_W2T) + (size_t)lk * 128 * 128,
                                kv ? nullptr : C.in[I_KNC] + l * 128, (bf16*)(ws + WS_CKVS) + ((size_t)seq * 1024 + blk * 128) * 128); }

                __syncthreads(); }
            pg8::Gemm g{(const pg8::bf16_t*)(ws + WS_XN), (const pg8::bf16_t*)(ws + WS_WIN) + (size_t)l * INWP * DM, MPAD, INWP, DM}; pg8::StaticOrder S; S.init(MPAD, INWP, G, wg);
            if (l == 0) prenorm_prologue(C, S, nullptr, nullptr); else prenorm_prologue(C, S, (const float*)(ws + WS_PS), (const float*)(ws + WS_PSS));
            pg8::EpiIn E{(pg8::bf16_t*)(ws + WS_U), (pg8::bf16_t*)(ws + WS_US), (pg8::bf16_t*)(ws + WS_Q), (float*)(ws + WS_KVRAW), (float*)(ws + WS_GT), (pg8::bf16_t*)(ws + WS_KVC), (const PG8_LAS float*)(lds + LDS_RS), 0};
            pg8::gemm_phase<pg8::EpiIn, pg8::StaticOrder, true, true>(lds, g, S, E);
            if (G == 256 && wg >= 239) {
                __syncthreads(); LAS float* scr = (LAS float*)(C.lds + C.wid * 16384);
                for (int i = (wg - 239) * 8 + C.wid; i < (l == 0 ? TI_OUT : TI_GU_DEF); i += 17 * 8) weight_item(C, TI_LAYER + TI_IN + TI_GLU + (l == 0 ? 0 : TI_OUT) + i, scr); }
        }
        SEAM(pb + 0);
        if (SITE(4) && IN(pb + 1)) { SITE_BEGIN();
            const bool fast = (G == 256);
            if (variant == 0 || variant == 1) {
            if (fast) { if (wg >= 8 && wg < 248) for (int r = (wg - 8) * 8 + C.wid; r < MR; r += 240 * 8) kvfix_row(C, l, r);
                        if (wg >= 128 && wg < 192) { const int i = (wg - 128) * 8 + C.wid; ssm_sample_item(C, l, i / NG, i % NG); } }
            else { for (int r = gw; r < MR; r += NGW) kvfix_row(C, l, r);
                   for (int i = gw; i < SB * NG; i += NGW) ssm_sample_item(C, l, i / NG, i % NG); } }
            __syncthreads();
            const int nss = G > 16 ? G - 8 : G, ncm = G > 16 ? 8 : G, ccm = G > 16 ? wg - nss : wg;
            if ((variant == 0 || variant == 2) && wg < nss) for (int u = wg; u < NB * NG; u += nss) ssm_unit(C, l, u / NG, u % NG);
            {   pg8::Gemm g{(const pg8::bf16_t*)(ws + WS_KVC), (const pg8::bf16_t*)(ws + WS_W1C) + (size_t)l * 2 * 256 * 2048, 0, 0, 2048};
                pg8::GroupOrder S{8, ncm, (variant == 0 || variant == 3) ? ccm : -1, 4}; pg8::EpiTB E{(float*)(ws + WS_TBP)};
                pg8::gemm_phase<pg8::EpiTB, pg8::GroupOrder, true, true>(lds, g, S, E); }
            if (ccm >= 0 && (variant == 0 || variant == 3)) { VM_WAIT(); __syncthreads();
                for (int L = ccm; L < 8; L += ncm) for (int h2 = 0; h2 < 2; ++h2) { const int u = 2 * L + h2, kv = u >> 3;
                    cmp_stage2_unit(C, (const float*)(ws + WS_TBP), (size_t)u * 128, 0, 127, C.in[kv ? I_B1V : I_B1K] + l * 128, (const bf16*)(ws + WS_W2T) + (size_t)(l * 2 + kv) * 128 * 128,
                                    kv ? nullptr : C.in[I_KNC] + l * 128, (bf16*)(ws + WS_CKVP) + (size_t)u * 128 * 128); } }
        }
        SEAM(pb + 1);
        if (SITE(5) && IN(pb + 2)) { SITE_BEGIN();
            const bool fast = (G == 256);
            int gc = wg, gG = G;
            if (fast) { gG = 1 << 20; gc = 1 << 20;
                if (wg < 64) gc = wg; else if (wg >= 128) { const int p = wg - 128, j = p >> 3; if (j < 9) gc = 64 + 8 * j + (p & 7); } }
            {   pg8::Gemm g{(const pg8::bf16_t*)(ws + WS_Z), (const pg8::bf16_t*)(ws + WS_WGLU) + (size_t)l * 1024 * 1024, MPAD, 1024, 1024}; if (!(variant == 0 || variant == 4)) { gc = 1 << 20; gG = 1 << 20; }
                pg8::StaticOrder S; S.init(MPAD, 1024, gG, gc);
                pg8::EpiGlu E{(const pg8::bf16_t*)(ws + WS_Z), (pg8::bf16_t*)(ws + WS_SSMY)};
                pg8::gemm_phase<pg8::EpiGlu, pg8::StaticOrder, true, true>(lds, g, S, E); }
            __syncthreads();
#ifndef NO_SA
            if (fast) { if (wg < 64 && (variant == 0 || variant == 5)) attn_sample_unit(C, l, wg >> 3, (wg >> 2) & 1, wg & 3); }
            else for (int s = wg; s < 64; s += G) attn_sample_unit(C, l, s >> 3, (s >> 2) & 1, s & 3);
#endif
#ifndef NO_PA
            if (fast && (variant == 0 || variant == 6)) {
                if (wg >= 128) { const int p = wg - 128, bk = p & 7; attn_prompt_unit(C, l, bk >> 1, bk & 1, 16 + (p >> 3)); }
                else if (wg >= 64) { const int p = wg - 64, bk = p & 7, k = p >> 3;
                    for (int t2 = 0; t2 < 2; ++t2) attn_prompt_unit(C, l, bk >> 1, bk & 1, t2 == 0 ? 15 - k : k); }
            } else if (!fast) for (int u = wg; u < 256; u += G) { const int qb = u & 31, bk = u >> 5; attn_prompt_unit(C, l, bk >> 1, bk & 1, qb); }
#endif
        }
        SEAM(pb + 2);
        if (SITE(6) && IN(pb + 3)) { SITE_BEGIN(); for (int r = gw; r < MR; r += 4 * NGW) { const int left = (MR - r + NGW - 1) / NGW; mixnorm_rows<4>(C, l, r, NGW, left < 4 ? left : 4); } }
        SEAM(pb + 3);
        if (SITE(7) && IN(pb + 4)) { SITE_BEGIN();
            const void* bp = l == 0 ? (const void*)C.in[I_XP] : (const void*)(ws + WS_XN); const void* bs = l == 0 ? (const void*)C.in[I_XS] : (const void*)((const bf16*)(ws + WS_XN) + (size_t)MP * DM);
            const pg8::bf16_t* Wt = (const pg8::bf16_t*)(ws + WS_WOUT) + (size_t)l * DM * DM;
            {   pg8::Gemm g{(const pg8::bf16_t*)(ws + WS_H), Wt, MP, DM, DM}; pg8::StaticOrder S; S.init(MP, DM, G, wg); pg8::EpiRes<(l == 0), false> E{bp, (void*)(ws + WS_HN), (float*)(ws + WS_PS)};
                pg8::gemm_phase<pg8::EpiRes<(l == 0), false>, pg8::StaticOrder, true, true>(lds, g, S, E); }
            __syncthreads();
            sample_gemm_res<(l == 0), false>(C, (const bf16*)(ws + WS_H) + (size_t)MP * DM, Wt, DM, bs, (void*)((bf16*)(ws + WS_HN) + (size_t)MP * DM), wg, G, (float*)(ws + WS_PSS));
        }
        SEAM(pb + 4);
        if (SITE(8) && IN(pb + 5)) { SITE_BEGIN();
            pg8::Gemm g{(const pg8::bf16_t*)(ws + DBG_GU_A), (const pg8::bf16_t*)(ws + WS_WGU) + (size_t)l * 2 * DFF * DM, MPAD, 2 * DFF, DM}; pg8::StaticOrder S; S.init(MPAD, 2 * DFF, G, wg);
            prenorm_prologue(C, S, (const float*)(ws + WS_PS), (const float*)(ws + WS_PSS));
            pg8::EpiSwiGLU E{(pg8::bf16_t*)(ws + WS_HMID), (const PG8_LAS float*)(lds + LDS_RS), 0};
#ifdef DBG_ONEUNIT
            for (int ui = 0; ui < 6; ++ui) { pg8::OneUnitOrder S1{S, ui}; pg8::gemm_phase<pg8::EpiSwiGLU, pg8::OneUnitOrder, true, true>(lds, g, S1, E); __syncthreads(); }
#else
            pg8::gemm_phase<pg8::EpiSwiGLU, pg8::StaticOrder, true, true>(lds, g, S, E);
#endif
            if (l == 1 && G == 256 && wg >= 172) window_copy(C, wg - 172, 84);
            if (l == 0 && G == 256 && wg >= 172) {
                __syncthreads(); LAS float* scr = (LAS float*)(C.lds + C.wid * 16384);
                for (int i = (wg - 172) * 8 + C.wid; i < TI_DN + TI_GLU + TI_IN_DEF; i += 84 * 8)
                    weight_item(C, TI_LAYER + (i < TI_DN ? TI_IN + TI_GLU + TI_OUT + 2 * TI_G + i : (i < TI_DN + TI_GLU ? TI_IN + (i - TI_DN) : i - TI_DN - TI_GLU)), scr); }
        }
        SEAM(pb + 5);
        if (SITE(9) && IN(pb + 6)) { SITE_BEGIN();
            void* op = l == 0 ? (void*)(ws + WS_XN) : (void*)(C.out + O_YP); void* os = l == 0 ? (void*)((bf16*)(ws + WS_XN) + (size_t)MP * DM) : (void*)(C.out + O_YS);
            const pg8::bf16_t* Wt = (const pg8::bf16_t*)(ws + WS_WDN) + (size_t)l * DM * DFF;
            {   pg8::Gemm g{(const pg8::bf16_t*)(ws + WS_HMID), Wt, MP, DM, DFF}; pg8::StaticOrder S; S.init(MP, DM, G, wg); pg8::EpiRes<false, (l == 1)> E{(const void*)(ws + WS_HN), op, l == 0 ? (float*)(ws + WS_PS) : nullptr};
                pg8::gemm_phase<pg8::EpiRes<false, (l == 1)>, pg8::StaticOrder, true, true>(lds, g, S, E); }
            __syncthreads();
            sample_gemm_res<false, (l == 1)>(C, (const bf16*)(ws + WS_HMID) + (size_t)MP * DFF, Wt, DFF, (const void*)((const bf16*)(ws + WS_HN) + (size_t)MP * DM), os, wg, G, l == 0 ? (float*)(ws + WS_PSS) : nullptr);
        }
        SEAM(pb + 6);
    }
    {
        constexpr int l = 1, pb = 2 + 7 * l;
        if (SITE(3) && IN(pb + 0)) { SITE_BEGIN();
            if (l == 0) {
            for (int u = wg; u < 512; u += G) { const int seq = u >> 3, blk = u & 7, lk = seq >> 4, l = lk >> 1, kv = lk & 1;
                cmp_stage2_unit(C, (const float*)(ws + WS_TBS), (size_t)seq * 1024, blk * 128, 1023, C.in[kv ? I_B1V : I_B1K] + l * 128, (const bf16*)(ws + WS_W2T) + (size_t)lk * 128 * 128,
                                kv ? nullptr : C.in[I_KNC] + l * 128, (bf16*)(ws + WS_CKVS) + ((size_t)seq * 1024 + blk * 128) * 128); }

                __syncthreads(); }
            pg8::Gemm g{(const pg8::bf16_t*)(ws + WS_XN), (const pg8::bf16_t*)(ws + WS_WIN) + (size_t)l * INWP * DM, MPAD, INWP, DM}; pg8::StaticOrder S; S.init(MPAD, INWP, G, wg);
            if (l == 0) prenorm_prologue(C, S, nullptr, nullptr); else prenorm_prologue(C, S, (const float*)(ws + WS_PS), (const float*)(ws + WS_PSS));
            pg8::EpiIn E{(pg8::bf16_t*)(ws + WS_U), (pg8::bf16_t*)(ws + WS_US), (pg8::bf16_t*)(ws + WS_Q), (float*)(ws + WS_KVRAW), (float*)(ws + WS_GT), (pg8::bf16_t*)(ws + WS_KVC), (const PG8_LAS float*)(lds + LDS_RS), 0};
            pg8::gemm_phase<pg8::EpiIn, pg8::StaticOrder, true, true>(lds, g, S, E);
            if (G == 256 && wg >= 239) {
                __syncthreads(); LAS float* scr = (LAS float*)(C.lds + C.wid * 16384);
                for (int i = (wg - 239) * 8 + C.wid; i < (l == 0 ? TI_OUT : TI_GU_DEF); i += 17 * 8) weight_item(C, TI_LAYER + TI_IN + TI_GLU + (l == 0 ? 0 : TI_OUT) + i, scr); }
        }
        SEAM(pb + 0);
        if (SITE(4) && IN(pb + 1)) { SITE_BEGIN();
            const bool fast = (G == 256);
            if (variant == 0 || variant == 1) {
            if (fast) { if (wg >= 8 && wg < 248) for (int r = (wg - 8) * 8 + C.wid; r < MR; r += 240 * 8) kvfix_row(C, l, r);
                        if (wg >= 128 && wg < 192) { const int i = (wg - 128) * 8 + C.wid; ssm_sample_item(C, l, i / NG, i % NG); } }
            else { for (int r = gw; r < MR; r += NGW) kvfix_row(C, l, r);
                   for (int i = gw; i < SB * NG; i += NGW) ssm_sample_item(C, l, i / NG, i % NG); } }
            __syncthreads();
            const int nss = G > 16 ? G - 8 : G, ncm = G > 16 ? 8 : G, ccm = G > 16 ? wg - nss : wg;
            if ((variant == 0 || variant == 2) && wg < nss) for (int u = wg; u < NB * NG; u += nss) ssm_unit(C, l, u / NG, u % NG);
            {   pg8::Gemm g{(const pg8::bf16_t*)(ws + WS_KVC), (const pg8::bf16_t*)(ws + WS_W1C) + (size_t)l * 2 * 256 * 2048, 0, 0, 2048};
                pg8::GroupOrder S{8, ncm, (variant == 0 || variant == 3) ? ccm : -1, 4}; pg8::EpiTB E{(float*)(ws + WS_TBP)};
                pg8::gemm_phase<pg8::EpiTB, pg8::GroupOrder, true, true>(lds, g, S, E); }
            if (ccm >= 0 && (variant == 0 || variant == 3)) { VM_WAIT(); __syncthreads();
                for (int L = ccm; L < 8; L += ncm) for (int h2 = 0; h2 < 2; ++h2) { const int u = 2 * L + h2, kv = u >> 3;
                    cmp_stage2_unit(C, (const float*)(ws + WS_TBP), (size_t)u * 128, 0, 127, C.in[kv ? I_B1V : I_B1K] + l * 128, (const bf16*)(ws + WS_W2T) + (size_t)(l * 2 + kv) * 128 * 128,
                                    kv ? nullptr : C.in[I_KNC] + l * 128, (bf16*)(ws + WS_CKVP) + (size_t)u * 128 * 128); } }
        }
        SEAM(pb + 1);
        if (SITE(5) && IN(pb + 2)) { SITE_BEGIN();
            const bool fast = (G == 256);
            int gc = wg, gG = G;
            if (fast) { gG = 1 << 20; gc = 1 << 20;
                if (wg < 64) gc = wg; else if (wg >= 128) { const int p = wg - 128, j = p >> 3; if (j < 9) gc = 64 + 8 * j + (p & 7); } }
            {   pg8::Gemm g{(const pg8::bf16_t*)(ws + WS_Z), (const pg8::bf16_t*)(ws + WS_WGLU) + (size_t)l * 1024 * 1024, MPAD, 1024, 1024}; if (!(variant == 0 || variant == 4)) { gc = 1 << 20; gG = 1 << 20; }
                pg8::StaticOrder S; S.init(MPAD, 1024, gG, gc);
                pg8::EpiGlu E{(const pg8::bf16_t*)(ws + WS_Z), (pg8::bf16_t*)(ws + WS_SSMY)};
                pg8::gemm_phase<pg8::EpiGlu, pg8::StaticOrder, true, true>(lds, g, S, E); }
            __syncthreads();
#ifndef NO_SA
            if (fast) { if (wg < 64 && (variant == 0 || variant == 5)) attn_sample_unit(C, l, wg >> 3, (wg >> 2) & 1, wg & 3); }
            else for (int s = wg; s < 64; s += G) attn_sample_unit(C, l, s >> 3, (s >> 2) & 1, s & 3);
#endif
#ifndef NO_PA
            if (fast && (variant == 0 || variant == 6)) {
                if (wg >= 128) { const int p = wg - 128, bk = p & 7; attn_prompt_unit(C, l, bk >> 1, bk & 1, 16 + (p >> 3)); }
                else if (wg >= 64) { const int p = wg - 64, bk = p & 7, k = p >> 3;
                    for (int t2 = 0; t2 < 2; ++t2) attn_prompt_unit(C, l, bk >> 1, bk & 1, t2 == 0 ? 15 - k : k); }
            } else if (!fast) for (int u = wg; u < 256; u += G) { const int qb = u & 31, bk = u >> 5; attn_prompt_unit(C, l, bk >> 1, bk & 1, qb); }
#endif
        }
        SEAM(pb + 2);
        if (SITE(6) && IN(pb + 3)) { SITE_BEGIN(); for (int r = gw; r < MR; r += 4 * NGW) { const int left = (MR - r + NGW - 1) / NGW; mixnorm_rows<4>(C, l, r, NGW, left < 4 ? left : 4); } }
        SEAM(pb + 3);
        if (SITE(7) && IN(pb + 4)) { SITE_BEGIN();
            const void* bp = l == 0 ? (const void*)C.in[I_XP] : (const void*)(ws + WS_XN); const void* bs = l == 0 ? (const void*)C.in[I_XS] : (const void*)((const bf16*)(ws + WS_XN) + (size_t)MP * DM);
            const pg8::bf16_t* Wt = (const pg8::bf16_t*)(ws + WS_WOUT) + (size_t)l * DM * DM;
            {   pg8::Gemm g{(const pg8::bf16_t*)(ws + WS_H), Wt, MP, DM, DM}; pg8::StaticOrder S; S.init(MP, DM, G, wg); pg8::EpiRes<(l == 0), false> E{bp, (void*)(ws + WS_HN), (float*)(ws + WS_PS)};
                pg8::gemm_phase<pg8::EpiRes<(l == 0), false>, pg8::StaticOrder, true, true>(lds, g, S, E); }
            __syncthreads();
            sample_gemm_res<(l == 0), false>(C, (const bf16*)(ws + WS_H) + (size_t)MP * DM, Wt, DM, bs, (void*)((bf16*)(ws + WS_HN) + (size_t)MP * DM), wg, G, (float*)(ws + WS_PSS));
        }
        SEAM(pb + 4);
        if (SITE(8) && IN(pb + 5)) { SITE_BEGIN();
            pg8::Gemm g{(const pg8::bf16_t*)(ws + DBG_GU_A), (const pg8::bf16_t*)(ws + WS_WGU) + (size_t)l * 2 * DFF * DM, MPAD, 2 * DFF, DM}; pg8::StaticOrder S; S.init(MPAD, 2 * DFF, G, wg);
            prenorm_prologue(C, S, (const float*)(ws + WS_PS), (const float*)(ws + WS_PSS));
            pg8::EpiSwiGLU E{(pg8::bf16_t*)(ws + WS_HMID), (const PG8_LAS float*)(lds + LDS_RS), 0};
#ifdef DBG_ONEUNIT
            for (int ui = 0; ui < 6; ++ui) { pg8::OneUnitOrder S1{S, ui}; pg8::gemm_phase<pg8::EpiSwiGLU, pg8::OneUnitOrder, true, true>(lds, g, S1, E); __syncthreads(); }
#else
            pg8::gemm_phase<pg8::EpiSwiGLU, pg8::StaticOrder, true, true>(lds, g, S, E);
#endif
            if (l == 1 && G == 256 && wg >= 172) window_copy(C, wg - 172, 84);
            if (l == 0 && G == 256 && wg >= 172) {
                __syncthreads(); LAS float* scr = (LAS float*)(C.lds + C.wid * 16384);
                for (int i = (wg - 172) * 8 + C.wid; i < TI_DN + TI_GLU + TI_IN_DEF; i += 84 * 8)
                    weight_item(C, TI_LAYER + (i < TI_DN ? TI_IN + TI_GLU + TI_OUT + 2 * TI_G + i : (i < TI_DN + TI_GLU ? TI_IN + (i - TI_DN) : i - TI_DN - TI_GLU)), scr); }
        }
        SEAM(pb + 5);
        if (SITE(9) && IN(pb + 6)) { SITE_BEGIN();
            void* op = l == 0 ? (void*)(ws + WS_XN) : (void*)(C.out + O_YP); void* os = l == 0 ? (void*)((bf16*)(ws + WS_XN) + (size_t)MP * DM) : (void*)(C.out + O_YS);
            const pg8::bf16_t* Wt = (const pg8::bf16_t*)(ws + WS_WDN) + (size_t)l * DM * DFF;
            {   pg8::Gemm g{(const pg8::bf16_t*)(ws + WS_HMID), Wt, MP, DM, DFF}; pg8::StaticOrder S; S.init(MP, DM, G, wg); pg8::EpiRes<false, (l == 1)> E{(const void*)(ws + WS_HN), op, l == 0 ? (float*)(ws + WS_PS) : nullptr};
                pg8::gemm_phase<pg8::EpiRes<false, (l == 1)>, pg8::StaticOrder, true, true>(lds, g, S, E); }
            __syncthreads();
            sample_gemm_res<false, (l == 1)>(C, (const bf16*)(ws + WS_HMID) + (size_t)MP * DFF, Wt, DFF, (const void*)((const bf16*)(ws + WS_HN) + (size_t)MP * DM), os, wg, G, l == 0 ? (float*)(ws + WS_PSS) : nullptr);
        }
        SEAM(pb + 6);
    }
#ifdef DBG_DUMP_OFF
    if (IN(99)) { const size_t gt = (size_t)blockIdx.x * 512 + threadIdx.x, NT = (size_t)gridDim.x * 512;
#ifdef DBG_DUMP_BF16
        const bf16* src = (const bf16*)(a.ws + (size_t)(DBG_DUMP_OFF));
        const float marker = a.out[O_SSMS];
        for (size_t i = gt; i < (size_t)(DBG_DUMP_N); i += NT) { float* d = i < (size_t)MP * DM ? a.out + O_YP + i : a.out + O_YS + (i - (size_t)MP * DM); float v = bf2f(src[i]);
#ifdef DBG_LOWBITS
            v = (float)(src[i] & 0xFFu);
#endif
#ifdef DBG_PERTURB
            if (marker != 1.0f && i >= 1000 && i < 1000 + DBG_PERTURB) v = v * 2.0f + 1.0f;
#endif
            *d = v; }
        __syncthreads();
        if (gt == 0) { __builtin_amdgcn_s_sleep(100); a.out[O_SSMS] = 1.0f; }
#else
#ifdef DBG_DUMP_FROM_OUT
        const float* src = (const float*)(a.out + (size_t)(DBG_DUMP_OFF));
#else
        const float* src = (const float*)(a.ws + (size_t)(DBG_DUMP_OFF));
#endif
        for (size_t i = gt; i < (size_t)(DBG_DUMP_N) / 4; i += NT) { const size_t o = 4 * i; float* d = o < (size_t)MP * DM ? a.out + O_YP + o : a.out + O_YS + (o - (size_t)MP * DM); f32x4 vv = *(const f32x4*)(src + o);
#ifdef DBG_LOWBITS
            for (int q = 0; q < 4; ++q) vv[q] = (float)(__float_as_uint(vv[q]) & 0xFFu);
#endif
            *(f32x4*)d = vv; }
#endif
    }
#endif
#undef IN
#undef SEAM
}

extern "C" void kernel_launch(void* const* d_in, const int* in_sizes, int n_in, void* d_out, int out_size, void* d_ws, size_t ws_size, hipStream_t stream) {
    static int grid = 0;
    if (grid == 0) {
        if (n_in != NIN || (size_t)out_size != O_END || ws_size < WS_END) { fprintf(stderr, "kernel_launch: shape mismatch: n_in %d out %d ws %zu (need %d, %zu, >= %zu)\n", n_in, out_size, ws_size, NIN, (size_t)O_END, (size_t)WS_END); grid = -1; return; }
        int dev = 0, cus = 0, per_cu = 0;
        if (hipGetDevice(&dev) != hipSuccess || hipDeviceGetAttribute(&cus, hipDeviceAttributeMultiprocessorCount, dev) != hipSuccess) { fprintf(stderr, "kernel_launch: device query failed\n"); grid = -1; return; }
        if (hipFuncSetAttribute((const void*)hymba_fwd, hipFuncAttributeMaxDynamicSharedMemorySize, LDS_BYTES) != hipSuccess) { fprintf(stderr, "kernel_launch: hipFuncSetAttribute(%d) failed\n", LDS_BYTES); grid = -1; return; }
        if (hipOccupancyMaxActiveBlocksPerMultiprocessor(&per_cu, (const void*)hymba_fwd, 512, LDS_BYTES) != hipSuccess || per_cu < 1) fprintf(stderr, "kernel_launch: occupancy query says %d\n", per_cu);
        (void)hipGetLastError();
        grid = cus;
    }
    if (grid < 0) return;
#ifdef DBG_MEMSET_WS
    (void)hipMemsetAsync((char*)d_ws + CTL_BYTES, 0x11, WS_END - CTL_BYTES, stream);
#endif
    if (hipMemsetAsync((char*)d_ws + WS_CTL, 0, CTL_BYTES, stream) != hipSuccess) { fprintf(stderr, "kernel_launch: memset failed\n"); return; }
    Args a{};
    for (int i = 0; i < NIN; ++i) a.in[i] = (const float*)d_in[i];
    a.out = (float*)d_out; a.ws = (unsigned char*)d_ws;
#if MK_MULTI
#ifdef DBG_STOP
    for (int ph = 0; ph < DBG_STOP; ++ph) { a.ph_lo = ph; a.ph_hi = ph + 1; hipLaunchKernelGGL(hymba_fwd, dim3(grid), dim3(512), LDS_BYTES, stream, a); }
#ifdef DBG_EXTRA_PHASE
    a.ph_lo = DBG_EXTRA_PHASE; a.ph_hi = DBG_EXTRA_PHASE + 1; hipLaunchKernelGGL(hymba_fwd, dim3(grid), dim3(512), LDS_BYTES, stream, a);
#endif
#ifdef DBG_REPEAT12
    for (int rr = 0; rr < DBG_REPEAT12; ++rr) { a.ph_lo = 12; a.ph_hi = 13; hipLaunchKernelGGL(hymba_fwd, dim3(grid), dim3(512), LDS_BYTES, stream, a); }
#endif
#ifdef DBG_DUMP_OFF
    a.ph_lo = 99; a.ph_hi = 100; hipLaunchKernelGGL(hymba_fwd, dim3(grid), dim3(512), LDS_BYTES, stream, a);
#endif
#else
    for (int ph = 0; ph < NPH; ++ph) { a.ph_lo = ph; a.ph_hi = ph + 1; hipLaunchKernelGGL(hymba_fwd, dim3(grid), dim3(512), LDS_BYTES, stream, a); }
#endif
#else
    a.ph_lo = 0; a.ph_hi = NPH; hipLaunchKernelGGL(hymba_fwd, dim3(grid), dim3(512), LDS_BYTES, stream, a);
#ifndef PROBE_VARIANT
#define PROBE_VARIANT 0
#endif
#ifdef PROBE_EXTRA_PHASE
    (void)hipMemsetAsync((char*)d_ws + WS_CTL, 0, CTL_BYTES, stream);
    a.ph_lo = PROBE_EXTRA_PHASE; a.ph_hi = PROBE_EXTRA_PHASE + 1 + 1000 * PROBE_VARIANT; hipLaunchKernelGGL(hymba_fwd, dim3(grid), dim3(512), LDS_BYTES, stream, a);
#endif
#endif
    const hipError_t le = hipPeekAtLastError();
    if (le != hipSuccess) fprintf(stderr, "kernel_launch: launch failed: %s\n", hipGetErrorName(le));
}
```

```cpp
#include <hip/hip_runtime.h>
#include <cstdio>
#include <cstdint>

#ifndef MK_MULTI
#define MK_MULTI 0
#endif

namespace pg8 {
#define PG8_LAS __attribute__((address_space(3)))
typedef unsigned short bf16_t;
typedef short bf16x8 __attribute__((ext_vector_type(8)));
typedef float f32x4 __attribute__((ext_vector_type(4)));
typedef unsigned u32x4 __attribute__((ext_vector_type(4)));
constexpr int BM = 256, BK = 64, HALF = 128, HTB = HALF * BK * 2  , STAGE_BYTES = 8 * HTB, NXCD = 8, WGM = 8;

__host__ __device__ __forceinline__ int lds_byte(int r, int c) { const int st = (r >> 4) * 2 + (c >> 5), rr = r & 15, cc = c & 31, ob = rr * 64 + cc * 2; return st * 1024 + (ob ^ (((ob >> 9) & 1) << 5)); }
__host__ __device__ __forceinline__ void stage_rc(int b, int& R, int& C) { const int st = b / 1024, sb = b % 1024, swz = sb ^ (((sb >> 9) & 1) << 5); R = (st >> 1) * 16 + swz / 64; C = (st & 1) * 32 + (swz % 64) / 2; }
__host__ __device__ __forceinline__ int perm32(int rho) { const int n = rho >> 4, i = rho & 15; return 8 * (i >> 2) + 4 * n + (i & 3); }

struct Unit { int pm, pn; };
struct Gemm { const bf16_t* A; const bf16_t* Bt; int M, N, K; };

struct StaticOrder {
    int nM, nN, nwg, G, c;
    __host__ __device__ void init(int M, int N, int G_, int c_) { nM = M / BM; nN = N / BM; nwg = nM * nN; G = G_; c = c_; }
    __host__ __device__ bool next(int i, Unit& u) const {
        const long L = (long)i * G + c; if (L >= nwg) return false;
        int wgid = (int)L; { const int q = nwg / NXCD, r = nwg % NXCD, xcd = wgid % NXCD, off = wgid / NXCD; wgid = (xcd < r ? xcd * (q + 1) : r * (q + 1) + (xcd - r) * q) + off; }
        const int nig = WGM * nN, gid = wgid / nig, fm = gid * WGM, gsz = (nM - fm) < WGM ? (nM - fm) : WGM;
        u.pm = fm + ((wgid % nig) % gsz); u.pn = (wgid % nig) / gsz; return true;
    }
    __device__ __forceinline__ void a_ready(const Unit&) const {}
    __device__ __forceinline__ void done(const Unit&) const {}
};
__device__ __forceinline__ unsigned cvt_pk_bf16(float lo, float hi) { unsigned r; asm volatile("v_cvt_pk_bf16_f32 %0, %1, %2" : "=v"(r) : "v"(lo), "v"(hi)); return r; }
typedef float f32x2 __attribute__((ext_vector_type(2)));
typedef unsigned u32x2 __attribute__((ext_vector_type(2)));
__device__ __forceinline__ float fast_sigmoid(float x) { return __builtin_amdgcn_rcpf(1.0f + __builtin_amdgcn_exp2f(-1.4426950408889634f * x)); }
__device__ __forceinline__ float gelu_tanh(float x) { const float a = 1.5957691216057308f * (x + 0.044715f * x * x * x); return x * fast_sigmoid(a); }

struct GroupOrder {
    int n, G, c, per;
    __device__ bool next(int i, Unit& u) const { const int L = i * G + c; if (c < 0 || L >= n) return false; u.pm = L; u.pn = L / per; return true; }
    __device__ __forceinline__ void a_ready(const Unit&) const {}
    __device__ __forceinline__ void done(const Unit&) const {}
};

struct OneUnitOrder {
    StaticOrder S; int i;
    __device__ bool next(int k, Unit& u) const { return k == 0 ? S.next(i, u) : false; }
    __device__ __forceinline__ void a_ready(const Unit&) const {}
    __device__ __forceinline__ void done(const Unit&) const {}
};
struct EpiIn {
    static constexpr bool PERM = true, AFTER_DRAIN = false;
    bf16_t* U; bf16_t* Us; bf16_t* Q; float* KVraw; float* Gt; bf16_t* KVC; const PG8_LAS float* RS; mutable int slot;
    __device__ __forceinline__ void operator()(const f32x4 (&acc)[2][2][4][2], const Unit& u, int wr, int wc, int fr, int fq) const {
        const int pn = u.pn, cw = wc * 32 + 8 * fq; const PG8_LAS float* rsp = RS + slot * 256 + wr * 64 + fr; ++slot;
#pragma unroll
        for (int ai = 0; ai < 2; ++ai)
#pragma unroll
            for (int m = 0; m < 4; ++m) {
                const int row = u.pm * BM + ai * HALF + wr * 64 + m * 16 + fr; const float rs = rsp[ai * HALF + m * 16];
                if (row < 8224) {
#pragma unroll
                    for (int bj = 0; bj < 2; ++bj) {
                        const int col = pn * BM + bj * HALF + cw; const f32x4 v0 = acc[ai][bj][m][0] * rs, v1 = acc[ai][bj][m][1] * rs;
                        if (pn < 8) {
                            u32x4 w; w.x = cvt_pk_bf16(v0[0], v0[1]); w.y = cvt_pk_bf16(v0[2], v0[3]); w.z = cvt_pk_bf16(v1[0], v1[1]); w.w = cvt_pk_bf16(v1[2], v1[3]);
                            if (pn < 4) {
                                if (row < 8192) { const int b = row >> 11, t = row & 2047, g = col >> 4, p0 = col & 15;
                                    *(u32x4*)(U + ((size_t)((b * 64 + g) * 2048 + t) * 16 + p0)) = w; }
                                else *(u32x4*)(Us + (size_t)(row - 8192) * 1024 + col) = w;
                            } else *(u32x4*)(Q + (size_t)row * 1024 + (col - 1024)) = w;
                        } else if (pn < 14) {
                            float* d = KVraw + (size_t)row * 1536 + (col - 2048); *(f32x4*)d = v0; *(f32x4*)(d + 4) = v1;
                            if (pn < 10 && row < 8192) {
                                u32x4 w; w.x = cvt_pk_bf16(v0[0], v0[1]); w.y = cvt_pk_bf16(v0[2], v0[3]); w.z = cvt_pk_bf16(v1[0], v1[1]); w.w = cvt_pk_bf16(v1[2], v1[3]);
                                const int b = row >> 11, t = row & 2047; *(u32x4*)(KVC + ((size_t)(((pn - 8) * 4 + b) * 2 + bj) * 2048 + t) * 128 + cw) = w; }
                        } else {
                            const int cc = col - 3584;
                            if (cc < 24) { f32x4 a, b2;
#pragma unroll
                                for (int j = 0; j < 4; ++j) { a[j] = fast_sigmoid(v0[j]); b2[j] = fast_sigmoid(v1[j]); }
                                float* d = Gt + (size_t)row * 32 + cc; *(f32x4*)d = a; *(f32x4*)(d + 4) = b2; }
                        }
                    }
                }
            }
    }
};
struct EpiTB {
    static constexpr bool PERM = false, AFTER_DRAIN = false;
    float* C;
    __device__ __forceinline__ void operator()(const f32x4 (&acc)[2][2][4][2], const Unit& u, int wr, int wc, int fr, int fq) const {
#pragma unroll
        for (int ai = 0; ai < 2; ++ai)
#pragma unroll
            for (int m = 0; m < 4; ++m) { float* rowp = C + (size_t)(u.pm * BM + ai * HALF + wr * 64 + m * 16 + fr) * 256 + wc * 32 + 4 * fq;
#pragma unroll
                for (int bj = 0; bj < 2; ++bj)
#pragma unroll
                    for (int n = 0; n < 2; ++n) *(f32x4*)(rowp + bj * HALF + n * 16) = acc[ai][bj][m][n]; }
    }
};
struct EpiGlu {
    static constexpr bool PERM = true, AFTER_DRAIN = false;
    const bf16_t* Z; bf16_t* Y;
    __device__ __forceinline__ void operator()(const f32x4 (&acc)[2][2][4][2], const Unit& u, int wr, int wc, int fr, int fq) const {
#pragma unroll
        for (int ai = 0; ai < 2; ++ai) { u32x4 zz[4][2];
#pragma unroll
            for (int m = 0; m < 4; ++m) { const size_t off = (size_t)(u.pm * BM + ai * HALF + wr * 64 + m * 16 + fr) * 1024 + u.pn * BM + wc * 32 + 8 * fq; zz[m][0] = *(const u32x4*)(Z + off); zz[m][1] = *(const u32x4*)(Z + off + HALF); }
#pragma unroll
            for (int m = 0; m < 4; ++m) { const size_t off = (size_t)(u.pm * BM + ai * HALF + wr * 64 + m * 16 + fr) * 1024 + u.pn * BM + wc * 32 + 8 * fq;
#pragma unroll
                for (int bj = 0; bj < 2; ++bj) { const u32x4 z = zz[m][bj]; const f32x4 v0 = acc[ai][bj][m][0], v1 = acc[ai][bj][m][1];
                    float zf[8];
#pragma unroll
                    for (int j = 0; j < 4; ++j) { zf[2 * j] = __uint_as_float(z[j] << 16); zf[2 * j + 1] = __uint_as_float(z[j] & 0xffff0000u); }
                    u32x4 w; w.x = cvt_pk_bf16(zf[0] * fast_sigmoid(v0[0]), zf[1] * fast_sigmoid(v0[1])); w.y = cvt_pk_bf16(zf[2] * fast_sigmoid(v0[2]), zf[3] * fast_sigmoid(v0[3]));
                    w.z = cvt_pk_bf16(zf[4] * fast_sigmoid(v1[0]), zf[5] * fast_sigmoid(v1[1])); w.w = cvt_pk_bf16(zf[6] * fast_sigmoid(v1[2]), zf[7] * fast_sigmoid(v1[3]));
                    *(u32x4*)(Y + off + bj * HALF) = w; } } }
    }
};
template <bool BF32, bool OF32> struct EpiRes {
    static constexpr bool PERM = true, AFTER_DRAIN = false;
    const void* base; void* out; float* PS;
    __device__ __forceinline__ void operator()(const f32x4 (&acc)[2][2][4][2], const Unit& u, int wr, int wc, int fr, int fq) const {
        const int col0 = u.pn * BM + wc * 32 + 8 * fq;
        constexpr int MG = BF32 ? 2 : 4;
#pragma unroll
        for (int ai = 0; ai < 2; ++ai)
#pragma unroll
            for (int m0 = 0; m0 < 4; m0 += MG) {
                f32x4 bf[MG][2][2]; u32x4 bh[MG][2];
#pragma unroll
                for (int mm = 0; mm < MG; ++mm) { const size_t off = (size_t)(u.pm * BM + ai * HALF + wr * 64 + (m0 + mm) * 16 + fr) * 2048 + col0;
#pragma unroll
                    for (int bj = 0; bj < 2; ++bj) { if (BF32) { bf[mm][bj][0] = *(const f32x4*)((const float*)base + off + bj * HALF); bf[mm][bj][1] = *(const f32x4*)((const float*)base + off + bj * HALF + 4); }
                                                     else bh[mm][bj] = *(const u32x4*)((const bf16_t*)base + off + bj * HALF); } }
#pragma unroll
                for (int mm = 0; mm < MG; ++mm) { const int m = m0 + mm; const int row = u.pm * BM + ai * HALF + wr * 64 + m * 16 + fr; const size_t off = (size_t)row * 2048 + col0; float ss = 0.f;
#pragma unroll
                    for (int bj = 0; bj < 2; ++bj) { f32x4 b0, b1;
                        if (BF32) { b0 = bf[mm][bj][0]; b1 = bf[mm][bj][1]; }
                        else { const u32x4 w = bh[mm][bj];
                            b0 = (f32x4){__uint_as_float(w.x << 16), __uint_as_float(w.x & 0xffff0000u), __uint_as_float(w.y << 16), __uint_as_float(w.y & 0xffff0000u)};
                            b1 = (f32x4){__uint_as_float(w.z << 16), __uint_as_float(w.z & 0xffff0000u), __uint_as_float(w.w << 16), __uint_as_float(w.w & 0xffff0000u)}; }
                        const f32x4 v0 = b0 + acc[ai][bj][m][0], v1 = b1 + acc[ai][bj][m][1];
                        if (OF32) { *(f32x4*)((float*)out + off + bj * HALF) = v0; *(f32x4*)((float*)out + off + bj * HALF + 4) = v1; }
                        else { u32x4 w; w.x = cvt_pk_bf16(v0[0], v0[1]); w.y = cvt_pk_bf16(v0[2], v0[3]); w.z = cvt_pk_bf16(v1[0], v1[1]); w.w = cvt_pk_bf16(v1[2], v1[3]); *(u32x4*)((bf16_t*)out + off + bj * HALF) = w; }
                        if (PS) ss += ((v0[0] * v0[0] + v0[1] * v0[1]) + (v0[2] * v0[2] + v0[3] * v0[3])) + ((v1[0] * v1[0] + v1[1] * v1[1]) + (v1[2] * v1[2] + v1[3] * v1[3])); }
                    if (PS) { ss += __shfl_xor(ss, 16); ss += __shfl_xor(ss, 32); if (fq == 0) PS[(size_t)row * 32 + u.pn * 4 + wc] = ss; } }
                asm volatile("" ::: "memory"); }
    }
};
struct EpiSwiGLU {
    static constexpr bool PERM = true, AFTER_DRAIN = false;
    bf16_t* Hm; const PG8_LAS float* RS; mutable int slot;
    __device__ __forceinline__ void operator()(const f32x4 (&acc)[2][2][4][2], const Unit& u, int wr, int wc, int fr, int fq) const {
        const PG8_LAS float* rsp = RS + slot * 256 + wr * 64 + fr; ++slot;
#pragma unroll
        for (int ai = 0; ai < 2; ++ai)
#pragma unroll
            for (int m = 0; m < 4; ++m) { const float rs = rsp[ai * HALF + m * 16]; bf16_t* d = Hm + (size_t)(u.pm * BM + ai * HALF + wr * 64 + m * 16 + fr) * 5632 + u.pn * HALF + wc * 32 + 8 * fq;
                float h[8];
#pragma unroll
                for (int n = 0; n < 2; ++n)
#pragma unroll
                    for (int j = 0; j < 4; ++j) { const float gt = acc[ai][0][m][n][j] * rs, up = acc[ai][1][m][n][j] * rs;
#ifdef DBG_NOSIG
                        h[4 * n + j] = gt + 0.5f * up; }
#else
                        h[4 * n + j] = gt * fast_sigmoid(gt) * up; }
#endif

                u32x4 w; w.x = cvt_pk_bf16(h[0], h[1]); w.y = cvt_pk_bf16(h[2], h[3]); w.z = cvt_pk_bf16(h[4], h[5]); w.w = cvt_pk_bf16(h[6], h[7]);
                *(u32x4*)d = w; }
    }
};
template <class Epi, class Sched, bool ALIGN_EPI = false, bool SP2 = false>
__device__ __forceinline__ void gemm_phase(PG8_LAS unsigned char* lds, const Gemm g, const Sched& S, const Epi& E) {
    int tid = threadIdx.x; asm volatile("" : "+v"(tid));
    const int wid = __builtin_amdgcn_readfirstlane(tid >> 6), lane = tid & 63, wr = wid >> 2, wc = wid & 3, fr = lane & 15, fq = lane >> 4;
    const int K = g.K, nt = K / BK;
    unsigned voffA[2], voffB[2];
#pragma unroll
    for (int i = 0; i < 2; ++i) { int R, C; stage_rc(tid * 16 + i * 8192, R, C); const int Rb = Epi::PERM ? ((R & ~31) + perm32(R & 31)) : R;
        voffA[i] = (unsigned)(R * K + C) * 2u; voffB[i] = (unsigned)(Rb * K + C) * 2u; }
    const size_t kstep = (size_t)(BK * 2);
    const size_t hstep = (size_t)HALF * K * 2;
    const size_t tstep = 2 * hstep;
    const unsigned ldsw = (unsigned)wid * 1024u;
    const int aoff = lds_byte(wr * 64 + fr, fq * 8), boff = lds_byte(wc * 32 + fr, fq * 8);
#define PG8_SA(b, h) (((b) * 2 + (h)) * HTB)
#define PG8_SB(b, h) ((4 + (b) * 2 + (h)) * HTB)
#define PG8_STAGE(bufoff, gbase, voff) do { _Pragma("unroll") for (int _i = 0; _i < 2; ++_i) \
        __builtin_amdgcn_global_load_lds((const unsigned*)((const char*)(gbase) + (voff)[_i]), (PG8_LAS unsigned*)(lds + (bufoff) + ldsw + _i * 8192), 16, 0, 0); } while (0)
#define PG8_LDA(dst, b, h) do { _Pragma("unroll") for (int m = 0; m < 4; ++m) _Pragma("unroll") for (int k = 0; k < 2; ++k) dst[m][k] = *(const PG8_LAS bf16x8*)(lds + PG8_SA(b, h) + aoff + m * 2048 + k * 1024); } while (0)
#define PG8_LDB(dst, b, h) do { _Pragma("unroll") for (int n = 0; n < 2; ++n) _Pragma("unroll") for (int k = 0; k < 2; ++k) dst[n][k] = *(const PG8_LAS bf16x8*)(lds + PG8_SB(b, h) + boff + n * 2048 + k * 1024); } while (0)
#define PG8_MMA(ai, bj, At, Bt) do { __builtin_amdgcn_s_setprio(1); _Pragma("unroll") for (int m = 0; m < 4; ++m) _Pragma("unroll") for (int n = 0; n < 2; ++n) _Pragma("unroll") for (int k = 0; k < 2; ++k) \
        acc[ai][bj][m][n] = __builtin_amdgcn_mfma_f32_16x16x32_bf16(Bt[n][k], At[m][k], acc[ai][bj][m][n], 0, 0, 0); __builtin_amdgcn_s_setprio(0); } while (0)
#define PG8_WAIT_V(n) asm volatile("s_waitcnt vmcnt(" #n ")" ::: "memory")
#define PG8_WAIT_L(n) asm volatile("s_waitcnt lgkmcnt(" #n ")" ::: "memory")
#define PG8_BAR __builtin_amdgcn_s_barrier()
#define PG8_SCHED __builtin_amdgcn_sched_barrier(0)
    Unit cur, nxt; int ui = 0;
    if (!S.next(0, cur)) return;
    f32x4 acc[2][2][4][2];
#pragma unroll
    for (int a = 0; a < 2; ++a)
#pragma unroll
        for (int b = 0; b < 2; ++b)
#pragma unroll
            for (int m = 0; m < 4; ++m)
#pragma unroll
                for (int n = 0; n < 2; ++n) acc[a][b][m][n] = (f32x4){0.f, 0.f, 0.f, 0.f};
    bf16x8 At[4][2], B0[2][2], B1[2][2];
    const char* cA = (const char*)g.A + (size_t)cur.pm * tstep; const char* cB = (const char*)g.Bt + (size_t)cur.pn * tstep;
    S.a_ready(cur);
    if constexpr (SP2) {
        PG8_STAGE(PG8_SB(0, 0), cB, voffB); PG8_STAGE(PG8_SB(0, 1), cB + hstep, voffB); PG8_STAGE(PG8_SA(0, 0), cA, voffA); PG8_STAGE(PG8_SA(0, 1), cA + hstep, voffA);
        if (wr == 1) PG8_BAR;
        PG8_WAIT_V(2); PG8_BAR;
        PG8_STAGE(PG8_SB(1, 0), cB + kstep, voffB); PG8_STAGE(PG8_SA(1, 0), cA + kstep, voffA); PG8_STAGE(PG8_SB(1, 1), cB + hstep + kstep, voffB);
        PG8_WAIT_V(6); PG8_BAR;
    } else {
        PG8_STAGE(PG8_SB(0, 0), cB, voffB); PG8_STAGE(PG8_SA(0, 0), cA, voffA); PG8_STAGE(PG8_SB(0, 1), cB + hstep, voffB); PG8_STAGE(PG8_SA(0, 1), cA + hstep, voffA);
        if (wr == 1) PG8_BAR;
        PG8_WAIT_V(4); PG8_BAR;
        PG8_STAGE(PG8_SB(1, 0), cB + kstep, voffB); PG8_STAGE(PG8_SA(1, 0), cA + kstep, voffA); PG8_STAGE(PG8_SB(1, 1), cB + hstep + kstep, voffB);
        PG8_WAIT_V(6); PG8_BAR;
    }
    for (;;) {
        const bool has_next = S.next(ui + 1, nxt);
        const char* nA = has_next ? (const char*)g.A + (size_t)nxt.pm * tstep : cA; const char* nB = has_next ? (const char*)g.Bt + (size_t)nxt.pn * tstep : cB;
        for (int t = 0; t < nt; t += 2) {
            const bool last = (t == nt - 2);
            const char* a1 = cA + (size_t)(t + 1) * kstep;
            const char* a2 = last ? nA : cA + (size_t)(t + 2) * kstep; const char* b2 = last ? nB : cB + (size_t)(t + 2) * kstep;
            const char* a3 = a2 + kstep; const char* b3 = b2 + kstep;
            if (last && has_next) S.a_ready(nxt);
            if constexpr (SP2) {
            PG8_LDB(B0, 0, 0); PG8_LDB(B1, 0, 1); PG8_SCHED; PG8_LDA(At, 0, 0); PG8_STAGE(PG8_SA(1, 1), a1 + hstep, voffA);
            PG8_WAIT_V(8); PG8_WAIT_L(0); PG8_BAR; PG8_MMA(0, 0, At, B0); PG8_MMA(0, 1, At, B1); PG8_BAR; PG8_SCHED;
            PG8_LDA(At, 0, 1); PG8_STAGE(PG8_SB(0, 0), b2, voffB); PG8_STAGE(PG8_SB(0, 1), b2 + hstep, voffB); PG8_STAGE(PG8_SA(0, 0), a2, voffA);
            PG8_WAIT_V(8); PG8_WAIT_L(0); PG8_BAR; PG8_MMA(1, 0, At, B0); PG8_MMA(1, 1, At, B1); PG8_BAR; PG8_SCHED;
            PG8_LDB(B0, 1, 0); PG8_LDB(B1, 1, 1); PG8_SCHED; PG8_LDA(At, 1, 0); PG8_STAGE(PG8_SA(0, 1), a2 + hstep, voffA);
            PG8_WAIT_V(8); PG8_WAIT_L(0); PG8_BAR; PG8_MMA(0, 0, At, B0); PG8_MMA(0, 1, At, B1); PG8_BAR; PG8_SCHED;
            PG8_LDA(At, 1, 1); PG8_STAGE(PG8_SB(1, 0), b3, voffB); PG8_STAGE(PG8_SB(1, 1), b3 + hstep, voffB); PG8_STAGE(PG8_SA(1, 0), a3, voffA);
            PG8_WAIT_V(8); PG8_WAIT_L(0); PG8_BAR; PG8_MMA(1, 0, At, B0); PG8_MMA(1, 1, At, B1); PG8_BAR; PG8_SCHED;
            } else {
            PG8_LDB(B0, 0, 0); PG8_SCHED; PG8_LDA(At, 0, 0); PG8_STAGE(PG8_SA(1, 1), a1 + hstep, voffA);
            PG8_WAIT_L(8); PG8_BAR; PG8_WAIT_L(0); PG8_MMA(0, 0, At, B0); PG8_BAR; PG8_SCHED;
            PG8_LDB(B1, 0, 1); PG8_STAGE(PG8_SB(0, 0), b2, voffB);
            PG8_BAR; PG8_WAIT_L(0); PG8_MMA(0, 1, At, B1); PG8_BAR;
            PG8_LDA(At, 0, 1); PG8_STAGE(PG8_SA(0, 0), a2, voffA);
            PG8_BAR; PG8_WAIT_L(0); PG8_MMA(1, 0, At, B0); PG8_BAR; PG8_SCHED;
            PG8_STAGE(PG8_SB(0, 1), b2 + hstep, voffB);
            PG8_WAIT_V(6); PG8_BAR; PG8_MMA(1, 1, At, B1); PG8_BAR;
            PG8_LDB(B0, 1, 0); PG8_SCHED; PG8_LDA(At, 1, 0); PG8_STAGE(PG8_SA(0, 1), a2 + hstep, voffA);
            PG8_WAIT_L(8); PG8_BAR; PG8_WAIT_L(0); PG8_MMA(0, 0, At, B0); PG8_BAR; PG8_SCHED;
            PG8_LDB(B1, 1, 1); PG8_STAGE(PG8_SB(1, 0), b3, voffB);
            PG8_BAR; PG8_WAIT_L(0); PG8_MMA(0, 1, At, B1); PG8_BAR;
            PG8_LDA(At, 1, 1); PG8_STAGE(PG8_SA(1, 0), a3, voffA);
            PG8_BAR; PG8_WAIT_L(0); PG8_MMA(1, 0, At, B0); PG8_BAR; PG8_SCHED;
            PG8_STAGE(PG8_SB(1, 1), b3 + hstep, voffB);
            PG8_WAIT_V(6); PG8_BAR; PG8_MMA(1, 1, At, B1); PG8_BAR;
            }
        }
        if constexpr (ALIGN_EPI) { if (wr == 0) PG8_BAR; }
        if constexpr (!Epi::AFTER_DRAIN) { E(acc, cur, wr, wc, fr, fq); S.done(cur); }
        if (!has_next) break;
#pragma unroll
        for (int a = 0; a < 2; ++a)
#pragma unroll
            for (int b = 0; b < 2; ++b)
#pragma unroll
                for (int m = 0; m < 4; ++m)
#pragma unroll
                    for (int n = 0; n < 2; ++n) acc[a][b][m][n] = (f32x4){0.f, 0.f, 0.f, 0.f};
        cur = nxt; cA = nA; cB = nB; ++ui;
        if constexpr (ALIGN_EPI) { if (wr == 1) PG8_BAR; }
    }
    PG8_WAIT_V(0);
    if constexpr (!ALIGN_EPI) { if (wr == 0) PG8_BAR; }
    PG8_BAR;
    if constexpr (Epi::AFTER_DRAIN) { E.fused(acc, cur, wr, wc, fr, fq, lds, wid, lane); S.done(cur); }
#undef PG8_SA
#undef PG8_SB
#undef PG8_STAGE
#undef PG8_LDA
#undef PG8_LDB
#undef PG8_MMA
#undef PG8_WAIT_V
#undef PG8_WAIT_L
#undef PG8_BAR
#undef PG8_SCHED
}
}
#define GAS __attribute__((address_space(1)))
typedef unsigned short bf16;
typedef short bf16x8 __attribute__((ext_vector_type(8)));
typedef short s16x4 __attribute__((ext_vector_type(4)));
typedef float f32x2 __attribute__((ext_vector_type(2)));
typedef float f32x4 __attribute__((ext_vector_type(4)));
typedef float f32x16 __attribute__((ext_vector_type(16)));
typedef unsigned u32x2 __attribute__((ext_vector_type(2)));
typedef unsigned u32x4 __attribute__((ext_vector_type(4)));
using pg8::cvt_pk_bf16; using pg8::fast_sigmoid; using pg8::gelu_tanh;
#define LDS_WAIT() asm volatile("s_waitcnt lgkmcnt(0)" ::: "memory")
#define VM_WAIT() asm volatile("s_waitcnt vmcnt(0)" ::: "memory")

constexpr int DM = 2048, NB = 4, SEQ = 2048, MP = NB * SEQ  , SB = 8, ST = 4, MS = SB * ST  , MR = MP + MS  , MPAD = 8448;
constexpr int PAST = 16384, NPOOL = 1280, INW = 3608, INWP = 3840, DFF = 5632, NG = 64  ;
constexpr float EPS = 1e-6f, SM_SCALE = 0.08838834764831845f;
constexpr int NIN = 35;
enum { I_XP = 0, I_XS, I_CCMP, I_CSLC, I_SWIN, I_SSSM, I_PT, I_NMIX, I_WIN, I_ARE, I_AIM, I_LDT, I_BRE, I_BIM, I_CRE, I_CIM, I_D, I_WGLU, I_QN, I_KNC, I_KNS, I_KNW,
       I_W1K, I_B1K, I_W2K, I_W1V, I_B1V, I_W2V, I_NSSM, I_NATT, I_WOUT, I_NFFN, I_WG, I_WU, I_WD };
constexpr size_t O_YP = 0, O_YS = O_YP + (size_t)MP * DM, O_CMPP = O_YS + (size_t)MS * DM, O_SLCP = O_CMPP + 2ull * MP * 512, O_WINP = O_SLCP + 2ull * MP * 512,
                 O_SSMP = O_WINP + 2ull * NB * 512 * 512, O_CMPS = O_SSMP + 2ull * NB * 64 * 128, O_SLCS = O_CMPS + 2ull * MS * 512, O_WINS = O_SLCS + 2ull * MS * 512,
                 O_SSMS = O_WINS + 2ull * SB * 512 * 512, O_END = O_SSMS + 2ull * SB * 64 * 128;
constexpr size_t WS_CTL = 0, CTL_BYTES = 1u << 20;
constexpr size_t WS_WIN = CTL_BYTES;
constexpr size_t WS_WGLU = WS_WIN + 2ull * INWP * DM * 2;
constexpr size_t WS_WOUT = WS_WGLU + 2ull * 1024 * 1024 * 2;
constexpr size_t WS_WGU = WS_WOUT + 2ull * DM * DM * 2;
constexpr size_t WS_WDN = WS_WGU + 2ull * 2 * DFF * DM * 2;
constexpr size_t WS_W1C = WS_WDN + 2ull * DM * DFF * 2;
constexpr size_t WS_W2T = WS_W1C + 2ull * 2 * 256 * 2048 * 2;
constexpr size_t WS_TG = WS_W2T + 2ull * 2 * 128 * 128 * 2;
constexpr size_t WS_EG = WS_TG + 2ull * 64 * 256 * 256 * 2;
constexpr size_t WS_FG = WS_EG + 2ull * 64 * 128 * 256 * 2;
constexpr size_t WS_LAM1 = WS_FG + 2ull * 64 * 256 * 128 * 2;
constexpr size_t WS_LAM16 = WS_LAM1 + 2ull * 64 * 64 * 2 * 4;
constexpr size_t WS_BBAR = WS_LAM16 + 2ull * 64 * 64 * 2 * 4;
constexpr size_t WS_CA = WS_BBAR + 2ull * 64 * 64 * 16 * 2 * 4;
constexpr size_t WS_TBS = WS_CA + 2ull * 2 * 8 * 2 * 16384 * 128 * 2;
constexpr size_t WS_TBP = WS_TBS + 4ull * 16384 * 256 * 4;
constexpr size_t WS_CKVS = WS_TBP + 2048ull * 256 * 4;
constexpr size_t WS_CKVP = WS_CKVS + 2ull * 2 * 8 * 2 * 1024 * 128 * 2;
constexpr size_t WS_XN = WS_CKVP + 2ull * 4 * 2 * 128 * 128 * 2;
constexpr size_t WS_U = WS_XN + (size_t)MPAD * DM * 2;
constexpr size_t WS_US = WS_U + 4ull * 64 * 2048 * 16 * 2;
constexpr size_t WS_Q = WS_US + 32ull * 1024 * 2;
constexpr size_t WS_KVRAW = WS_Q + (size_t)MPAD * 1024 * 2;
constexpr size_t WS_KVC = WS_KVRAW + (size_t)MPAD * 1536 * 4;
constexpr size_t WS_KVS = WS_KVC + 2ull * 4 * 2 * 2048 * 128 * 2;
constexpr size_t WS_KVW = WS_KVS + 2ull * 4 * 2 * 2048 * 128 * 2;
constexpr size_t WS_GT = WS_KVW + 2ull * 4 * 2 * 2048 * 128 * 2;
constexpr size_t WS_Z = WS_GT + (size_t)MPAD * 32 * 4;
constexpr size_t WS_SSMY = WS_Z + (size_t)MPAD * 1024 * 2;
constexpr size_t WS_ATT = WS_SSMY + (size_t)MPAD * 1024 * 2;
constexpr size_t WS_H = WS_ATT + (size_t)MPAD * 1024 * 4;
constexpr size_t WS_YA = WS_H + (size_t)MPAD * DM * 2;
constexpr size_t WS_YB = WS_YA + (size_t)MPAD * DM * 4;
constexpr size_t WS_HN = WS_YB + (size_t)MPAD * DM * 4;
constexpr size_t WS_HMID = WS_HN + (size_t)MPAD * DM * 2;
constexpr size_t WS_PS = WS_HMID + (size_t)MPAD * DFF * 2;
constexpr size_t WS_PSS = WS_PS + (size_t)MPAD * 32 * 4;
constexpr size_t WS_END = WS_PSS + 32ull * 128 * 4;
static_assert(WS_END < 1500ull * 1024 * 1024, "ws map");
constexpr int CW_BAR = 4096;
constexpr int LDS_BYTES = 159744, MISC_OFF = LDS_BYTES - 64, LDS_RS = 131072;

#define LAS __attribute__((address_space(3)))
#define XB_TMO      128
#define XB_XCNT(j)  (256  + 64 * (j))
#define XB_XSUB(j)  (1280 + 64 * (j))
#define XB_XGEN(j)  (2304 + 64 * (j))
#define XB_TOP      3328
#define XB_TOPGEN   3392
#define XCD_BAR_WORDS 3456
#define XB_SPIN_CAP (1u << 18)
#define LAS __attribute__((address_space(3)))

__device__ __forceinline__ unsigned xb_ld(unsigned* p)              { return __hip_atomic_load(p, __ATOMIC_RELAXED, __HIP_MEMORY_SCOPE_AGENT); }
__device__ __forceinline__ unsigned xb_add(unsigned* p, unsigned v) { return __hip_atomic_fetch_add(p, v, __ATOMIC_RELAXED, __HIP_MEMORY_SCOPE_AGENT); }
__device__ __forceinline__ unsigned xb_xcc_id() { return (unsigned)__builtin_amdgcn_s_getreg((3 << 11) | 20) & 0xFu; }
#define XB_SPIN(cond, bar) do { unsigned _sp = 0; while (cond) { __builtin_amdgcn_s_sleep(1); \
    if ((++_sp & 255u) == 0u) { if (xb_ld(&(bar)[XB_TMO])) break; if (_sp > XB_SPIN_CAP) { atomicAdd(&(bar)[XB_TMO], 1u); break; } } } } while (0)

struct XcdBarrier {
    unsigned* bar; unsigned x;
    volatile LAS unsigned* st;
};

__device__ __forceinline__ XcdBarrier xcd_barrier_post(unsigned* bar, volatile LAS unsigned* st) {
    XcdBarrier b; b.bar = bar; b.x = xb_xcc_id(); b.st = st;
    if (threadIdx.x == 0) (void)xb_add(&bar[XB_XCNT(b.x)], 1u);
    return b;
}
__device__ __forceinline__ void xcd_barrier_complete(unsigned* bar, unsigned x, unsigned& nloc, unsigned& nx) {
    const unsigned G = gridDim.x * gridDim.y * gridDim.z;
    unsigned sum, cnt, mine, sp = 0u;
    for (;;) {
        sum = 0u; cnt = 0u; mine = 0u;
#pragma unroll
        for (unsigned j = 0; j < 16; ++j) { const unsigned c = xb_ld(&bar[XB_XCNT(j)]); sum += c; cnt += (c > 0u) ? 1u : 0u; mine = (j == x) ? c : mine; }
        if (sum == G) break;
        __builtin_amdgcn_s_sleep(1);
        if ((++sp & 255u) == 0u) { if (xb_ld(&bar[XB_TMO])) break; if (sp > XB_SPIN_CAP) { atomicAdd(&bar[XB_TMO], 1u); break; } }
    }
    nloc = mine > 0u ? mine : 1u; nx = cnt > 0u ? cnt : 1u;
}

__device__ __forceinline__ void xcd_barrier(const XcdBarrier& b) {
    asm volatile("s_waitcnt vmcnt(0)" ::: "memory");
    __syncthreads();
    if (threadIdx.x == 0) {
        unsigned* bar = b.bar;
        __builtin_amdgcn_s_waitcnt(0);
        unsigned nloc = b.st[0], nx = b.st[1];
        if (nloc == 0u) { xcd_barrier_complete(bar, b.x, nloc, nx); b.st[0] = nloc; b.st[1] = nx; }
        const unsigned old = xb_add(&bar[XB_XSUB(b.x)], 1u);
        const unsigned gen = old / nloc;
        if (old + 1u == (gen + 1u) * nloc) {
            __builtin_amdgcn_fence(__ATOMIC_RELEASE, "agent");
            asm volatile("s_waitcnt vmcnt(0)" ::: "memory");
            const unsigned og = xb_add(&bar[XB_TOP], 1u);
            const unsigned tg = og / nx;
            if (og + 1u == (tg + 1u) * nx) xb_add(&bar[XB_TOPGEN], 1u);
            else XB_SPIN(xb_ld(&bar[XB_TOPGEN]) == tg, bar);
            __builtin_amdgcn_fence(__ATOMIC_ACQUIRE, "agent");
            xb_add(&bar[XB_XGEN(b.x)], 1u);
            asm volatile("s_waitcnt vmcnt(0)" ::: "memory");
        } else {
            XB_SPIN(xb_ld(&bar[XB_XGEN(b.x)]) == gen, bar);
            __builtin_amdgcn_fence(__ATOMIC_ACQUIRE, "agent");
            asm volatile("s_waitcnt vmcnt(0)" ::: "memory");
        }
    }
    __syncthreads();
}


struct Args { const float* in[NIN]; float* out; unsigned char* ws; int ph_lo, ph_hi; };
typedef const GAS float* cfp_t; typedef const cfp_t __attribute__((address_space(4)))* InArr;
struct InTab { InArr p; __device__ __forceinline__ const float* operator[](int i) const { return (const float*)p[i]; } };
struct Ctx {
    LAS unsigned char* lds; int tid, lane, wid, G, wg;
    InTab in; float* out; unsigned char* ws;
};
__device__ __forceinline__ float wave_sum(float v) {
#pragma unroll
    for (int o = 1; o < 64; o <<= 1) v += __shfl_xor(v, o);
    return v;
}
__device__ __forceinline__ float wave_max(float v) {
#pragma unroll
    for (int o = 1; o < 64; o <<= 1) v = fmaxf(v, __shfl_xor(v, o));
    return v;
}
__device__ __forceinline__ float bf2f(unsigned short b) { return __uint_as_float(((unsigned)b) << 16); }
__device__ __forceinline__ float bflo(unsigned w) { return __uint_as_float(w << 16); }
__device__ __forceinline__ float bfhi(unsigned w) { return __uint_as_float(w & 0xffff0000u); }
__device__ __forceinline__ unsigned short f2bf(float f) { return (unsigned short)(cvt_pk_bf16(f, 0.f) & 0xffffu); }

__device__ __forceinline__ void transpose_item(const float* W, int ldw, int nvalid, bf16* WT, int ldt, int k0, int n0, int drow0, LAS float* scr, int lane, const float* kg = nullptr) {
    const int nn = lane & 31;
    float wv[32];
#pragma unroll
    for (int i = 0; i < 32; ++i) { const int kk = 2 * i + (lane >> 5); wv[i] = (nn < nvalid) ? W[(size_t)(k0 + kk) * ldw + n0 + nn] : 0.f; }
#pragma unroll
    for (int i = 0; i < 32; ++i) { const int kk = 2 * i + (lane >> 5); scr[kk * 33 + nn] = kg ? wv[i] * kg[k0 + kk] : wv[i]; }
    LDS_WAIT(); asm volatile("" ::: "memory");
    const int c = lane & 7;
#pragma unroll
    for (int j = 0; j < 4; ++j) { const int n = (lane >> 3) + 8 * j; const LAS float* s = scr + (8 * c) * 33 + n;
        u32x4 o; o.x = cvt_pk_bf16(s[0 * 33], s[1 * 33]); o.y = cvt_pk_bf16(s[2 * 33], s[3 * 33]); o.z = cvt_pk_bf16(s[4 * 33], s[5 * 33]); o.w = cvt_pk_bf16(s[6 * 33], s[7 * 33]);
        *(u32x4*)(WT + (size_t)(drow0 + n) * ldt + k0 + 8 * c) = o; }
    LDS_WAIT(); asm volatile("" ::: "memory");
}
constexpr int TI_IN = 32 * 113, TI_GLU = 16 * 32, TI_OUT = 32 * 64, TI_G = 32 * 176, TI_DN = 88 * 64, TI_W1 = 4 * 32 * 4, TI_W2 = 2 * 2 * 4;
constexpr int TI_LAYER = TI_IN + TI_GLU + TI_OUT + 2 * TI_G + TI_DN + TI_W1 + TI_W2;
constexpr int TI_IN_DEF = 2048;
__device__ __forceinline__ void weight_item(const Ctx& C, int item, LAS float* scr) {
    const int l = item / TI_LAYER; int r = item % TI_LAYER; unsigned char* ws = C.ws; const int lane = C.lane;
    if (r < TI_IN) { const int kb = r / 113, nb = r % 113, n0 = 32 * nb; const int nv = (INW - n0) < 32 ? (INW - n0) : 32;
        transpose_item(C.in[I_WIN] + (size_t)l * DM * INW, INW, nv, (bf16*)(ws + WS_WIN) + (size_t)l * INWP * DM, DM, 64 * kb, n0, n0, scr, lane, l == 1 ? C.in[I_NMIX] + DM : nullptr); return; } r -= TI_IN;
    if (r < TI_GLU) { const int kb = r / 32, nb = r % 32;
        transpose_item(C.in[I_WGLU] + (size_t)l * 1024 * 1024, 1024, 32, (bf16*)(ws + WS_WGLU) + (size_t)l * 1024 * 1024, 1024, 64 * kb, 32 * nb, 32 * nb, scr, lane); return; } r -= TI_GLU;
    if (r < TI_OUT) { const int kb = r / 64, nb = r % 64;
        transpose_item(C.in[I_WOUT] + (size_t)l * DM * DM, DM, 32, (bf16*)(ws + WS_WOUT) + (size_t)l * DM * DM, DM, 64 * kb, 32 * nb, 32 * nb, scr, lane); return; } r -= TI_OUT;
    if (r < 2 * TI_G) { const int up = r / TI_G; r %= TI_G; const int kb = r / 176, nb = r % 176, n0 = 32 * nb;
        transpose_item(C.in[up ? I_WU : I_WG] + (size_t)l * DM * DFF, DFF, 32, (bf16*)(ws + WS_WGU) + (size_t)l * 2 * DFF * DM, DM, 64 * kb, n0, 256 * (n0 >> 7) + (n0 & 127) + 128 * up, scr, lane, C.in[I_NFFN] + l * DM); return; } r -= 2 * TI_G;
    if (r < TI_DN) { const int kb = r / 64, nb = r % 64;
        transpose_item(C.in[I_WD] + (size_t)l * DFF * DM, DM, 32, (bf16*)(ws + WS_WDN) + (size_t)l * DM * DFF, DFF, 64 * kb, 32 * nb, 32 * nb, scr, lane); return; } r -= TI_DN;
    if (r < TI_W1) { const int which = r / 128, rr = r % 128, kb = rr / 4, nb = rr % 4;
        transpose_item(C.in[which < 2 ? I_W1K : I_W1V] + (size_t)l * 4096 * 128 + (size_t)(which & 1) * 2048 * 128, 128, 32,
                       (bf16*)(ws + WS_W1C) + (size_t)(l * 2 + (which >> 1)) * 256 * 2048, 2048, 64 * kb, 32 * nb, (which & 1) * 128 + 32 * nb, scr, lane); return; } r -= TI_W1;
    { const int which = r / 8, rr = r % 8, kb = rr / 4, nb = rr % 4;
        transpose_item(C.in[which ? I_W2V : I_W2K] + (size_t)l * 128 * 128, 128, 32, (bf16*)(ws + WS_W2T) + (size_t)(l * 2 + which) * 128 * 128, 128, 64 * kb, 32 * nb, 32 * nb, scr, lane); }
}
__device__ __forceinline__ void norm_row_2048(const float* x, const float* g, bf16* o, int lane) {
    f32x4 v[8], gv[8]; float s = 0.f;
#pragma unroll
    for (int j = 0; j < 8; ++j) { v[j] = *(const f32x4*)(x + 4 * lane + 256 * j); gv[j] = *(const f32x4*)(g + 4 * lane + 256 * j); }
#pragma unroll
    for (int j = 0; j < 8; ++j) s += (v[j][0] * v[j][0] + v[j][1] * v[j][1]) + (v[j][2] * v[j][2] + v[j][3] * v[j][3]);
    const float rstd = 1.0f / sqrtf(wave_sum(s) * (1.0f / 2048.0f) + EPS);
#pragma unroll
    for (int j = 0; j < 8; ++j) { const f32x4 gg = gv[j]; u32x2 w; w.x = cvt_pk_bf16(v[j][0] * rstd * gg[0], v[j][1] * rstd * gg[1]); w.y = cvt_pk_bf16(v[j][2] * rstd * gg[2], v[j][3] * rstd * gg[3]);
        *(u32x2*)(o + 4 * lane + 256 * j) = w; }
}
__device__ __forceinline__ void norm_pass(const Ctx& C, const float* xp, const float* xs, const float* g, bf16* XO) {
    const int gw = C.wg * 8 + C.wid, NGW = C.G * 8;
    for (int r = gw; r < MR; r += NGW) norm_row_2048(r < MP ? xp + (size_t)r * DM : xs + (size_t)(r - MP) * DM, g, XO + (size_t)r * DM, C.lane);
}
__device__ __forceinline__ double exp_d(double x) {
    int m = 0; while (fabs(x) > 0.5) { x *= 0.5; ++m; }
    double t = 1.0, s = 1.0;
#pragma unroll
    for (int i = 1; i <= 18; ++i) { t *= x * (1.0 / (double)i); s += t; }
    for (int i = 0; i < m; ++i) s *= s;
    return s;
}
__device__ __forceinline__ void sincos_d(double x, double& sn, double& cs) {
    const double k = rint(x * 0.63661977236758134308);
    double r = fma(-k, 1.57079632679489655800, x); r = fma(-k, 6.12323399573676603587e-17, r);
    const int q = (int)((long long)k & 3ll);
    const double r2 = r * r;
    double sp = 1.0 / 6227020800.0; sp = sp * r2 - 1.0 / 39916800.0; sp = sp * r2 + 1.0 / 362880.0; sp = sp * r2 - 1.0 / 5040.0; sp = sp * r2 + 1.0 / 120.0; sp = sp * r2 - 1.0 / 6.0; sp = sp * r2 + 1.0; sp *= r;
    double cp = -1.0 / 87178291200.0; cp = cp * r2 + 1.0 / 479001600.0; cp = cp * r2 - 1.0 / 3628800.0; cp = cp * r2 + 1.0 / 40320.0; cp = cp * r2 - 1.0 / 720.0; cp = cp * r2 + 1.0 / 24.0; cp = cp * r2 - 0.5; cp = cp * r2 + 1.0;
    sn = (q == 0) ? sp : (q == 1) ? cp : (q == 2) ? -sp : -cp;
    cs = (q == 0) ? cp : (q == 1) ? -sp : (q == 2) ? -cp : sp;
}
__device__ __forceinline__ void ssm_precompute(const Ctx& C, int l, int g) {
    LAS float* lpr = (LAS float*)C.lds;
    LAS float* lpi = lpr + 17 * 64;
    LAS float* Bbr = lpi + 17 * 64;
    LAS float* Bbi = Bbr + 1024;
    LAS float* Ccr = Bbi + 1024;
    LAS float* Cci = Ccr + 1024;
    LAS float* Kt = Cci + 1024;
    LAS float* CTr = Kt + 4096;
    LAS float* CTi = CTr + 1024;
    const int tid = C.tid; const int lg = l * NG + g;
    for (int idx = tid; idx < 17 * 64; idx += 512) { const int tau = idx >> 6, n = idx & 63;
        const double are = (double)C.in[I_ARE][lg * 64 + n], aim = (double)C.in[I_AIM][lg * 64 + n], dt = exp_d((double)C.in[I_LDT][lg]);
        const double mag = exp_d(are * dt * tau), ang = aim * dt * tau; double sn, cs; sincos_d(ang, sn, cs);
        lpr[tau * 64 + n] = (float)(mag * cs); lpi[tau * 64 + n] = (float)(mag * sn); }
    if (tid < 64) { const int n = tid;
        const double are = (double)C.in[I_ARE][lg * 64 + n], aim = (double)C.in[I_AIM][lg * 64 + n], dt = exp_d((double)C.in[I_LDT][lg]);
        f32x4 brv[4], biv[4];
#pragma unroll
        for (int q = 0; q < 4; ++q) { brv[q] = *(const f32x4*)(C.in[I_BRE] + (size_t)(lg * 64 + n) * 16 + 4 * q); biv[q] = *(const f32x4*)(C.in[I_BIM] + (size_t)(lg * 64 + n) * 16 + 4 * q); }
        const double mag = exp_d(are * dt), ang = aim * dt; double sn, cs; sincos_d(ang, sn, cs); const double l1r = mag * cs, l1i = mag * sn;
        const double nr = l1r - 1.0, ni = l1i, den = are * are + aim * aim; const double cfr = (nr * are + ni * aim) / den, cfi = (ni * are - nr * aim) / den;
        float* bb = (float*)(C.ws + WS_BBAR) + (size_t)(lg * 64 + n) * 32;
#pragma unroll
        for (int p = 0; p < 16; ++p) { const double br = (double)brv[p >> 2][p & 3], bi = (double)biv[p >> 2][p & 3];
            const float xr = (float)(cfr * br - cfi * bi), xi = (float)(cfr * bi + cfi * br); Bbr[n * 16 + p] = xr; Bbi[n * 16 + p] = xi; bb[2 * p] = xr; bb[2 * p + 1] = xi; }
        float* o1 = (float*)(C.ws + WS_LAM1) + (size_t)(lg * 64 + n) * 2; o1[0] = (float)l1r; o1[1] = (float)l1i;
        { const double m16 = exp_d(are * dt * 16.0), a16 = aim * dt * 16.0; double s16, c16; sincos_d(a16, s16, c16); float* o16 = (float*)(C.ws + WS_LAM16) + (size_t)(lg * 64 + n) * 2; o16[0] = (float)(m16 * c16); o16[1] = (float)(m16 * s16); }
    }
    for (int i = tid; i < 1024; i += 512) { const float cr = C.in[I_CRE][(size_t)lg * 1024 + i], ci = C.in[I_CIM][(size_t)lg * 1024 + i]; Ccr[i] = cr; Cci[i] = ci; CTr[(i & 63) * 16 + (i >> 6)] = cr; CTi[(i & 63) * 16 + (i >> 6)] = ci; }
    __syncthreads();
    {
        const int tau = tid >> 5, p = (tid >> 1) & 15, h = tid & 1; float s8[8];
#pragma unroll
        for (int j = 0; j < 8; ++j) s8[j] = 0.f;
        for (int n = 0; n < 64; ++n) { const float cr = CTr[n * 16 + p], ci = CTi[n * 16 + p], lr = lpr[tau * 64 + n], li = lpi[tau * 64 + n]; const float wr = cr * lr - ci * li, wi = cr * li + ci * lr;
            const f32x4 b0 = *(const LAS f32x4*)(Bbr + n * 16 + 8 * h), b1 = *(const LAS f32x4*)(Bbr + n * 16 + 8 * h + 4), c0 = *(const LAS f32x4*)(Bbi + n * 16 + 8 * h), c1 = *(const LAS f32x4*)(Bbi + n * 16 + 8 * h + 4);
#pragma unroll
            for (int j = 0; j < 4; ++j) { s8[j] += wr * b0[j] - wi * c0[j]; s8[4 + j] += wr * b1[j] - wi * c1[j]; } }
        const float dsk = C.in[I_D][lg * 16 + p];
#pragma unroll
        for (int j = 0; j < 8; ++j) { if (tau == 0 && p == 8 * h + j) s8[j] += dsk; }
        *(LAS f32x4*)(Kt + (tau << 8) + p * 16 + 8 * h) = (f32x4){s8[0], s8[1], s8[2], s8[3]}; *(LAS f32x4*)(Kt + (tau << 8) + p * 16 + 8 * h + 4) = (f32x4){s8[4], s8[5], s8[6], s8[7]};
    }
    __syncthreads();
    bf16* TG = (bf16*)(C.ws + WS_TG) + (size_t)lg * 65536; bf16* EG = (bf16*)(C.ws + WS_EG) + (size_t)lg * 32768; bf16* FG = (bf16*)(C.ws + WS_FG) + (size_t)lg * 32768;
    for (int i8 = tid; i8 < 8192; i8 += 512) { const int row = i8 >> 5, c8 = i8 & 31, tq = row >> 4, p = row & 15, s = c8 >> 1, pp0 = (c8 & 1) * 8; u32x4 w = (u32x4){0u, 0u, 0u, 0u};
        if (tq >= s) { const LAS float* kp = Kt + ((tq - s) << 8) + p * 16 + pp0; const f32x4 k0 = *(const LAS f32x4*)kp, k1 = *(const LAS f32x4*)(kp + 4);
            w.x = cvt_pk_bf16(k0[0], k0[1]); w.y = cvt_pk_bf16(k0[2], k0[3]); w.z = cvt_pk_bf16(k1[0], k1[1]); w.w = cvt_pk_bf16(k1[2], k1[3]); }
        *(u32x4*)(TG + (size_t)i8 * 8) = w; }
    for (int i8 = tid; i8 < 4096; i8 += 512) { const int n2 = i8 >> 5, c8 = i8 & 31, s = c8 >> 1, pp0 = (c8 & 1) * 8, n = n2 & 63; const int tau = 15 - s;
        const float lr = lpr[tau * 64 + n], li = lpi[tau * 64 + n]; const LAS float* bp = Bbr + n * 16 + pp0; const LAS float* cp = Bbi + n * 16 + pp0;
        const f32x4 b0 = *(const LAS f32x4*)bp, b1 = *(const LAS f32x4*)(bp + 4), c0 = *(const LAS f32x4*)cp, c1 = *(const LAS f32x4*)(cp + 4); float e[8];
#pragma unroll
        for (int j = 0; j < 4; ++j) { e[j] = n2 < 64 ? (lr * b0[j] - li * c0[j]) : (lr * c0[j] + li * b0[j]); e[4 + j] = n2 < 64 ? (lr * b1[j] - li * c1[j]) : (lr * c1[j] + li * b1[j]); }
        u32x4 w; w.x = cvt_pk_bf16(e[0], e[1]); w.y = cvt_pk_bf16(e[2], e[3]); w.z = cvt_pk_bf16(e[4], e[5]); w.w = cvt_pk_bf16(e[6], e[7]);
        *(u32x4*)(EG + (size_t)i8 * 8) = w; }
    for (int i8 = tid; i8 < 4096; i8 += 512) { const int row = i8 >> 4, q0 = (i8 & 15) * 8, n0 = q0 & 63, tq = row >> 4, p = row & 15; const int tau = tq + 1;
        const LAS float* a0 = Ccr + p * 64 + n0; const LAS float* a1 = Cci + p * 64 + n0; const LAS float* a2 = lpr + tau * 64 + n0; const LAS float* a3 = lpi + tau * 64 + n0;
        const f32x4 cr0 = *(const LAS f32x4*)a0, cr1 = *(const LAS f32x4*)(a0 + 4), ci0 = *(const LAS f32x4*)a1, ci1 = *(const LAS f32x4*)(a1 + 4), lr0 = *(const LAS f32x4*)a2, lr1 = *(const LAS f32x4*)(a2 + 4), li0 = *(const LAS f32x4*)a3, li1 = *(const LAS f32x4*)(a3 + 4); float e[8];
#pragma unroll
        for (int j = 0; j < 4; ++j) { e[j] = q0 < 64 ? (cr0[j] * lr0[j] - ci0[j] * li0[j]) : -(cr0[j] * li0[j] + ci0[j] * lr0[j]); e[4 + j] = q0 < 64 ? (cr1[j] * lr1[j] - ci1[j] * li1[j]) : -(cr1[j] * li1[j] + ci1[j] * lr1[j]); }
        u32x4 w; w.x = cvt_pk_bf16(e[0], e[1]); w.y = cvt_pk_bf16(e[2], e[3]); w.z = cvt_pk_bf16(e[4], e[5]); w.w = cvt_pk_bf16(e[6], e[7]);
        *(u32x4*)(FG + (size_t)i8 * 8) = w; }
    __syncthreads();
}
__device__ __forceinline__ void p0_prologue(const Ctx& C) {
    const int gw = C.wg * 8 + C.wid, NGW = C.G * 8, lane = C.lane;
    for (int u = C.wg; u < 2 * NG; u += C.G) ssm_precompute(C, u / NG, u % NG);
    __syncthreads();
    LAS float* scr = (LAS float*)(C.lds + C.wid * 16384);
    if (C.G == 256) {
        for (int idx = gw; idx < 2 * TI_LAYER - (TI_GLU + TI_OUT + TI_DN + TI_IN_DEF); idx += NGW) { int it = idx;
            if (idx >= TI_LAYER) { const int j = idx - TI_LAYER + TI_IN_DEF; it = TI_LAYER + (j < TI_IN ? j : (j < TI_IN + 2 * TI_G ? j + TI_GLU + TI_OUT : j + TI_GLU + TI_OUT + TI_DN)); }
            weight_item(C, it, scr); }
    } else
    for (int it = gw; it < 2 * TI_LAYER; it += NGW) weight_item(C, it, scr);
    norm_pass(C, C.in[I_XP], C.in[I_XS], C.in[I_NMIX], (bf16*)(C.ws + WS_XN));
    { const size_t gt = (size_t)C.wg * 512 + C.tid, NT = (size_t)C.G * 512; const size_t per = 508ull * 512 / 4;
        const float* swin = C.in[I_SWIN];
        for (size_t i0 = gt; i0 < 2ull * SB * per; i0 += 8 * NT) { f32x4 v[8];
#pragma unroll
            for (int k = 0; k < 8; ++k) { const size_t i = i0 + (size_t)k * NT; if (i < 2ull * SB * per) { const size_t ls = i / per, j = i % per; v[k] = *(const f32x4*)(swin + ls * 512 * 512 + 4 * 512 + 4 * j); } }
#pragma unroll
            for (int k = 0; k < 8; ++k) { const size_t i = i0 + (size_t)k * NT; if (i < 2ull * SB * per) { const size_t ls = i / per, j = i % per; *(f32x4*)(C.out + O_WINS + ls * 512 * 512 + 4 * j) = v[k]; } } } }
}

__device__ __forceinline__ void cmp1_sample_unit(const Ctx& C, int u, int variant = 0) {
    constexpr int BP = 136;
    const int blk = u & 7, kvh = (u >> 3) & 1, sb = (u >> 4) & 7, kv = (u >> 7) & 1, l = u >> 8;
    int tid = C.tid; asm volatile("" : "+v"(tid)); const int lane = tid & 63, wid = C.wid, fr = lane & 15, fq = lane >> 4;
    LAS bf16* Bl = (LAS bf16*)C.lds;
    const bf16* W = (const bf16*)(C.ws + WS_W1C) + (size_t)(l * 2 + kv) * 256 * 2048;
    const int* pt = (const int*)C.in[I_PT];
    const int irow = blk * 128 + 8 * fr + wid;
    const float* rp = C.in[I_CCMP] + ((((size_t)l * NPOOL + pt[sb * 128 + (irow >> 3)]) * 128 + ((16 * irow) & 127)) * 2 + kvh) * 256 + kv * 128 + 8 * fq;
    f32x4 acc[16];
#pragma unroll
    for (int nb = 0; nb < 16; ++nb) acc[nb] = (f32x4){0.f, 0.f, 0.f, 0.f};
    u32x4 breg[8];
#pragma unroll
    for (int j = 0; j < 8; ++j) { const int p = tid + 512 * j; breg[j] = *(const u32x4*)(W + (size_t)(p >> 4) * 2048 + (p & 15) * 8); }
#pragma unroll
    for (int j = 0; j < 8; ++j) { const int p = tid + 512 * j; *(LAS u32x4*)(Bl + (p >> 4) * BP + (p & 15) * 8) = breg[j]; }
    __syncthreads();
    f32x4 arA[4][2], arB[4][2]; bf16x8 acur[4];
#define CMP1_LOADA(S_, r_) do { if (variant != 7) { _Pragma("unroll") for (int ks = 0; ks < 4; ++ks) { const float* p = rp + (size_t)(r_) * 512 + 32 * ks; S_[ks][0] = *(const f32x4*)p; S_[ks][1] = *(const f32x4*)(p + 4); } } } while (0)
#define CMP1_CVTA(S_) do { _Pragma("unroll") for (int ks = 0; ks < 4; ++ks) { const f32x4 v0 = S_[ks][0], v1 = S_[ks][1]; u32x4 w; \
        w.x = cvt_pk_bf16(v0[0], v0[1]); w.y = cvt_pk_bf16(v0[2], v0[3]); w.z = cvt_pk_bf16(v1[0], v1[1]); w.w = cvt_pk_bf16(v1[2], v1[3]); acur[ks] = __builtin_bit_cast(bf16x8, w); } } while (0)
#define CMP1_STEP(r_, SNEXT_, rload_) do { const int buf = (r_) & 1; \
        if ((r_) + 1 < 16 && variant != 8) { _Pragma("unroll") for (int j = 0; j < 8; ++j) { const int p = tid + 512 * j; breg[j] = *(const u32x4*)(W + (size_t)(p >> 4) * 2048 + ((r_) + 1) * 128 + (p & 15) * 8); } } \
        if (variant != 8) { _Pragma("unroll") for (int ks = 0; ks < 4; ++ks) { _Pragma("unroll") for (int nb = 0; nb < 16; ++nb) { \
            const bf16x8 x = *(const LAS bf16x8*)(Bl + (size_t)buf * 256 * BP + (16 * nb + fr) * BP + 32 * ks + 8 * fq); acc[nb] = __builtin_amdgcn_mfma_f32_16x16x32_bf16(x, acur[ks], acc[nb], 0, 0, 0); \
            if ((nb & 7) == 7) asm volatile("" ::: "memory"); } } } \
        if ((r_) + 1 < 16) { _Pragma("unroll") for (int j = 0; j < 8; ++j) { const int p = tid + 512 * j; *(LAS u32x4*)(Bl + (size_t)(buf ^ 1) * 256 * BP + (p >> 4) * BP + (p & 15) * 8) = breg[j]; } \
            CMP1_CVTA(SNEXT_); if ((rload_) < 16) CMP1_LOADA(SNEXT_, (rload_)); } \
        __syncthreads(); } while (0)
    if (variant == 7) { _Pragma("unroll") for (int ks = 0; ks < 4; ++ks) { arA[ks][0] = (f32x4){0.f, 0.f, 0.f, 0.f}; arA[ks][1] = arA[ks][0]; arB[ks][0] = arA[ks][0]; arB[ks][1] = arA[ks][0]; } }
    CMP1_LOADA(arA, 0); CMP1_CVTA(arA); CMP1_LOADA(arA, 1); CMP1_LOADA(arB, 2);
#pragma unroll 1
    for (int r = 0; r < 16; r += 2) {
        CMP1_STEP(r, arA, r + 3);
        CMP1_STEP(r + 1, arB, r + 4);
    }
#undef CMP1_LOADA
#undef CMP1_CVTA
#undef CMP1_STEP
    float* TB = (float*)(C.ws + WS_TBS) + ((size_t)((((l * 2 + kv) * 8 + sb) * 2 + kvh) * 1024) + irow) * 256 + 4 * fq;
#pragma unroll
    for (int nb = 0; nb < 16; ++nb) *(f32x4*)(TB + 16 * nb) = acc[nb];
}
__device__ __forceinline__ void cmp_stage2_unit(const Ctx& C, const float* TB, size_t tb0, int i0, int imax, const float* b1, const bf16* W2t, const float* gain  , bf16* out0) {
    LAS bf16* Hs = (LAS bf16*)C.lds;
    LAS bf16* Ws = Hs + 128 * 136;
    int tid = C.tid; asm volatile("" : "+v"(tid)); const int lane = tid & 63, wid = C.wid, fr = lane & 15, fq = lane >> 4;
    {   const int c4 = (tid & 31) * 4; const f32x4 bb = *(const f32x4*)(b1 + c4);
        f32x4 tp[8], bt[8];
#pragma unroll
        for (int k = 0; k < 8; ++k) { const int i = i0 + (tid >> 5) + 16 * k; const int i1 = (i + 1 < imax) ? i + 1 : imax;
            tp[k] = *(const f32x4*)(TB + (tb0 + (i < imax ? i : imax)) * 256 + c4); bt[k] = *(const f32x4*)(TB + (tb0 + i1) * 256 + 128 + c4); }
#pragma unroll
        for (int k = 0; k < 8; ++k) { const int r = (tid >> 5) + 16 * k; const f32x4 a = tp[k], b = bt[k];
            u32x2 w; w.x = cvt_pk_bf16(gelu_tanh(a[0] + b[0] + bb[0]), gelu_tanh(a[1] + b[1] + bb[1])); w.y = cvt_pk_bf16(gelu_tanh(a[2] + b[2] + bb[2]), gelu_tanh(a[3] + b[3] + bb[3]));
            *(LAS u32x2*)(Hs + r * 136 + c4) = w; } }
    {   u32x4 wv[4];
#pragma unroll
        for (int k = 0; k < 4; ++k) { const int idx = tid + 512 * k; wv[k] = *(const u32x4*)(W2t + (idx >> 4) * 128 + (idx & 15) * 8); }
#pragma unroll
        for (int k = 0; k < 4; ++k) { const int idx = tid + 512 * k; *(LAS u32x4*)(Ws + (idx >> 4) * 136 + (idx & 15) * 8) = wv[k]; } }
    __syncthreads();
    f32x4 acc[8];
#pragma unroll
    for (int n = 0; n < 8; ++n) acc[n] = (f32x4){0.f, 0.f, 0.f, 0.f};
#pragma unroll
    for (int ks = 0; ks < 4; ++ks) { const bf16x8 y = *(const LAS bf16x8*)(Hs + (16 * wid + fr) * 136 + 32 * ks + 8 * fq);
#pragma unroll
        for (int n = 0; n < 8; ++n) { const bf16x8 x = *(const LAS bf16x8*)(Ws + (16 * n + fr) * 136 + 32 * ks + 8 * fq); acc[n] = __builtin_amdgcn_mfma_f32_16x16x32_bf16(x, y, acc[n], 0, 0, 0); } }
    float rstd = 1.f;
    if (gain) { float ss = 0.f;
#pragma unroll
        for (int n = 0; n < 8; ++n) ss += (acc[n][0] * acc[n][0] + acc[n][1] * acc[n][1]) + (acc[n][2] * acc[n][2] + acc[n][3] * acc[n][3]);
        ss += __shfl_xor(ss, 16); ss += __shfl_xor(ss, 32); rstd = 1.0f / sqrtf(ss * (1.0f / 128.0f) + EPS); }
    bf16* orow = out0 + (size_t)(16 * wid + fr) * 128;
    f32x4 ggv[8];
#pragma unroll
    for (int n = 0; n < 8; ++n) ggv[n] = gain ? *(const f32x4*)(gain + 16 * n + 4 * fq) : (f32x4){1.f, 1.f, 1.f, 1.f};
#pragma unroll
    for (int n = 0; n < 8; ++n) { f32x4 v = acc[n] * rstd; if (gain) { v = v * ggv[n]; }
        u32x2 w; w.x = cvt_pk_bf16(v[0], v[1]); w.y = cvt_pk_bf16(v[2], v[3]); *(u32x2*)(orow + 16 * n + 4 * fq) = w; }
    __syncthreads();
}

__device__ __forceinline__ void kvfix_row(const Ctx& C, int l, int row) {
    const int lane = C.lane; const float* src = (const float*)(C.ws + WS_KVRAW) + (size_t)row * 1536 + 2 * lane;
    const float* gs = C.in[I_KNS] + l * 128 + 2 * lane; const float* gwn = C.in[I_KNW] + l * 128 + 2 * lane;
    bf16* KVS = (bf16*)(C.ws + WS_KVS); bf16* KVW = (bf16*)(C.ws + WS_KVW);
    const bool prompt = row < MP; const int b = row >> 11, t = row & 2047, sb = (row - MP) >> 2, st = (row - MP) & 3;
    f32x2 vin[6][2];
#pragma unroll
    for (int part = 0; part < 6; ++part)
#pragma unroll
        for (int kvh = 0; kvh < 2; ++kvh) vin[part][kvh] = *(const f32x2*)(src + part * 256 + kvh * 128);
    const f32x2 ggs = *(const f32x2*)gs, ggw = *(const f32x2*)gwn;
#pragma unroll
    for (int part = 0; part < 6; ++part)
#pragma unroll
        for (int kvh = 0; kvh < 2; ++kvh) {
            f32x2 v = vin[part][kvh]; const int kv = part & 1, br = part >> 1;
            if (part == 2 || part == 4) { const float ss = wave_sum(v[0] * v[0] + v[1] * v[1]); const float rstd = 1.0f / sqrtf(ss * (1.0f / 128.0f) + EPS); const f32x2 gg = (br == 1) ? ggs : ggw; v = v * rstd * gg; }
            const size_t o512 = (size_t)kvh * 256 + kv * 128 + 2 * lane;
            if (prompt) {
                if (br != 0) { bf16* kb = (br == 1 ? KVS : KVW) + ((size_t)((kv * 4 + b) * 2 + kvh) * 2048 + t) * 128 + 2 * lane; *(unsigned*)kb = cvt_pk_bf16(v[0], v[1]); }
                if (br == 0) *(f32x2*)(C.out + O_CMPP + ((size_t)(l * NB + b) * 2048 + t) * 512 + o512) = v;
                else if (br == 1) *(f32x2*)(C.out + O_SLCP + ((size_t)(l * NB + b) * 2048 + t) * 512 + o512) = v;
                else if (t >= 1536) *(f32x2*)(C.out + O_WINP + ((size_t)(l * NB + b) * 512 + (t - 1536)) * 512 + o512) = v;
            } else {
                if (br == 0) *(f32x2*)(C.out + O_CMPS + ((size_t)(l * SB + sb) * 4 + st) * 512 + o512) = v;
                else if (br == 1) *(f32x2*)(C.out + O_SLCS + ((size_t)(l * SB + sb) * 4 + st) * 512 + o512) = v;
                else *(f32x2*)(C.out + O_WINS + ((size_t)(l * SB + sb) * 512 + 508 + st) * 512 + o512) = v;
            }
        }
}
template <int NR>
__device__ __forceinline__ void mixnorm_rows(const Ctx& C, int l, int row0, int rstride, int nvalid) {
    const int lane = C.lane; const float* g1 = C.in[I_NSSM] + l * 1024; const float* g2 = C.in[I_NATT] + l * 1024;
    f32x4 a[NR][4]; u32x2 sw[NR][4];
#pragma unroll
    for (int i = 0; i < NR; ++i) { const int row = row0 + (i < nvalid ? i : 0) * rstride; const bf16* sy = (const bf16*)(C.ws + WS_SSMY) + (size_t)row * 1024; const float* at = (const float*)(C.ws + WS_ATT) + (size_t)row * 1024;
#pragma unroll
        for (int j = 0; j < 4; ++j) { sw[i][j] = *(const u32x2*)(sy + 4 * lane + 256 * j); a[i][j] = *(const f32x4*)(at + 4 * lane + 256 * j); } }
    f32x4 ga[4], gb[4];
#pragma unroll
    for (int j = 0; j < 4; ++j) { ga[j] = *(const f32x4*)(g1 + 4 * lane + 256 * j); gb[j] = *(const f32x4*)(g2 + 4 * lane + 256 * j); }
#pragma unroll
    for (int i = 0; i < NR; ++i) { if (i < nvalid) { const int row = row0 + i * rstride; bf16* H = (bf16*)(C.ws + WS_H) + (size_t)row * DM; f32x4 s[4]; float s1 = 0.f, s2 = 0.f;
#pragma unroll
        for (int j = 0; j < 4; ++j) { const u32x2 w = sw[i][j]; s[j] = (f32x4){bflo(w.x), bfhi(w.x), bflo(w.y), bfhi(w.y)};
            s1 += (s[j][0] * s[j][0] + s[j][1] * s[j][1]) + (s[j][2] * s[j][2] + s[j][3] * s[j][3]); s2 += (a[i][j][0] * a[i][j][0] + a[i][j][1] * a[i][j][1]) + (a[i][j][2] * a[i][j][2] + a[i][j][3] * a[i][j][3]); }
        const float r1 = 1.0f / sqrtf(wave_sum(s1) * (1.0f / 1024.0f) + EPS), r2 = 1.0f / sqrtf(wave_sum(s2) * (1.0f / 1024.0f) + EPS);
#pragma unroll
        for (int j = 0; j < 4; ++j) { u32x2 w; w.x = cvt_pk_bf16(s[j][0] * r1 * ga[j][0], s[j][1] * r1 * ga[j][1]); w.y = cvt_pk_bf16(s[j][2] * r1 * ga[j][2], s[j][3] * r1 * ga[j][3]); *(u32x2*)(H + 4 * lane + 256 * j) = w;
            w.x = cvt_pk_bf16(a[i][j][0] * r2 * gb[j][0], a[i][j][1] * r2 * gb[j][1]); w.y = cvt_pk_bf16(a[i][j][2] * r2 * gb[j][2], a[i][j][3] * r2 * gb[j][3]); *(u32x2*)(H + 1024 + 4 * lane + 256 * j) = w; } } }
}
template <bool BF32, bool OF32>
__device__ __forceinline__ void sample_gemm_res(const Ctx& C, const bf16* A, const bf16* Bt, int K, const void* base, void* out, int first, int stride, float* PSS) {
    LAS f32x4* red = (LAS f32x4*)C.lds;
    const int lane = C.lane, wid = C.wid, fr = lane & 15, fq = lane >> 4, kw = K / 8;
    for (int cb = first; cb < DM / 16; cb += stride) {
        f32x4 acc0 = (f32x4){0.f, 0.f, 0.f, 0.f}, acc1 = acc0;
        const bf16* bp = Bt + (size_t)(16 * cb + fr) * K + wid * kw + 8 * fq; const bf16* ap0 = A + (size_t)fr * K + wid * kw + 8 * fq; const bf16* ap1 = ap0 + (size_t)16 * K;
        int k = 0;
        for (; k + 128 <= kw; k += 128) { bf16x8 x[4], y0[4], y1[4];
#pragma unroll
            for (int j = 0; j < 4; ++j) { x[j] = *(const bf16x8*)(bp + k + 32 * j); y0[j] = *(const bf16x8*)(ap0 + k + 32 * j); y1[j] = *(const bf16x8*)(ap1 + k + 32 * j); }
#pragma unroll
            for (int j = 0; j < 4; ++j) { acc0 = __builtin_amdgcn_mfma_f32_16x16x32_bf16(x[j], y0[j], acc0, 0, 0, 0); acc1 = __builtin_amdgcn_mfma_f32_16x16x32_bf16(x[j], y1[j], acc1, 0, 0, 0); } }
        for (; k < kw; k += 32) { const bf16x8 x = *(const bf16x8*)(bp + k), y0 = *(const bf16x8*)(ap0 + k), y1 = *(const bf16x8*)(ap1 + k);
            acc0 = __builtin_amdgcn_mfma_f32_16x16x32_bf16(x, y0, acc0, 0, 0, 0); acc1 = __builtin_amdgcn_mfma_f32_16x16x32_bf16(x, y1, acc1, 0, 0, 0); }
        red[(wid * 2 + 0) * 64 + lane] = acc0; red[(wid * 2 + 1) * 64 + lane] = acc1;
        __syncthreads();
        if (C.tid < 128) { const int mb = C.tid >> 6; f32x4 s = red[mb * 64 + lane];
#pragma unroll
            for (int w = 1; w < 8; ++w) s = s + red[(w * 2 + mb) * 64 + lane];
            const size_t off = (size_t)(16 * mb + fr) * DM + 16 * cb + 4 * fq; f32x4 b;
            if (BF32) b = *(const f32x4*)((const float*)base + off); else { const u32x2 w = *(const u32x2*)((const bf16*)base + off); b = (f32x4){bflo(w.x), bfhi(w.x), bflo(w.y), bfhi(w.y)}; }
            const f32x4 v = b + s;
            if (OF32) *(f32x4*)((float*)out + off) = v; else { u32x2 w; w.x = cvt_pk_bf16(v[0], v[1]); w.y = cvt_pk_bf16(v[2], v[3]); *(u32x2*)((bf16*)out + off) = w; }
            if (PSS) { float ss = (v[0] * v[0] + v[1] * v[1]) + (v[2] * v[2] + v[3] * v[3]); ss += __shfl_xor(ss, 16); ss += __shfl_xor(ss, 32); if (fq == 0) PSS[(16 * mb + fr) * 128 + cb] = ss; } }
        __syncthreads();
    }
}

__device__ __forceinline__ void ssm_unit(const Ctx& C, int l, int b, int g) {
    constexpr int UP = 264, SP = 132;
    LAS bf16* Ul = (LAS bf16*)C.lds;
    LAS float* Sl = (LAS float*)(C.lds + 128 * UP * 2);
    int tid = C.tid; asm volatile("" : "+v"(tid)); const int lane = tid & 63, wid = C.wid, fr = lane & 15, fq = lane >> 4, lg = l * NG + g;
    const bf16* Ug = (const bf16*)(C.ws + WS_U) + (size_t)(b * NG + g) * 2048 * 16;
    for (int idx = tid; idx < 4096; idx += 512) { const int c = idx >> 5, o = (idx & 31) * 8; *(LAS u32x4*)(Ul + c * UP + o) = *(const u32x4*)(Ug + c * 256 + o); }
    __syncthreads();
    const bf16* EG = (const bf16*)(C.ws + WS_EG) + (size_t)lg * 32768; const bf16* TG = (const bf16*)(C.ws + WS_TG) + (size_t)lg * 65536; const bf16* FG = (const bf16*)(C.ws + WS_FG) + (size_t)lg * 32768;
    bf16x8 tg0[8], tg1[8];
#pragma unroll
    for (int ks = 0; ks < 8; ++ks) { if (ks <= wid) { tg0[ks] = *(const bf16x8*)(TG + (size_t)(32 * wid + fr) * 256 + 32 * ks + 8 * fq); tg1[ks] = *(const bf16x8*)(TG + (size_t)(32 * wid + 16 + fr) * 256 + 32 * ks + 8 * fq); }
                                     else { tg0[ks] = (bf16x8){0, 0, 0, 0, 0, 0, 0, 0}; tg1[ks] = tg0[ks]; } }
    {
        f32x4 acc[8];
#pragma unroll
        for (int nb = 0; nb < 8; ++nb) acc[nb] = (f32x4){0.f, 0.f, 0.f, 0.f};
#pragma unroll
        for (int ks = 0; ks < 8; ++ks) { const bf16x8 x = *(const bf16x8*)(EG + (size_t)(16 * wid + fr) * 256 + 32 * ks + 8 * fq);
#pragma unroll
            for (int nb = 0; nb < 8; ++nb) { const bf16x8 y = *(const LAS bf16x8*)(Ul + (16 * nb + fr) * UP + 32 * ks + 8 * fq); acc[nb] = __builtin_amdgcn_mfma_f32_16x16x32_bf16(x, y, acc[nb], 0, 0, 0); } }
#pragma unroll
        for (int nb = 0; nb < 8; ++nb) *(LAS f32x4*)(Sl + (16 * nb + fr) * SP + 16 * wid + 4 * fq) = acc[nb];
    }
    __syncthreads();
#ifdef DBG_DUMP_S
    { float* dbg = (float*)(C.ws + WS_ATT) + (size_t)((l * 0 + b) * NG + g) * 16384;
      for (int i = tid; i < 16384; i += 512) dbg[i] = Sl[(i >> 7) * SP + (i & 127)];
      __syncthreads(); }
#endif
    if (wid == 0) {
        const float* lm = (const float*)(C.ws + WS_LAM16) + (size_t)(lg * 64 + lane) * 2; const float lr = lm[0], li = lm[1]; float hr = 0.f, hi = 0.f;
#pragma unroll 1
        for (int c0 = 0; c0 < 128; c0 += 8) {
            float sr[8], si[8], pr[8], pi[8];
#pragma unroll
            for (int j = 0; j < 8; ++j) { sr[j] = Sl[(c0 + j) * SP + lane]; si[j] = Sl[(c0 + j) * SP + 64 + lane]; }
            LDS_WAIT();
#pragma unroll
            for (int j = 0; j < 8; ++j) { pr[j] = hr; pi[j] = hi; float nr = __builtin_fmaf(lr, hr, -(li * hi)) + sr[j], ni = __builtin_fmaf(lr, hi, li * hr) + si[j]; asm volatile("" : "+v"(nr), "+v"(ni)); hr = nr; hi = ni; }
#pragma unroll
            for (int j = 0; j < 8; ++j) { Sl[(c0 + j) * SP + lane] = pr[j]; Sl[(c0 + j) * SP + 64 + lane] = pi[j]; }
            LDS_WAIT();
        }
        float* ho = C.out + O_SSMP + ((size_t)(l * NB + b) * NG + g) * 128 + 2 * lane; ho[0] = hr; ho[1] = hi;
#ifdef DBG_DUMP_S
        { float* d2 = (float*)(C.ws + WS_ATT) + 4194304 + ((size_t)(b) * NG + g) * 128 + 2 * lane; d2[0] = hr; d2[1] = hi; }
#endif
    }
    f32x4 ya[2][8];
#pragma unroll
    for (int mb = 0; mb < 2; ++mb)
#pragma unroll
        for (int nb = 0; nb < 8; ++nb) ya[mb][nb] = (f32x4){0.f, 0.f, 0.f, 0.f};
#pragma unroll
    for (int ks = 0; ks < 8; ++ks) { if (ks <= wid) {
#pragma unroll
        for (int nb = 0; nb < 8; ++nb) { const bf16x8 y = *(const LAS bf16x8*)(Ul + (16 * nb + fr) * UP + 32 * ks + 8 * fq);
            ya[0][nb] = __builtin_amdgcn_mfma_f32_16x16x32_bf16(tg0[ks], y, ya[0][nb], 0, 0, 0); ya[1][nb] = __builtin_amdgcn_mfma_f32_16x16x32_bf16(tg1[ks], y, ya[1][nb], 0, 0, 0); } } }
    __syncthreads();
#ifndef DBG_NOCARRY
#pragma unroll
    for (int ks = 0; ks < 4; ++ks) {
        const bf16x8 x0 = *(const bf16x8*)(FG + (size_t)(32 * wid + fr) * 128 + 32 * ks + 8 * fq), x1 = *(const bf16x8*)(FG + (size_t)(32 * wid + 16 + fr) * 128 + 32 * ks + 8 * fq);
#pragma unroll
        for (int nb = 0; nb < 8; ++nb) { const LAS float* hp = Sl + (16 * nb + fr) * SP + 32 * ks + 8 * fq; const f32x4 h0 = *(const LAS f32x4*)hp, h1 = *(const LAS f32x4*)(hp + 4);
            u32x4 w; w.x = cvt_pk_bf16(h0[0], h0[1]); w.y = cvt_pk_bf16(h0[2], h0[3]); w.z = cvt_pk_bf16(h1[0], h1[1]); w.w = cvt_pk_bf16(h1[2], h1[3]); const bf16x8 y = __builtin_bit_cast(bf16x8, w);
            ya[0][nb] = __builtin_amdgcn_mfma_f32_16x16x32_bf16(x0, y, ya[0][nb], 0, 0, 0); ya[1][nb] = __builtin_amdgcn_mfma_f32_16x16x32_bf16(x1, y, ya[1][nb], 0, 0, 0); } }
#endif
    bf16* Z = (bf16*)(C.ws + WS_Z);
#pragma unroll
    for (int mb = 0; mb < 2; ++mb)
#pragma unroll
        for (int nb = 0; nb < 8; ++nb) { const f32x4 y = ya[mb][nb]; u32x2 w; w.x = cvt_pk_bf16(gelu_tanh(y[0]), gelu_tanh(y[1])); w.y = cvt_pk_bf16(gelu_tanh(y[2]), gelu_tanh(y[3]));
            *(u32x2*)(Z + (size_t)(b * 2048 + 16 * (16 * nb + fr) + 2 * wid + mb) * 1024 + 16 * g + 4 * fq) = w; }
    __syncthreads();
}
__device__ __forceinline__ void ssm_sample_item(const Ctx& C, int l, int sb, int g) {
    const int lane = C.lane, lg = l * NG + g;
    const float* lm = (const float*)(C.ws + WS_LAM1) + (size_t)(lg * 64 + lane) * 2; const float lr = lm[0], li = lm[1];
    const float* h0 = C.in[I_SSSM] + (((size_t)(l * SB + sb) * NG + g) * 64 + lane) * 2; float hr = h0[0], hi = h0[1];
    const float* bb = (const float*)(C.ws + WS_BBAR) + (size_t)(lg * 64 + lane) * 32;
    f32x4 bq[8];
#pragma unroll
    for (int j = 0; j < 8; ++j) bq[j] = *(const f32x4*)(bb + 4 * j);
    const float* cre = C.in[I_CRE] + (size_t)lg * 1024 + lane; const float* cim = C.in[I_CIM] + (size_t)lg * 1024 + lane;
    const float dsk = (lane < 16) ? C.in[I_D][lg * 16 + lane] : 0.f;
    bf16* Z = (bf16*)(C.ws + WS_Z);
    float crv[16], civ[16];
#pragma unroll
    for (int p = 0; p < 16; ++p) { crv[p] = cre[p * 64]; civ[p] = cim[p * 64]; }
    for (int st = 0; st < ST; ++st) {
        const bf16* up = (const bf16*)(C.ws + WS_US) + (size_t)(sb * ST + st) * 1024 + 16 * g;
        const u32x4 u0 = *(const u32x4*)up, u1 = *(const u32x4*)(up + 8); float uf[16];
#pragma unroll
        for (int j = 0; j < 4; ++j) { uf[2 * j] = bflo(u0[j]); uf[2 * j + 1] = bfhi(u0[j]); uf[8 + 2 * j] = bflo(u1[j]); uf[8 + 2 * j + 1] = bfhi(u1[j]); }
        float br = 0.f, bi = 0.f;
#pragma unroll
        for (int j = 0; j < 8; ++j) { br += bq[j][0] * uf[2 * j] + bq[j][2] * uf[2 * j + 1]; bi += bq[j][1] * uf[2 * j] + bq[j][3] * uf[2 * j + 1]; }
        const float nr = lr * hr - li * hi + br, ni = lr * hi + li * hr + bi; hr = nr; hi = ni;
        float ymine = 0.f;
#pragma unroll
        for (int p = 0; p < 16; ++p) { const float y = wave_sum(crv[p] * hr - civ[p] * hi); if (lane == p) ymine = y + dsk * uf[p]; }
        if (lane < 16) Z[(size_t)(MP + sb * ST + st) * 1024 + 16 * g + lane] = f2bf(gelu_tanh(ymine));
    }
    float* ho = C.out + O_SSMS + (((size_t)(l * SB + sb) * NG + g) * 64 + lane) * 2; ho[0] = hr; ho[1] = hi;
}

#define KSWZ(row, colB) ((row) * 256 + ((colB) ^ (((row) & 7) << 4)))
#define SBAR() __builtin_amdgcn_sched_barrier(0)
constexpr int AL_V = 0, AL_K = 32768, AL_WS = 65536, AL_PC = 67584, AL_SC = 133120, AL_SM = 141312;
constexpr float CL2 = SM_SCALE * 1.4426950408889634f;
__device__ __forceinline__ int crow(int r, int hi) { return (r & 3) + 8 * (r >> 2) + 4 * hi; }
__device__ __forceinline__ int v_st(int k, int c) { const int kk = (k & ~0xC) | ((k & 4) << 1) | ((k & 8) >> 1); return ((kk >> 3) * 4 + (c >> 5)) * 512 + ((kk & 7) * 32 + (c & 31)) * 2; }
__device__ __forceinline__ int v_rd_base(int lane) { return ((lane & 3) << 3) | (((lane >> 2) & 3) << 6) | (((lane >> 4) & 1) << 5) | (((lane >> 5) & 1) << 8); }
constexpr int v_rd_off(int d0, int ks, int half) { return d0 * 512 + ks * 4096 + half * 2048; }
template <int OFF> __device__ __forceinline__ s16x4 tr_read(int vb) {
    s16x4 r; asm volatile("ds_read_b64_tr_b16 %0, %1 offset:%2" : "=&v"(r) : "v"(vb), "i"(OFF) : "memory"); return r;
}
template <int D0> __device__ __forceinline__ void pv_one(f32x16& od, int vb, bf16x8 pa0, bf16x8 pa1, bf16x8 pa2, bf16x8 pa3) {
    const s16x4 l0 = tr_read<v_rd_off(D0, 0, 0)>(vb), h0 = tr_read<v_rd_off(D0, 0, 1)>(vb), l1 = tr_read<v_rd_off(D0, 1, 0)>(vb), h1 = tr_read<v_rd_off(D0, 1, 1)>(vb);
    const s16x4 l2 = tr_read<v_rd_off(D0, 2, 0)>(vb), h2 = tr_read<v_rd_off(D0, 2, 1)>(vb), l3 = tr_read<v_rd_off(D0, 3, 0)>(vb), h3 = tr_read<v_rd_off(D0, 3, 1)>(vb);
    asm volatile("s_waitcnt lgkmcnt(0)" ::: "memory"); SBAR();
#define PKV(L, H) (bf16x8){L[0], L[1], L[2], L[3], H[0], H[1], H[2], H[3]}
    od = __builtin_amdgcn_mfma_f32_32x32x16_bf16(pa0, PKV(l0, h0), od, 0, 0, 0);
    od = __builtin_amdgcn_mfma_f32_32x32x16_bf16(pa1, PKV(l1, h1), od, 0, 0, 0);
    od = __builtin_amdgcn_mfma_f32_32x32x16_bf16(pa2, PKV(l2, h2), od, 0, 0, 0);
    od = __builtin_amdgcn_mfma_f32_32x32x16_bf16(pa3, PKV(l3, h3), od, 0, 0, 0);
#undef PKV
}
__device__ __forceinline__ void pv_d0(f32x16* o, int vb, bf16x8 pa0, bf16x8 pa1, bf16x8 pa2, bf16x8 pa3) {
    pv_one<0>(o[0], vb, pa0, pa1, pa2, pa3); pv_one<1>(o[1], vb, pa0, pa1, pa2, pa3); pv_one<2>(o[2], vb, pa0, pa1, pa2, pa3); pv_one<3>(o[3], vb, pa0, pa1, pa2, pa3);
}
__device__ __forceinline__ void qkt(f32x16& p0, f32x16& p1, const LAS unsigned char* Ks, const bf16x8* qr, int r32, int hi) {
    p0 = f32x16{}; p1 = f32x16{};
#pragma unroll
    for (int d0 = 0; d0 < 8; ++d0) { const int cb = (d0 * 16 + hi * 8) * 2;
        const bf16x8 b0 = *(const LAS bf16x8*)(Ks + KSWZ(r32, cb)); const bf16x8 b1 = *(const LAS bf16x8*)(Ks + KSWZ(32 + r32, cb));
        p0 = __builtin_amdgcn_mfma_f32_32x32x16_bf16(b0, qr[d0], p0, 0, 0, 0); p1 = __builtin_amdgcn_mfma_f32_32x32x16_bf16(b1, qr[d0], p1, 0, 0, 0); }
}
__device__ __forceinline__ float softmax_tile(f32x16& p0, f32x16& p1, float bc, float a2, int mode, int lim, int hi_in, float& m_reg, float& l_reg, bf16x8& pa0, bf16x8& pa1, bf16x8& pa2, bf16x8& pa3) {
    const float ninf = -__builtin_inff();
    int hi = hi_in; asm volatile("" : "+v"(lim), "+v"(hi));
    const float a2l = a2 + bc * (float)(4 * hi);
#pragma unroll
    for (int r = 0; r < 16; ++r) { const float cr = (float)((r & 3) + 8 * (r >> 2)); p0[r] = fmaf(bc, cr, p0[r]); p1[r] = fmaf(bc, cr, p1[r]); }
    if (mode != 0) {
#pragma unroll
        for (int r = 0; r < 16; ++r) { const int kk = (r & 3) + 8 * (r >> 2) + 4 * hi; const bool v0 = (mode == 1) ? (kk <= lim) : (kk > lim), v1 = (mode == 1) ? (kk + 32 <= lim) : (kk + 32 > lim);
            p0[r] = v0 ? p0[r] : ninf; p1[r] = v1 ? p1[r] : ninf; }
    }
    float m0 = p0[0], m1 = p1[0];
#pragma unroll
    for (int r = 1; r < 16; ++r) { m0 = fmaxf(m0, p0[r]); m1 = fmaxf(m1, p1[r]); }
    float pm = fmaxf(m0 + a2l, m1 + (a2l + 32.f * bc));
    { auto rr = __builtin_amdgcn_permlane32_swap(__float_as_uint(pm), __float_as_uint(pm), false, false); pm = fmaxf(__uint_as_float(rr[0]), __uint_as_float(rr[1])); }
    const float mn = fmaxf(m_reg, pm); const float alpha = __builtin_amdgcn_exp2f((m_reg - mn) * CL2); m_reg = mn;
    const float o0 = (a2l - mn) * CL2, o1 = (a2l + 32.f * bc - mn) * CL2;
#pragma unroll
    for (int r = 0; r < 16; ++r) { p0[r] = __builtin_amdgcn_exp2f(fmaf(p0[r], CL2, o0)); p1[r] = __builtin_amdgcn_exp2f(fmaf(p1[r], CL2, o1)); }
    float ps = 0.f;
#pragma unroll
    for (int r = 0; r < 16; ++r) ps += p0[r] + p1[r];
    { auto rr = __builtin_amdgcn_permlane32_swap(__float_as_uint(ps), __float_as_uint(ps), false, false); ps = __uint_as_float(rr[0]) + __uint_as_float(rr[1]); }
    l_reg = l_reg * alpha + ps;
#define PK4(P, BASE, OUT) do { unsigned a0 = cvt_pk_bf16(P[BASE + 0], P[BASE + 1]), a1 = cvt_pk_bf16(P[BASE + 2], P[BASE + 3]);   \
    unsigned b0 = cvt_pk_bf16(P[BASE + 4], P[BASE + 5]), b1 = cvt_pk_bf16(P[BASE + 6], P[BASE + 7]);                              \
    auto r0 = __builtin_amdgcn_permlane32_swap(a0, b0, false, false); auto r1 = __builtin_amdgcn_permlane32_swap(a1, b1, false, false); \
    u32x4 w = {r0[0], r1[0], r0[1], r1[1]}; OUT = __builtin_bit_cast(bf16x8, w); } while (0)
    PK4(p0, 0, pa0); PK4(p0, 8, pa1); PK4(p1, 0, pa2); PK4(p1, 8, pa3);
#undef PK4
    return alpha;
}
struct AttnSt { bf16x8 v0, v1, k0, k1; };
#define ATT_SLOAD(S, Kp, Vp, krow) do { (S).v0 = *(const bf16x8*)((Vp) + (size_t)((krow) + sr) * 128 + sc); (S).v1 = *(const bf16x8*)((Vp) + (size_t)((krow) + 32 + sr) * 128 + sc); \
    (S).k0 = *(const bf16x8*)((Kp) + (size_t)((krow) + sr) * 128 + sc); (S).k1 = *(const bf16x8*)((Kp) + (size_t)((krow) + 32 + sr) * 128 + sc); } while (0)
#define ATT_SWRITE(S, b) do { *(LAS bf16x8*)(lds + AL_V + (b) * 16384 + vst0) = (S).v0; *(LAS bf16x8*)(lds + AL_V + (b) * 16384 + vst1) = (S).v1; \
    *(LAS bf16x8*)(lds + AL_K + (b) * 16384 + KSWZ(sr, sc * 2)) = (S).k0; *(LAS bf16x8*)(lds + AL_K + (b) * 16384 + KSWZ(32 + sr, sc * 2)) = (S).k1; } while (0)
#define ATT_RESC(a) do { if (__any((a) < 1.f)) { if (hi == 0) al_l[r32] = (a); LDS_WAIT(); int hf = hi; asm volatile("" : "+v"(hf)); \
    _Pragma("unroll") for (int r = 0; r < 16; ++r) { const float f = al_l[crow(r, hf)]; _Pragma("unroll") for (int d = 0; d < 4; ++d) o[d][r] *= f; } } } while (0)
#define ATT_FINAL(gate_, first_) do { const float scl = (gate_) / fmaxf(l_reg, 1e-30f); if (hi == 0) li_l[r32] = scl; LDS_WAIT(); \
    int hf = hi, rf = r32; asm volatile("" : "+v"(hf), "+v"(rf)); \
    _Pragma("unroll") for (int rg = 0; rg < 4; ++rg) { \
    _Pragma("unroll") for (int r2 = 0; r2 < 4; ++r2) { const int r = 4 * rg + r2; const float f = li_l[crow(r, hf)]; float* op = ATTw + (size_t)crow(r, hf) * 1024 + rf; \
        _Pragma("unroll") for (int d = 0; d < 4; ++d) { const float val = o[d][r] * f; op[32 * d] = (first_) ? val : op[32 * d] + val; } } \
    if (rg & 1) asm volatile("" ::: "memory"); } } while (0)

__device__ __forceinline__ void attn_prompt_unit(const Ctx& C, int l, int b, int kvh, int qb) {
    LAS unsigned char* lds = C.lds;
    int lane = C.lane; asm volatile("" : "+v"(lane));
    const int tid = C.tid, wid = C.wid, r32 = lane & 31, hi = lane >> 5;
    if (wid < 4) __builtin_amdgcn_s_setprio(3);
    const int head = kvh * 4 + (wid >> 1), qloc = 32 * (wid & 1) + r32, t = 64 * qb + qloc, row = b * 2048 + t;
    LAS float* al_l = (LAS float*)(lds + AL_WS) + wid * 64; LAS float* li_l = al_l + 32;
    LAS _Float16* Pst = (LAS _Float16*)(lds + AL_PC); LAS float* Sc = (LAS float*)(lds + AL_SC); LAS unsigned* Sm = (LAS unsigned*)(lds + AL_SM);
    const float slope = __builtin_amdgcn_exp2f(-(float)(head + 1)), bck = slope * (1.0f / SM_SCALE);
    bf16x8 qr[8];
    {   const bf16* Qp = (const bf16*)(C.ws + WS_Q) + (size_t)row * 1024 + head * 128 + hi * 8; const float* qg = C.in[I_QN] + l * 128 + hi * 8;
        u32x4 raw[8]; float ss = 0.f;
#pragma unroll
        for (int d0 = 0; d0 < 8; ++d0) { raw[d0] = *(const u32x4*)(Qp + d0 * 16);
#pragma unroll
            for (int j = 0; j < 4; ++j) { const float a = bflo(raw[d0][j]), c = bfhi(raw[d0][j]); ss += a * a + c * c; } }
        ss += __shfl_xor(ss, 32); const float rstd = 1.0f / sqrtf(ss * (1.0f / 128.0f) + EPS);
#pragma unroll
        for (int d0 = 0; d0 < 8; ++d0) { const f32x4 g0 = *(const f32x4*)(qg + d0 * 16), g1 = *(const f32x4*)(qg + d0 * 16 + 4); u32x4 w;
            w.x = cvt_pk_bf16(bflo(raw[d0][0]) * rstd * g0[0], bfhi(raw[d0][0]) * rstd * g0[1]); w.y = cvt_pk_bf16(bflo(raw[d0][1]) * rstd * g0[2], bfhi(raw[d0][1]) * rstd * g0[3]);
            w.z = cvt_pk_bf16(bflo(raw[d0][2]) * rstd * g1[0], bfhi(raw[d0][2]) * rstd * g1[1]); w.w = cvt_pk_bf16(bflo(raw[d0][3]) * rstd * g1[2], bfhi(raw[d0][3]) * rstd * g1[3]);
            qr[d0] = __builtin_bit_cast(bf16x8, w); } }
    const float* grow = (const float*)(C.ws + WS_GT) + (size_t)row * 32 + head * 3;
    const float g_cmp = grow[0], g_slc = grow[1], g_win = grow[2];
    float* ATTw = (float*)(C.ws + WS_ATT) + (size_t)(b * 2048 + 64 * qb + 32 * (wid & 1)) * 1024 + head * 128;
    const int sr = tid >> 4, sc = (tid & 15) * 8, vst0 = v_st(sr, sc), vst1 = v_st(32 + sr, sc);
    const int vb0 = (int)(uintptr_t)(lds + AL_V) + v_rd_base(lane);
    if (tid < 64) Sm[tid] = 0u;
    f32x16 o[4]; float m_reg, l_reg; bf16x8 pa0, pa1, pa2, pa3; AttnSt stg;
    {   const bf16* Kp = (const bf16*)(C.ws + WS_CKVP) + (size_t)((0 * 4 + b) * 2 + kvh) * 128 * 128; const bf16* Vp = (const bf16*)(C.ws + WS_CKVP) + (size_t)((1 * 4 + b) * 2 + kvh) * 128 * 128;
        ATT_SLOAD(stg, Kp, Vp, 0); ATT_SWRITE(stg, 0); ATT_SLOAD(stg, Kp, Vp, 64); ATT_SWRITE(stg, 1);
        __syncthreads();
        m_reg = -1e30f; l_reg = 0.f;
        const int cmax = (t - 31) >> 4; const float bcc = 16.f * bck;
        {   f32x16 pA0, pA1, pB0, pB1; bf16x8 pb0, pb1, pb2, pb3;
            qkt(pA0, pA1, lds + AL_K, qr, r32, hi);
            (void)softmax_tile(pA0, pA1, bcc, 0.f, 1, cmax, hi, m_reg, l_reg, pa0, pa1, pa2, pa3);
            qkt(pB0, pB1, lds + AL_K + 16384, qr, r32, hi);
            const float al1 = softmax_tile(pB0, pB1, bcc, 64.f * bcc, 1, cmax - 64, hi, m_reg, l_reg, pb0, pb1, pb2, pb3);
            const float il = 1.0f / fmaxf(l_reg, 1e-30f), ia = al1 * il;
            LAS _Float16* prow = Pst + ((wid >> 1) * 64 + qloc) * 128;
#pragma unroll
            for (int r = 0; r < 16; ++r) { const int kk = crow(r, hi);
                prow[kk] = (_Float16)(pA0[r] * ia); prow[32 + kk] = (_Float16)(pA1[r] * ia); prow[64 + kk] = (_Float16)(pB0[r] * il); prow[96 + kk] = (_Float16)(pB1[r] * il); }
#pragma unroll
            for (int d = 0; d < 4; ++d) o[d] = f32x16{};
            pv_d0(o, vb0, pa0, pa1, pa2, pa3);
            ATT_RESC(al1);
            pv_d0(o, vb0 + 16384, pb0, pb1, pb2, pb3);
        }
        ATT_FINAL(g_cmp, true);
    }
    __syncthreads();
    {   int tid2 = tid; asm volatile("" : "+v"(tid2)); const int qi = tid2 >> 3, sub = tid2 & 7; const LAS _Float16* pq = Pst + qi * 128;
        float pc[17];
#pragma unroll
        for (int i = 0; i < 17; ++i) { const int c = 16 * sub - 1 + i; float v = 0.f; if (c >= 0) v = ((float)pq[c] + (float)pq[64 * 128 + c]) + ((float)pq[2 * 64 * 128 + c] + (float)pq[3 * 64 * 128 + c]); pc[i] = v; }
#pragma unroll
        for (int jj = 0; jj < 4; ++jj) { const int j = 4 * sub + jj; Sc[qi * 32 + j] = pc[4 * jj] + 2.f * (pc[4 * jj + 1] + pc[4 * jj + 2] + pc[4 * jj + 3]) + pc[4 * jj + 4]; }
        __syncthreads();
        if (qb >= 16) {
            for (int jj = 0; jj < 4; ++jj) { const int j = 4 * sub + jj; bool sel;
                if (j == 0 || j == qb || j == qb - 1) sel = true; else if (j > qb) sel = false;
                else { const float v = Sc[qi * 32 + j]; int rank = 0; for (int jp = 1; jp <= qb - 2; ++jp) { const float vp = Sc[qi * 32 + jp]; rank += (vp > v || (vp == v && jp < j)) ? 1 : 0; } sel = rank < 13; }
                if (sel) __hip_atomic_fetch_or(Sm + qi, 1u << j, __ATOMIC_RELAXED, __HIP_MEMORY_SCOPE_WORKGROUP); }
        } else if (sub == 0) Sm[qi] = (2u << qb) - 1u;
        __syncthreads();
    }
    const unsigned rowmask = Sm[qloc];
    const float ninf = -__builtin_inff();
    {   const bf16* Kp = (const bf16*)(C.ws + WS_KVS) + (size_t)((0 * 4 + b) * 2 + kvh) * 2048 * 128; const bf16* Vp = (const bf16*)(C.ws + WS_KVS) + (size_t)((1 * 4 + b) * 2 + kvh) * 2048 * 128;
#pragma unroll
        for (int d = 0; d < 4; ++d) o[d] = f32x16{};
        m_reg = -1e30f; l_reg = 0.f;
        ATT_SLOAD(stg, Kp, Vp, 64 * qb); ATT_SWRITE(stg, 0); __syncthreads();
        for (int j = qb; j >= 0; --j) { const int bf = (qb - j) & 1;
            if (j > 0) ATT_SLOAD(stg, Kp, Vp, 64 * (j - 1));
            if (__any((rowmask >> j) & 1u)) {
                f32x16 p0, p1; qkt(p0, p1, lds + AL_K + bf * 16384, qr, r32, hi);
                const float a2 = ((rowmask >> j) & 1u) ? bck * (float)(64 * (j - qb)) : ninf;
                const float al = softmax_tile(p0, p1, bck, a2, (j == qb) ? 1 : 0, qloc, hi, m_reg, l_reg, pa0, pa1, pa2, pa3);
                ATT_RESC(al);
                pv_d0(o, vb0 + bf * 16384, pa0, pa1, pa2, pa3); }
            if (j > 0) ATT_SWRITE(stg, bf ^ 1);
            __syncthreads(); }
        ATT_FINAL(g_slc, false);
    }
    {   const bf16* Kp = (const bf16*)(C.ws + WS_KVW) + (size_t)((0 * 4 + b) * 2 + kvh) * 2048 * 128; const bf16* Vp = (const bf16*)(C.ws + WS_KVW) + (size_t)((1 * 4 + b) * 2 + kvh) * 2048 * 128;
#pragma unroll
        for (int d = 0; d < 4; ++d) o[d] = f32x16{};
        m_reg = -1e30f; l_reg = 0.f;
        const int jlo = qb > 8 ? qb - 8 : 0;
        ATT_SLOAD(stg, Kp, Vp, 64 * qb); ATT_SWRITE(stg, 0); __syncthreads();
        for (int j = qb; j >= jlo; --j) { const int bf = (qb - j) & 1;
            if (j > jlo) ATT_SLOAD(stg, Kp, Vp, 64 * (j - 1));
            f32x16 p0, p1; qkt(p0, p1, lds + AL_K + bf * 16384, qr, r32, hi);
            const int mode = (j == qb) ? 1 : ((j == qb - 8) ? 2 : 0);
            const float al = softmax_tile(p0, p1, bck, bck * (float)(64 * (j - qb)), mode, qloc, hi, m_reg, l_reg, pa0, pa1, pa2, pa3);
            ATT_RESC(al);
            pv_d0(o, vb0 + bf * 16384, pa0, pa1, pa2, pa3);
            if (j > jlo) ATT_SWRITE(stg, bf ^ 1);
            __syncthreads(); }
        ATT_FINAL(g_win, false);
    }
    __builtin_amdgcn_s_setprio(0);
    __syncthreads();
}

constexpr int SA_SCP = 2576;
constexpr int SA_Q = 0, SA_SC = 2048, SA_PC = SA_SC + 4 * SA_SCP * 4, SA_BS = SA_PC + 4096, SA_RED = SA_BS + 1088, SA_SEL = SA_RED + 128, SA_KOFF = SA_SEL + 64, SA_PV = SA_KOFF + 8192, SA_END = SA_PV + 8 * 4 * 128 * 4;
static_assert(SA_END <= MISC_OFF, "sample attention LDS map");
__device__ __forceinline__ void dot4_f32(const float* k, const LAS float* qs, float (&s)[4]) {
    s[0] = s[1] = s[2] = s[3] = 0.f;
#pragma unroll 8
    for (int d = 0; d < 128; d += 4) { const f32x4 kv = *(const f32x4*)(k + d);
#pragma unroll
        for (int h = 0; h < 4; ++h) { const f32x4 q = *(const LAS f32x4*)(qs + h * 128 + d); s[h] += (kv[0] * q[0] + kv[1] * q[1]) + (kv[2] * q[2] + kv[3] * q[3]); } }
}
__device__ __forceinline__ void dot4_bf16(const bf16* k, const LAS float* qs, float (&s)[4]) {
    s[0] = s[1] = s[2] = s[3] = 0.f;
#pragma unroll 8
    for (int d = 0; d < 128; d += 8) { const u32x4 kw = *(const u32x4*)(k + d); float kf[8];
#pragma unroll
        for (int j = 0; j < 4; ++j) { kf[2 * j] = bflo(kw[j]); kf[2 * j + 1] = bfhi(kw[j]); }
#pragma unroll
        for (int h = 0; h < 4; ++h) { const f32x4 q0 = *(const LAS f32x4*)(qs + h * 128 + d), q1 = *(const LAS f32x4*)(qs + h * 128 + d + 4);
            s[h] += (kf[0] * q0[0] + kf[1] * q0[1]) + (kf[2] * q0[2] + kf[3] * q0[3]) + (kf[4] * q1[0] + kf[5] * q1[1]) + (kf[6] * q1[2] + kf[7] * q1[3]); } }
}
__device__ __forceinline__ void sample_softmax(int wid, int lane, LAS float* sc, LAS float* red, int n) {
    const int h = wid >> 1, c0 = (wid & 1) * 64 + lane; LAS float* row = sc + h * SA_SCP;
    float mx = -__builtin_inff(); for (int c = c0; c < n; c += 128) mx = fmaxf(mx, row[c]);
    mx = wave_max(mx); if (lane == 0) red[wid] = mx;
    __syncthreads();
    float m = fmaxf(red[2 * h], red[2 * h + 1]); if (!(m > -1e37f)) m = 0.f;
    float sm = 0.f; for (int c = c0; c < n; c += 128) { const float e = __builtin_amdgcn_exp2f((row[c] - m) * 1.4426950408889634f); row[c] = e; sm += e; }
    sm = wave_sum(sm); if (lane == 0) red[8 + wid] = sm;
    __syncthreads();
    const float inv = 1.0f / fmaxf(red[8 + 2 * h] + red[8 + 2 * h + 1], 1e-37f);
    for (int c = c0; c < n; c += 128) row[c] *= inv;
    __syncthreads();
}
__device__ __forceinline__ void attn_sample_unit(const Ctx& C, int l, int sb, int kvh, int st) {
    LAS unsigned char* lds = C.lds; int tid = C.tid; asm volatile("" : "+v"(tid)); const int lane = tid & 63, wid = C.wid;
    LAS float* qs = (LAS float*)(lds + SA_Q); LAS float* sc = (LAS float*)(lds + SA_SC); LAS float* pc = (LAS float*)(lds + SA_PC); LAS float* bs = (LAS float*)(lds + SA_BS);
    LAS float* red = (LAS float*)(lds + SA_RED); LAS int* selj = (LAS int*)(lds + SA_SEL); LAS unsigned long long* koff = (LAS unsigned long long*)(lds + SA_KOFF); LAS float* pvr = (LAS float*)(lds + SA_PV);
    const int pos = PAST + st, row = MP + sb * ST + st; const int* pt = (const int*)C.in[I_PT];
    if (wid < 4) { const int h = wid; const unsigned w = *(const unsigned*)((const bf16*)(C.ws + WS_Q) + (size_t)row * 1024 + (kvh * 4 + h) * 128 + 2 * lane); const float x0 = bflo(w), x1 = bfhi(w);
        const float rstd = 1.0f / sqrtf(wave_sum(x0 * x0 + x1 * x1) * (1.0f / 128.0f) + EPS); const f32x2 g = *(const f32x2*)(C.in[I_QN] + l * 128 + 2 * lane);
        qs[h * 128 + 2 * lane] = x0 * rstd * g[0]; qs[h * 128 + 2 * lane + 1] = x1 * rstd * g[1]; }
    __syncthreads();
    float slope[4];
#pragma unroll
    for (int h = 0; h < 4; ++h) slope[h] = __builtin_amdgcn_exp2f(-(float)(kvh * 4 + h + 1));
    const bf16* CK = (const bf16*)(C.ws + WS_CKVS) + (size_t)(((l * 2 + 0) * 8 + sb) * 2 + kvh) * 1024 * 128; const bf16* CV = (const bf16*)(C.ws + WS_CKVS) + (size_t)(((l * 2 + 1) * 8 + sb) * 2 + kvh) * 1024 * 128;
    const float* WB = C.in[I_SWIN] + ((((size_t)l * SB + sb) * 512) * 2 + kvh) * 256;
    const float* WN = C.out + O_WINS + ((((size_t)l * SB + sb) * 512 + 508) * 2 + kvh) * 256;
    for (int c = tid; c < 1023; c += 512) { float s[4]; dot4_bf16(CK + (size_t)c * 128, qs, s); const float dist = (float)(pos - 16 * c) - 15.5f;
#pragma unroll
        for (int h = 0; h < 4; ++h) sc[h * SA_SCP + c] = s[h] * SM_SCALE - slope[h] * dist; }
    __syncthreads();
    sample_softmax(wid, lane, sc, red, 1023);
    for (int c = tid; c < 1024; c += 512) pc[c] = (c < 1023) ? (sc[c] + sc[SA_SCP + c]) + (sc[2 * SA_SCP + c] + sc[3 * SA_SCP + c]) : 0.f;
    __syncthreads();
    for (int j = tid; j < 257; j += 512) { float s = 0.f; if (j < 256) s = 2.f * (pc[4 * j] + pc[4 * j + 1] + pc[4 * j + 2]) + pc[4 * j + 3]; if (j > 0) s += pc[4 * j - 1]; bs[j] = s; }
    if (tid == 0) { selj[0] = 0; selj[1] = 255; selj[2] = 256; }
    __syncthreads();
    if (tid < 254) { const int j = tid + 1; const float v = bs[j]; int rank = 0; for (int jp = 1; jp <= 254; ++jp) { const float vp = bs[jp]; rank += (vp > v || (vp == v && jp < j)) ? 1 : 0; } if (rank < 13) selj[3 + rank] = j; }
    __syncthreads();
    for (int idx = tid; idx < 1024 + 516; idx += 512) {
        const float* base; bool valid = true; int kpos;
        if (idx < 1024) { const int j = selj[idx >> 6], r = idx & 63; kpos = 64 * j + r;
            if (j < 256) { const int page = pt[sb * 128 + (j >> 1)]; base = C.in[I_CSLC] + ((((size_t)l * NPOOL + page) * 128 + (j & 1) * 64 + r) * 2 + kvh) * 256; }
            else { valid = (r <= st); base = C.out + O_SLCS + ((((size_t)l * SB + sb) * 4 + (r < 4 ? r : 0)) * 2 + kvh) * 256; }
            koff[idx] = (unsigned long long)(uintptr_t)base;
        } else { const int i = idx - 1024;
            if (i < 512) { base = WB + (size_t)i * 512; valid = i > st; kpos = PAST - 512 + i; } else { const int r = i - 512; base = WN + (size_t)r * 512; valid = r <= st; kpos = PAST + r; } }
        float s[4]; dot4_f32(base, qs, s); const float dist = (float)(pos - kpos);
#pragma unroll
        for (int h = 0; h < 4; ++h) sc[h * SA_SCP + 1024 + idx] = valid ? (s[h] * SM_SCALE - slope[h] * dist) : -__builtin_inff(); }
    __syncthreads();
    sample_softmax(wid, lane, sc + 1024, red, 1024);
    sample_softmax(wid, lane, sc + 2048, red, 516);
    float acc[3][4][2];
#pragma unroll
    for (int b3 = 0; b3 < 3; ++b3)
#pragma unroll
        for (int h = 0; h < 4; ++h) { acc[b3][h][0] = 0.f; acc[b3][h][1] = 0.f; }
    {
        const bf16* vp = CV + 2 * lane;
#pragma unroll 1
        for (int i0 = 0; i0 < 128; i0 += 16) { unsigned v[16];
#pragma unroll
            for (int j = 0; j < 16; ++j) { const int c = wid + 8 * (i0 + j); v[j] = *(const unsigned*)(vp + (size_t)(c < 1023 ? c : 1022) * 128); }
#pragma unroll
            for (int j = 0; j < 16; ++j) { const int c = wid + 8 * (i0 + j); const float v0 = (c < 1023) ? bflo(v[j]) : 0.f, v1 = (c < 1023) ? bfhi(v[j]) : 0.f;
#pragma unroll
                for (int h = 0; h < 4; ++h) { const float p = sc[h * SA_SCP + (c < 1023 ? c : 1022)]; acc[0][h][0] += p * v0; acc[0][h][1] += p * v1; } } }
    }
    {
#pragma unroll 1
        for (int i0 = 0; i0 < 128; i0 += 16) { f32x2 v[16];
#pragma unroll
            for (int j = 0; j < 16; ++j) { const int k = wid + 8 * (i0 + j); v[j] = *(const GAS f32x2*)((const GAS float*)(uintptr_t)koff[k] + 128 + 2 * lane); }
#pragma unroll
            for (int j = 0; j < 16; ++j) { const int k = wid + 8 * (i0 + j);
#pragma unroll
                for (int h = 0; h < 4; ++h) { const float p = sc[h * SA_SCP + 1024 + k]; acc[1][h][0] += p * v[j][0]; acc[1][h][1] += p * v[j][1]; } } }
    }
    {
#pragma unroll 1
        for (int i0 = 0; i0 < 65; i0 += 13) { f32x2 v[13];
#pragma unroll
            for (int j = 0; j < 13; ++j) { const int i = wid + 8 * (i0 + j); const int ic = i < 516 ? i : 515; const float* p = (ic < 512) ? WB + (size_t)ic * 512 : WN + (size_t)(ic - 512) * 512; v[j] = *(const f32x2*)(p + 128 + 2 * lane); }
#pragma unroll
            for (int j = 0; j < 13; ++j) { const int i = wid + 8 * (i0 + j); const int ic = i < 516 ? i : 515; const float m = i < 516 ? 1.f : 0.f;
#pragma unroll
                for (int h = 0; h < 4; ++h) { const float p = sc[h * SA_SCP + 2048 + ic] * m; acc[2][h][0] += p * v[j][0]; acc[2][h][1] += p * v[j][1]; } } }
    }
    const float* grow = (const float*)(C.ws + WS_GT) + (size_t)row * 32 + kvh * 12;
#pragma unroll
    for (int h = 0; h < 4; ++h) { const float g0 = grow[h * 3], g1 = grow[h * 3 + 1], g2 = grow[h * 3 + 2];
        *(LAS f32x2*)(pvr + (wid * 4 + h) * 128 + 2 * lane) = (f32x2){g0 * acc[0][h][0] + g1 * acc[1][h][0] + g2 * acc[2][h][0], g0 * acc[0][h][1] + g1 * acc[1][h][1] + g2 * acc[2][h][1]}; }
    __syncthreads();
    { float t = 0.f;
#pragma unroll
      for (int w = 0; w < 8; ++w) t += pvr[w * 512 + tid];
      ((float*)(C.ws + WS_ATT))[(size_t)row * 1024 + kvh * 512 + tid] = t; }
    __syncthreads();
}
template <class Sched>
__device__ __forceinline__ void prenorm_prologue(const Ctx& C, const Sched& S, const float* PS, const float* PSS) {
    LAS float* RS = (LAS float*)(C.lds + LDS_RS);
    const int rr = C.tid >> 1, half = C.tid & 1;
    int pms[8];
#pragma unroll
    for (int i = 0; i < 8; ++i) { pg8::Unit u; pms[i] = S.next(i, u) ? u.pm : -1; }
#pragma unroll 4
    for (int i = 0; i < 8; ++i) { if (pms[i] >= 0) { float rs = 1.0f;
        if (PS) { const int grow = pms[i] * 256 + rr;
            if (grow < MP) { const float* p = PS + (size_t)grow * 32 + half * 16; float s = 0.f;
#pragma unroll
                for (int k = 0; k < 4; ++k) { const f32x4 v = *(const f32x4*)(p + 4 * k); s += (v[0] + v[1]) + (v[2] + v[3]); }
                s += __shfl_xor(s, 1); rs = 1.0f / sqrtf(s * (1.0f / 2048.0f) + EPS); }
            else if (grow < MR) { const float* p = PSS + (size_t)(grow - MP) * 128 + half * 64; float s = 0.f;
#pragma unroll
                for (int k = 0; k < 16; ++k) { const f32x4 v = *(const f32x4*)(p + 4 * k); s += (v[0] + v[1]) + (v[2] + v[3]); }
                s += __shfl_xor(s, 1); rs = 1.0f / sqrtf(s * (1.0f / 2048.0f) + EPS); } }
        if (half == 0) RS[i * 256 + rr] = rs; } }
    __syncthreads();
}

#ifndef PHMASK
#define PHMASK 0x1fff
#endif
#define SITE(i) ((PHMASK >> (i)) & 1)
#ifndef DBG_GU_A
#define DBG_GU_A WS_HN
#endif
constexpr int NPH = 16;
__global__ void __launch_bounds__(512, 2) hymba_fwd(Args a) {
    extern __shared__ __attribute__((aligned(16))) unsigned char lds_raw[];
    Ctx C0; C0.lds = (LAS unsigned char*)lds_raw; C0.tid = threadIdx.x; C0.lane = C0.tid & 63; C0.wid = __builtin_amdgcn_readfirstlane(C0.tid >> 6); C0.G = gridDim.x; C0.wg = blockIdx.x;
    C0.in.p = (InArr)__builtin_amdgcn_kernarg_segment_ptr(); C0.out = a.out; C0.ws = a.ws;
    LAS unsigned char* lds = C0.lds;
    volatile LAS unsigned* misc = (volatile LAS unsigned*)(lds + MISC_OFF);
    if (C0.tid < 4) misc[C0.tid] = 0u;
    __syncthreads();
#if !MK_MULTI
    XcdBarrier bar = xcd_barrier_post((unsigned*)(a.ws + WS_CTL) + CW_BAR, misc);
#endif
    const int lo = a.ph_lo, hi = a.ph_hi % 1000, variant = a.ph_hi / 1000;
#define IN(k) (lo <= (k) && (k) < hi)
#if MK_MULTI
#define SEAM(k) do { } while (0)
#else
#define SEAM(k) do { if (IN(k) && IN((k) + 1)) xcd_barrier(bar); } while (0)
#endif
#define SITE_BEGIN() Ctx Cs = C0; GAS unsigned char* wsg_ = (GAS unsigned char*)C0.ws; GAS float* outg_ = (GAS float*)C0.out; asm volatile("" : "+s"(wsg_), "+s"(outg_), "+s"(Cs.in.p), "+s"(Cs.G), "+s"(Cs.wg), "+s"(Cs.wid), "+v"(Cs.tid), "+v"(Cs.lane)); Cs.ws = (unsigned char*)wsg_; Cs.out = (float*)outg_; unsigned char* ws = Cs.ws; const Ctx& C = Cs; const int G = Cs.G, wg = Cs.wg, NGW = G * 8, gw = wg * 8 + C.wid; (void)gw; (void)ws; (void)NGW

    if (SITE(0) && IN(0)) { SITE_BEGIN(); p0_prologue(C); }
    SEAM(0);
    if (SITE(1) && IN(1)) { SITE_BEGIN();
        for (int u = wg; u < 512; u += G) cmp1_sample_unit(C, u, variant);
    }
    SEAM(1);
    {
        constexpr int l = 0, pb = 2 + 7 * l;
        if (SITE(3) && IN(pb + 0)) { SITE_BEGIN();
            if (l == 0) {
            for (int u = wg; u < 512; u += G) { const int seq = u >> 3, blk = u & 7, lk = seq >> 4, l = lk >> 1, kv = lk & 1;
                cmp_stage2_unit(C, (const float*)(ws + WS_TBS), (size_t)seq * 1024, blk * 128, 1023, C.in[kv ? I_B1V : I_B1K] + l * 128, (const bf16*)(ws + WS_W2T) + (size_t)lk * 128 * 128,
                                kv ? nullptr : C.in[I_KNC] + l * 128, (bf16*)(ws + WS_CKVS) + ((size_t)seq * 1024 + blk * 128) * 128); }

                __syncthreads(); }
            pg8::Gemm g{(const pg8::bf16_t*)(ws + WS_XN), (const pg8::bf16_t*)(ws + WS_WIN) + (size_t)l * INWP * DM, MPAD, INWP, DM}; pg8::StaticOrder S; S.init(MPAD, INWP, G, wg);
            if (l == 0) prenorm_prologue(C, S, nullptr, nullptr); else prenorm_prologue(C, S, (const float*)(ws + WS_PS), (const float*)(ws + WS_PSS));
            pg8::EpiIn E{(pg8::bf16_t*)(ws + WS_U), (pg8::bf16_t*)(ws + WS_US), (pg8::bf16_t*)(ws + WS_Q), (float*)(ws + WS_KVRAW), (float*)(ws + WS_GT), (pg8::bf16_t*)(ws + WS_KVC), (const PG8_LAS float*)(lds + LDS_RS), 0};
            pg8::gemm_phase<pg8::EpiIn, pg8::StaticOrder, true, true>(lds, g, S, E);
            if (l == 0 && G == 256 && wg >= 239) {
                __syncthreads(); LAS float* scr = (LAS float*)(C.lds + C.wid * 16384);
                for (int i = (wg - 239) * 8 + C.wid; i < TI_OUT; i += 17 * 8) weight_item(C, TI_LAYER + TI_IN + TI_GLU + i, scr); }
        }
        SEAM(pb + 0);
        if (SITE(4) && IN(pb + 1)) { SITE_BEGIN();
            const bool fast = (G == 256);
            if (variant == 0 || variant == 1) {
            if (fast) { if (wg >= 8 && wg < 248) for (int r = (wg - 8) * 8 + C.wid; r < MR; r += 240 * 8) kvfix_row(C, l, r);
                        if (wg >= 128 && wg < 192) { const int i = (wg - 128) * 8 + C.wid; ssm_sample_item(C, l, i / NG, i % NG); } }
            else { for (int r = gw; r < MR; r += NGW) kvfix_row(C, l, r);
                   for (int i = gw; i < SB * NG; i += NGW) ssm_sample_item(C, l, i / NG, i % NG); } }
            __syncthreads();
            const int nss = G > 16 ? G - 8 : G, ncm = G > 16 ? 8 : G, ccm = G > 16 ? wg - nss : wg;
            if ((variant == 0 || variant == 2) && wg < nss) for (int u = wg; u < NB * NG; u += nss) ssm_unit(C, l, u / NG, u % NG);
            {   pg8::Gemm g{(const pg8::bf16_t*)(ws + WS_KVC), (const pg8::bf16_t*)(ws + WS_W1C) + (size_t)l * 2 * 256 * 2048, 0, 0, 2048};
                pg8::GroupOrder S{8, ncm, (variant == 0 || variant == 3) ? ccm : -1, 4}; pg8::EpiTB E{(float*)(ws + WS_TBP)};
                pg8::gemm_phase<pg8::EpiTB, pg8::GroupOrder, true, true>(lds, g, S, E); }
            if (ccm >= 0 && (variant == 0 || variant == 3)) { VM_WAIT(); __syncthreads();
                for (int L = ccm; L < 8; L += ncm) for (int h2 = 0; h2 < 2; ++h2) { const int u = 2 * L + h2, kv = u >> 3;
                    cmp_stage2_unit(C, (const float*)(ws + WS_TBP), (size_t)u * 128, 0, 127, C.in[kv ? I_B1V : I_B1K] + l * 128, (const bf16*)(ws + WS_W2T) + (size_t)(l * 2 + kv) * 128 * 128,
                                    kv ? nullptr : C.in[I_KNC] + l * 128, (bf16*)(ws + WS_CKVP) + (size_t)u * 128 * 128); } }
        }
        SEAM(pb + 1);
        if (SITE(5) && IN(pb + 2)) { SITE_BEGIN();
            const bool fast = (G == 256);
            int gc = wg, gG = G;
            if (fast) { gG = 1 << 20; gc = 1 << 20;
                if (wg < 64) gc = wg; else if (wg >= 128) { const int p = wg - 128, j = p >> 3; if (j < 9) gc = 64 + 8 * j + (p & 7); } }
            {   pg8::Gemm g{(const pg8::bf16_t*)(ws + WS_Z), (const pg8::bf16_t*)(ws + WS_WGLU) + (size_t)l * 1024 * 1024, MPAD, 1024, 1024}; if (!(variant == 0 || variant == 4)) { gc = 1 << 20; gG = 1 << 20; }
                pg8::StaticOrder S; S.init(MPAD, 1024, gG, gc);
                pg8::EpiGlu E{(const pg8::bf16_t*)(ws + WS_Z), (pg8::bf16_t*)(ws + WS_SSMY)};
                pg8::gemm_phase<pg8::EpiGlu, pg8::StaticOrder, true, true>(lds, g, S, E); }
            __syncthreads();
#ifndef NO_SA
            if (fast) { if (wg < 64 && (variant == 0 || variant == 5)) attn_sample_unit(C, l, wg >> 3, (wg >> 2) & 1, wg & 3); }
            else for (int s = wg; s < 64; s += G) attn_sample_unit(C, l, s >> 3, (s >> 2) & 1, s & 3);
#endif
#ifndef NO_PA
            if (fast && (variant == 0 || variant == 6)) {
                if (wg >= 128) { const int p = wg - 128, bk = p & 7; attn_prompt_unit(C, l, bk >> 1, bk & 1, 16 + (p >> 3)); }
                else if (wg >= 64) { const int p = wg - 64, bk = p & 7, k = p >> 3;
                    for (int t2 = 0; t2 < 2; ++t2) attn_prompt_unit(C, l, bk >> 1, bk & 1, t2 == 0 ? 15 - k : k); }
            } else if (!fast) for (int u = wg; u < 256; u += G) { const int qb = u & 31, bk = u >> 5; attn_prompt_unit(C, l, bk >> 1, bk & 1, qb); }
#endif
        }
        SEAM(pb + 2);
        if (SITE(6) && IN(pb + 3)) { SITE_BEGIN(); for (int r = gw; r < MR; r += 4 * NGW) { const int left = (MR - r + NGW - 1) / NGW; mixnorm_rows<4>(C, l, r, NGW, left < 4 ? left : 4); } }
        SEAM(pb + 3);
        if (SITE(7) && IN(pb + 4)) { SITE_BEGIN();
            const void* bp = l == 0 ? (const void*)C.in[I_XP] : (const void*)(ws + WS_XN); const void* bs = l == 0 ? (const void*)C.in[I_XS] : (const void*)((const bf16*)(ws + WS_XN) + (size_t)MP * DM);
            const pg8::bf16_t* Wt = (const pg8::bf16_t*)(ws + WS_WOUT) + (size_t)l * DM * DM;
            {   pg8::Gemm g{(const pg8::bf16_t*)(ws + WS_H), Wt, MP, DM, DM}; pg8::StaticOrder S; S.init(MP, DM, G, wg); pg8::EpiRes<(l == 0), false> E{bp, (void*)(ws + WS_HN), (float*)(ws + WS_PS)};
                pg8::gemm_phase<pg8::EpiRes<(l == 0), false>, pg8::StaticOrder, true, true>(lds, g, S, E); }
            __syncthreads();
            sample_gemm_res<(l == 0), false>(C, (const bf16*)(ws + WS_H) + (size_t)MP * DM, Wt, DM, bs, (void*)((bf16*)(ws + WS_HN) + (size_t)MP * DM), wg, G, (float*)(ws + WS_PSS));
        }
        SEAM(pb + 4);
        if (SITE(8) && IN(pb + 5)) { SITE_BEGIN();
            pg8::Gemm g{(const pg8::bf16_t*)(ws + DBG_GU_A), (const pg8::bf16_t*)(ws + WS_WGU) + (size_t)l * 2 * DFF * DM, MPAD, 2 * DFF, DM}; pg8::StaticOrder S; S.init(MPAD, 2 * DFF, G, wg);
            prenorm_prologue(C, S, (const float*)(ws + WS_PS), (const float*)(ws + WS_PSS));
            pg8::EpiSwiGLU E{(pg8::bf16_t*)(ws + WS_HMID), (const PG8_LAS float*)(lds + LDS_RS), 0};
#ifdef DBG_ONEUNIT
            for (int ui = 0; ui < 6; ++ui) { pg8::OneUnitOrder S1{S, ui}; pg8::gemm_phase<pg8::EpiSwiGLU, pg8::OneUnitOrder, true, true>(lds, g, S1, E); __syncthreads(); }
#else
            pg8::gemm_phase<pg8::EpiSwiGLU, pg8::StaticOrder, true, true>(lds, g, S, E);
#endif
            if (l == 0 && G == 256 && wg >= 172) {
                __syncthreads(); LAS float* scr = (LAS float*)(C.lds + C.wid * 16384);
                for (int i = (wg - 172) * 8 + C.wid; i < TI_DN + TI_GLU + TI_IN_DEF; i += 84 * 8)
                    weight_item(C, TI_LAYER + (i < TI_DN ? TI_IN + TI_GLU + TI_OUT + 2 * TI_G + i : (i < TI_DN + TI_GLU ? TI_IN + (i - TI_DN) : i - TI_DN - TI_GLU)), scr); }
        }
        SEAM(pb + 5);
        if (SITE(9) && IN(pb + 6)) { SITE_BEGIN();
            void* op = l == 0 ? (void*)(ws + WS_XN) : (void*)(C.out + O_YP); void* os = l == 0 ? (void*)((bf16*)(ws + WS_XN) + (size_t)MP * DM) : (void*)(C.out + O_YS);
            const pg8::bf16_t* Wt = (const pg8::bf16_t*)(ws + WS_WDN) + (size_t)l * DM * DFF;
            {   pg8::Gemm g{(const pg8::bf16_t*)(ws + WS_HMID), Wt, MP, DM, DFF}; pg8::StaticOrder S; S.init(MP, DM, G, wg); pg8::EpiRes<false, (l == 1)> E{(const void*)(ws + WS_HN), op, l == 0 ? (float*)(ws + WS_PS) : nullptr};
                pg8::gemm_phase<pg8::EpiRes<false, (l == 1)>, pg8::StaticOrder, true, true>(lds, g, S, E); }
            __syncthreads();
            sample_gemm_res<false, (l == 1)>(C, (const bf16*)(ws + WS_HMID) + (size_t)MP * DFF, Wt, DFF, (const void*)((const bf16*)(ws + WS_HN) + (size_t)MP * DM), os, wg, G, l == 0 ? (float*)(ws + WS_PSS) : nullptr);
        }
        SEAM(pb + 6);
    }
    {
        constexpr int l = 1, pb = 2 + 7 * l;
        if (SITE(3) && IN(pb + 0)) { SITE_BEGIN();
            if (l == 0) {
            for (int u = wg; u < 512; u += G) { const int seq = u >> 3, blk = u & 7, lk = seq >> 4, l = lk >> 1, kv = lk & 1;
                cmp_stage2_unit(C, (const float*)(ws + WS_TBS), (size_t)seq * 1024, blk * 128, 1023, C.in[kv ? I_B1V : I_B1K] + l * 128, (const bf16*)(ws + WS_W2T) + (size_t)lk * 128 * 128,
                                kv ? nullptr : C.in[I_KNC] + l * 128, (bf16*)(ws + WS_CKVS) + ((size_t)seq * 1024 + blk * 128) * 128); }

                __syncthreads(); }
            pg8::Gemm g{(const pg8::bf16_t*)(ws + WS_XN), (const pg8::bf16_t*)(ws + WS_WIN) + (size_t)l * INWP * DM, MPAD, INWP, DM}; pg8::StaticOrder S; S.init(MPAD, INWP, G, wg);
            if (l == 0) prenorm_prologue(C, S, nullptr, nullptr); else prenorm_prologue(C, S, (const float*)(ws + WS_PS), (const float*)(ws + WS_PSS));
            pg8::EpiIn E{(pg8::bf16_t*)(ws + WS_U), (pg8::bf16_t*)(ws + WS_US), (pg8::bf16_t*)(ws + WS_Q), (float*)(ws + WS_KVRAW), (float*)(ws + WS_GT), (pg8::bf16_t*)(ws + WS_KVC), (const PG8_LAS float*)(lds + LDS_RS), 0};
            pg8::gemm_phase<pg8::EpiIn, pg8::StaticOrder, true, true>(lds, g, S, E);
            if (l == 0 && G == 256 && wg >= 239) {
                __syncthreads(); LAS float* scr = (LAS float*)(C.lds + C.wid * 16384);
                for (int i = (wg - 239) * 8 + C.wid; i < TI_OUT; i += 17 * 8) weight_item(C, TI_LAYER + TI_IN + TI_GLU + i, scr); }
        }
        SEAM(pb + 0);
        if (SITE(4) && IN(pb + 1)) { SITE_BEGIN();
            const bool fast = (G == 256);
            if (variant == 0 || variant == 1) {
            if (fast) { if (wg >= 8 && wg < 248) for (int r = (wg - 8) * 8 + C.wid; r < MR; r += 240 * 8) kvfix_row(C, l, r);
                        if (wg >= 128 && wg < 192) { const int i = (wg - 128) * 8 + C.wid; ssm_sample_item(C, l, i / NG, i % NG); } }
            else { for (int r = gw; r < MR; r += NGW) kvfix_row(C, l, r);
                   for (int i = gw; i < SB * NG; i += NGW) ssm_sample_item(C, l, i / NG, i % NG); } }
            __syncthreads();
            const int nss = G > 16 ? G - 8 : G, ncm = G > 16 ? 8 : G, ccm = G > 16 ? wg - nss : wg;
            if ((variant == 0 || variant == 2) && wg < nss) for (int u = wg; u < NB * NG; u += nss) ssm_unit(C, l, u / NG, u % NG);
            {   pg8::Gemm g{(const pg8::bf16_t*)(ws + WS_KVC), (const pg8::bf16_t*)(ws + WS_W1C) + (size_t)l * 2 * 256 * 2048, 0, 0, 2048};
                pg8::GroupOrder S{8, ncm, (variant == 0 || variant == 3) ? ccm : -1, 4}; pg8::EpiTB E{(float*)(ws + WS_TBP)};
                pg8::gemm_phase<pg8::EpiTB, pg8::GroupOrder, true, true>(lds, g, S, E); }
            if (ccm >= 0 && (variant == 0 || variant == 3)) { VM_WAIT(); __syncthreads();
                for (int L = ccm; L < 8; L += ncm) for (int h2 = 0; h2 < 2; ++h2) { const int u = 2 * L + h2, kv = u >> 3;
                    cmp_stage2_unit(C, (const float*)(ws + WS_TBP), (size_t)u * 128, 0, 127, C.in[kv ? I_B1V : I_B1K] + l * 128, (const bf16*)(ws + WS_W2T) + (size_t)(l * 2 + kv) * 128 * 128,
                                    kv ? nullptr : C.in[I_KNC] + l * 128, (bf16*)(ws + WS_CKVP) + (size_t)u * 128 * 128); } }
        }
        SEAM(pb + 1);
        if (SITE(5) && IN(pb + 2)) { SITE_BEGIN();
            const bool fast = (G == 256);
            int gc = wg, gG = G;
            if (fast) { gG = 1 << 20; gc = 1 << 20;
                if (wg < 64) gc = wg; else if (wg >= 128) { const int p = wg - 128, j = p >> 3; if (j < 9) gc = 64 + 8 * j + (p & 7); } }
            {   pg8::Gemm g{(const pg8::bf16_t*)(ws + WS_Z), (const pg8::bf16_t*)(ws + WS_WGLU) + (size_t)l * 1024 * 1024, MPAD, 1024, 1024}; if (!(variant == 0 || variant == 4)) { gc = 1 << 20; gG = 1 << 20; }
                pg8::StaticOrder S; S.init(MPAD, 1024, gG, gc);
                pg8::EpiGlu E{(const pg8::bf16_t*)(ws + WS_Z), (pg8::bf16_t*)(ws + WS_SSMY)};
                pg8::gemm_phase<pg8::EpiGlu, pg8::StaticOrder, true, true>(lds, g, S, E); }
            __syncthreads();
#ifndef NO_SA
            if (fast) { if (wg < 64 && (variant == 0 || variant == 5)) attn_sample_unit(C, l, wg >> 3, (wg >> 2) & 1, wg & 3); }
            else for (int s = wg; s < 64; s += G) attn_sample_unit(C, l, s >> 3, (s >> 2) & 1, s & 3);
#endif
#ifndef NO_PA
            if (fast && (variant == 0 || variant == 6)) {
                if (wg >= 128) { const int p = wg - 128, bk = p & 7; attn_prompt_unit(C, l, bk >> 1, bk & 1, 16 + (p >> 3)); }
                else if (wg >= 64) { const int p = wg - 64, bk = p & 7, k = p >> 3;
                    for (int t2 = 0; t2 < 2; ++t2) attn_prompt_unit(C, l, bk >> 1, bk & 1, t2 == 0 ? 15 - k : k); }
            } else if (!fast) for (int u = wg; u < 256; u += G) { const int qb = u & 31, bk = u >> 5; attn_prompt_unit(C, l, bk >> 1, bk & 1, qb); }
#endif
        }
        SEAM(pb + 2);
        if (SITE(6) && IN(pb + 3)) { SITE_BEGIN(); for (int r = gw; r < MR; r += 4 * NGW) { const int left = (MR - r + NGW - 1) / NGW; mixnorm_rows<4>(C, l, r, NGW, left < 4 ? left : 4); } }
        SEAM(pb + 3);
        if (SITE(7) && IN(pb + 4)) { SITE_BEGIN();
            const void* bp = l == 0 ? (const void*)C.in[I_XP] : (const void*)(ws + WS_XN); const void* bs = l == 0 ? (const void*)C.in[I_XS] : (const void*)((const bf16*)(ws + WS_XN) + (size_t)MP * DM);
            const pg8::bf16_t* Wt = (const pg8::bf16_t*)(ws + WS_WOUT) + (size_t)l * DM * DM;
            {   pg8::Gemm g{(const pg8::bf16_t*)(ws + WS_H), Wt, MP, DM, DM}; pg8::StaticOrder S; S.init(MP, DM, G, wg); pg8::EpiRes<(l == 0), false> E{bp, (void*)(ws + WS_HN), (float*)(ws + WS_PS)};
                pg8::gemm_phase<pg8::EpiRes<(l == 0), false>, pg8::StaticOrder, true, true>(lds, g, S, E); }
            __syncthreads();
            sample_gemm_res<(l == 0), false>(C, (const bf16*)(ws + WS_H) + (size_t)MP * DM, Wt, DM, bs, (void*)((bf16*)(ws + WS_HN) + (size_t)MP * DM), wg, G, (float*)(ws + WS_PSS));
        }
        SEAM(pb + 4);
        if (SITE(8) && IN(pb + 5)) { SITE_BEGIN();
            pg8::Gemm g{(const pg8::bf16_t*)(ws + DBG_GU_A), (const pg8::bf16_t*)(ws + WS_WGU) + (size_t)l * 2 * DFF * DM, MPAD, 2 * DFF, DM}; pg8::StaticOrder S; S.init(MPAD, 2 * DFF, G, wg);
            prenorm_prologue(C, S, (const float*)(ws + WS_PS), (const float*)(ws + WS_PSS));
            pg8::EpiSwiGLU E{(pg8::bf16_t*)(ws + WS_HMID), (const PG8_LAS float*)(lds + LDS_RS), 0};
#ifdef DBG_ONEUNIT
            for (int ui = 0; ui < 6; ++ui) { pg8::OneUnitOrder S1{S, ui}; pg8::gemm_phase<pg8::EpiSwiGLU, pg8::OneUnitOrder, true, true>(lds, g, S1, E); __syncthreads(); }
#else
            pg8::gemm_phase<pg8::EpiSwiGLU, pg8::StaticOrder, true, true>(lds, g, S, E);
#endif
            if (l == 0 && G == 256 && wg >= 172) {
                __syncthreads(); LAS float* scr = (LAS float*)(C.lds + C.wid * 16384);
                for (int i = (wg - 172) * 8 + C.wid; i < TI_DN + TI_GLU + TI_IN_DEF; i += 84 * 8)
                    weight_item(C, TI_LAYER + (i < TI_DN ? TI_IN + TI_GLU + TI_OUT + 2 * TI_G + i : (i < TI_DN + TI_GLU ? TI_IN + (i - TI_DN) : i - TI_DN - TI_GLU)), scr); }
        }
        SEAM(pb + 5);
        if (SITE(9) && IN(pb + 6)) { SITE_BEGIN();
            void* op = l == 0 ? (void*)(ws + WS_XN) : (void*)(C.out + O_YP); void* os = l == 0 ? (void*)((bf16*)(ws + WS_XN) + (size_t)MP * DM) : (void*)(C.out + O_YS);
            const pg8::bf16_t* Wt = (const pg8::bf16_t*)(ws + WS_WDN) + (size_t)l * DM * DFF;
            {   pg8::Gemm g{(const pg8::bf16_t*)(ws + WS_HMID), Wt, MP, DM, DFF}; pg8::StaticOrder S; S.init(MP, DM, G, wg); pg8::EpiRes<false, (l == 1)> E{(const void*)(ws + WS_HN), op, l == 0 ? (float*)(ws + WS_PS) : nullptr};
                pg8::gemm_phase<pg8::EpiRes<false, (l == 1)>, pg8::StaticOrder, true, true>(lds, g, S, E); }
            __syncthreads();
            sample_gemm_res<false, (l == 1)>(C, (const bf16*)(ws + WS_HMID) + (size_t)MP * DFF, Wt, DFF, (const void*)((const bf16*)(ws + WS_HN) + (size_t)MP * DM), os, wg, G, l == 0 ? (float*)(ws + WS_PSS) : nullptr);
        }
        SEAM(pb + 6);
    }
#ifdef DBG_DUMP_OFF
    if (IN(99)) { const size_t gt = (size_t)blockIdx.x * 512 + threadIdx.x, NT = (size_t)gridDim.x * 512;
#ifdef DBG_DUMP_BF16
        const bf16* src = (const bf16*)(a.ws + (size_t)(DBG_DUMP_OFF));
        const float marker = a.out[O_SSMS];
        for (size_t i = gt; i < (size_t)(DBG_DUMP_N); i += NT) { float* d = i < (size_t)MP * DM ? a.out + O_YP + i : a.out + O_YS + (i - (size_t)MP * DM); float v = bf2f(src[i]);
#ifdef DBG_LOWBITS
            v = (float)(src[i] & 0xFFu);
#endif
#ifdef DBG_PERTURB
            if (marker != 1.0f && i >= 1000 && i < 1000 + DBG_PERTURB) v = v * 2.0f + 1.0f;
#endif
            *d = v; }
        __syncthreads();
        if (gt == 0) { __builtin_amdgcn_s_sleep(100); a.out[O_SSMS] = 1.0f; }
#else
#ifdef DBG_DUMP_FROM_OUT
        const float* src = (const float*)(a.out + (size_t)(DBG_DUMP_OFF));
#else
        const float* src = (const float*)(a.ws + (size_t)(DBG_DUMP_OFF));
#endif
        for (size_t i = gt; i < (size_t)(DBG_DUMP_N) / 4; i += NT) { const size_t o = 4 * i; float* d = o < (size_t)MP * DM ? a.out + O_YP + o : a.out + O_YS + (o - (size_t)MP * DM); f32x4 vv = *(const f32x4*)(src + o);
#ifdef DBG_LOWBITS
            for (int q = 0; q < 4; ++q) vv[q] = (float)(__float_as_uint(vv[q]) & 0xFFu);
#endif
            *(f32x4*)d = vv; }
#endif
    }
#endif
#undef IN
#undef SEAM
}

extern "C" void kernel_launch(void* const* d_in, const int* in_sizes, int n_in, void* d_out, int out_size, void* d_ws, size_t ws_size, hipStream_t stream) {
    static int grid = 0;
    if (grid == 0) {
        if (n_in != NIN || (size_t)out_size != O_END || ws_size < WS_END) { fprintf(stderr, "kernel_launch: shape mismatch: n_in %d out %d ws %zu (need %d, %zu, >= %zu)\n", n_in, out_size, ws_size, NIN, (size_t)O_END, (size_t)WS_END); grid = -1; return; }
        int dev = 0, cus = 0, per_cu = 0;
        if (hipGetDevice(&dev) != hipSuccess || hipDeviceGetAttribute(&cus, hipDeviceAttributeMultiprocessorCount, dev) != hipSuccess) { fprintf(stderr, "kernel_launch: device query failed\n"); grid = -1; return; }
        if (hipFuncSetAttribute((const void*)hymba_fwd, hipFuncAttributeMaxDynamicSharedMemorySize, LDS_BYTES) != hipSuccess) { fprintf(stderr, "kernel_launch: hipFuncSetAttribute(%d) failed\n", LDS_BYTES); grid = -1; return; }
        if (hipOccupancyMaxActiveBlocksPerMultiprocessor(&per_cu, (const void*)hymba_fwd, 512, LDS_BYTES) != hipSuccess || per_cu < 1) fprintf(stderr, "kernel_launch: occupancy query says %d\n", per_cu);
        (void)hipGetLastError();
        grid = cus;
    }
    if (grid < 0) return;
#ifdef DBG_MEMSET_WS
    (void)hipMemsetAsync((char*)d_ws + CTL_BYTES, 0x11, WS_END - CTL_BYTES, stream);
#endif
    if (hipMemsetAsync((char*)d_ws + WS_CTL, 0, CTL_BYTES, stream) != hipSuccess) { fprintf(stderr, "kernel_launch: memset failed\n"); return; }
    Args a{};
    for (int i = 0; i < NIN; ++i) a.in[i] = (const float*)d_in[i];
    a.out = (float*)d_out; a.ws = (unsigned char*)d_ws;
#if MK_MULTI
#ifdef DBG_STOP
    for (int ph = 0; ph < DBG_STOP; ++ph) { a.ph_lo = ph; a.ph_hi = ph + 1; hipLaunchKernelGGL(hymba_fwd, dim3(grid), dim3(512), LDS_BYTES, stream, a); }
#ifdef DBG_EXTRA_PHASE
    a.ph_lo = DBG_EXTRA_PHASE; a.ph_hi = DBG_EXTRA_PHASE + 1; hipLaunchKernelGGL(hymba_fwd, dim3(grid), dim3(512), LDS_BYTES, stream, a);
#endif
#ifdef DBG_REPEAT12
    for (int rr = 0; rr < DBG_REPEAT12; ++rr) { a.ph_lo = 12; a.ph_hi = 13; hipLaunchKernelGGL(hymba_fwd, dim3(grid), dim3(512), LDS_BYTES, stream, a); }
#endif
#ifdef DBG_DUMP_OFF
    a.ph_lo = 99; a.ph_hi = 100; hipLaunchKernelGGL(hymba_fwd, dim3(grid), dim3(512), LDS_BYTES, stream, a);
#endif
#else
    for (int ph = 0; ph < NPH; ++ph) { a.ph_lo = ph; a.ph_hi = ph + 1; hipLaunchKernelGGL(hymba_fwd, dim3(grid), dim3(512), LDS_BYTES, stream, a); }
#endif
#else
    a.ph_lo = 0; a.ph_hi = NPH; hipLaunchKernelGGL(hymba_fwd, dim3(grid), dim3(512), LDS_BYTES, stream, a);
#ifndef PROBE_VARIANT
#define PROBE_VARIANT 0
#endif
#ifdef PROBE_EXTRA_PHASE
    (void)hipMemsetAsync((char*)d_ws + WS_CTL, 0, CTL_BYTES, stream);
    a.ph_lo = PROBE_EXTRA_PHASE; a.ph_hi = PROBE_EXTRA_PHASE + 1 + 1000 * PROBE_VARIANT; hipLaunchKernelGGL(hymba_fwd, dim3(grid), dim3(512), LDS_BYTES, stream, a);
#endif
#endif
    const hipError_t le = hipPeekAtLastError();
    if (le != hipSuccess) fprintf(stderr, "kernel_launch: launch failed: %s\n", hipGetErrorName(le));
}
```

```cpp
#include <hip/hip_runtime.h>
#include <cstdio>
#include <cstdint>

#ifndef MK_MULTI
#define MK_MULTI 0
#endif

namespace pg8 {
#define PG8_LAS __attribute__((address_space(3)))
typedef unsigned short bf16_t;
typedef short bf16x8 __attribute__((ext_vector_type(8)));
typedef float f32x4 __attribute__((ext_vector_type(4)));
typedef unsigned u32x4 __attribute__((ext_vector_type(4)));
constexpr int BM = 256, BK = 64, HALF = 128, HTB = HALF * BK * 2  , STAGE_BYTES = 8 * HTB, NXCD = 8, WGM = 8;

__host__ __device__ __forceinline__ int lds_byte(int r, int c) { const int st = (r >> 4) * 2 + (c >> 5), rr = r & 15, cc = c & 31, ob = rr * 64 + cc * 2; return st * 1024 + (ob ^ (((ob >> 9) & 1) << 5)); }
__host__ __device__ __forceinline__ void stage_rc(int b, int& R, int& C) { const int st = b / 1024, sb = b % 1024, swz = sb ^ (((sb >> 9) & 1) << 5); R = (st >> 1) * 16 + swz / 64; C = (st & 1) * 32 + (swz % 64) / 2; }
__host__ __device__ __forceinline__ int perm32(int rho) { const int n = rho >> 4, i = rho & 15; return 8 * (i >> 2) + 4 * n + (i & 3); }

struct Unit { int pm, pn; };
struct Gemm { const bf16_t* A; const bf16_t* Bt; int M, N, K; };

struct StaticOrder {
    int nM, nN, nwg, G, c;
    __host__ __device__ void init(int M, int N, int G_, int c_) { nM = M / BM; nN = N / BM; nwg = nM * nN; G = G_; c = c_; }
    __host__ __device__ bool next(int i, Unit& u) const {
        const long L = (long)i * G + c; if (L >= nwg) return false;
        int wgid = (int)L; { const int q = nwg / NXCD, r = nwg % NXCD, xcd = wgid % NXCD, off = wgid / NXCD; wgid = (xcd < r ? xcd * (q + 1) : r * (q + 1) + (xcd - r) * q) + off; }
        const int nig = WGM * nN, gid = wgid / nig, fm = gid * WGM, gsz = (nM - fm) < WGM ? (nM - fm) : WGM;
        u.pm = fm + ((wgid % nig) % gsz); u.pn = (wgid % nig) / gsz; return true;
    }
    __device__ __forceinline__ void a_ready(const Unit&) const {}
    __device__ __forceinline__ void done(const Unit&) const {}
};
__device__ __forceinline__ unsigned cvt_pk_bf16(float lo, float hi) { unsigned r; asm volatile("v_cvt_pk_bf16_f32 %0, %1, %2" : "=v"(r) : "v"(lo), "v"(hi)); return r; }
typedef float f32x2 __attribute__((ext_vector_type(2)));
typedef unsigned u32x2 __attribute__((ext_vector_type(2)));
__device__ __forceinline__ float fast_sigmoid(float x) { return __builtin_amdgcn_rcpf(1.0f + __builtin_amdgcn_exp2f(-1.4426950408889634f * x)); }
__device__ __forceinline__ float gelu_tanh(float x) { const float a = 1.5957691216057308f * (x + 0.044715f * x * x * x); return x * fast_sigmoid(a); }

struct GroupOrder {
    int n, G, c, per;
    __device__ bool next(int i, Unit& u) const { const int L = i * G + c; if (c < 0 || L >= n) return false; u.pm = L; u.pn = L / per; return true; }
    __device__ __forceinline__ void a_ready(const Unit&) const {}
    __device__ __forceinline__ void done(const Unit&) const {}
};

struct OneUnitOrder {
    StaticOrder S; int i;
    __device__ bool next(int k, Unit& u) const { return k == 0 ? S.next(i, u) : false; }
    __device__ __forceinline__ void a_ready(const Unit&) const {}
    __device__ __forceinline__ void done(const Unit&) const {}
};
struct EpiIn {
    static constexpr bool PERM = true, AFTER_DRAIN = false;
    bf16_t* U; bf16_t* Us; bf16_t* Q; float* KVraw; float* Gt; bf16_t* KVC; const PG8_LAS float* RS; mutable int slot;
    __device__ __forceinline__ void operator()(const f32x4 (&acc)[2][2][4][2], const Unit& u, int wr, int wc, int fr, int fq) const {
        const int pn = u.pn, cw = wc * 32 + 8 * fq; const PG8_LAS float* rsp = RS + slot * 256 + wr * 64 + fr; ++slot;
#pragma unroll
        for (int ai = 0; ai < 2; ++ai)
#pragma unroll
            for (int m = 0; m < 4; ++m) {
                const int row = u.pm * BM + ai * HALF + wr * 64 + m * 16 + fr; const float rs = rsp[ai * HALF + m * 16];
                if (row < 8224) {
#pragma unroll
                    for (int bj = 0; bj < 2; ++bj) {
                        const int col = pn * BM + bj * HALF + cw; const f32x4 v0 = acc[ai][bj][m][0] * rs, v1 = acc[ai][bj][m][1] * rs;
                        if (pn < 8) {
                            u32x4 w; w.x = cvt_pk_bf16(v0[0], v0[1]); w.y = cvt_pk_bf16(v0[2], v0[3]); w.z = cvt_pk_bf16(v1[0], v1[1]); w.w = cvt_pk_bf16(v1[2], v1[3]);
                            if (pn < 4) {
                                if (row < 8192) { const int b = row >> 11, t = row & 2047, g = col >> 4, p0 = col & 15;
                                    *(u32x4*)(U + ((size_t)((b * 64 + g) * 2048 + t) * 16 + p0)) = w; }
                                else *(u32x4*)(Us + (size_t)(row - 8192) * 1024 + col) = w;
                            } else *(u32x4*)(Q + (size_t)row * 1024 + (col - 1024)) = w;
                        } else if (pn < 14) {
                            float* d = KVraw + (size_t)row * 1536 + (col - 2048); *(f32x4*)d = v0; *(f32x4*)(d + 4) = v1;
                            if (pn < 10 && row < 8192) {
                                u32x4 w; w.x = cvt_pk_bf16(v0[0], v0[1]); w.y = cvt_pk_bf16(v0[2], v0[3]); w.z = cvt_pk_bf16(v1[0], v1[1]); w.w = cvt_pk_bf16(v1[2], v1[3]);
                                const int b = row >> 11, t = row & 2047; *(u32x4*)(KVC + ((size_t)(((pn - 8) * 4 + b) * 2 + bj) * 2048 + t) * 128 + cw) = w; }
                        } else {
                            const int cc = col - 3584;
                            if (cc < 24) { f32x4 a, b2;
#pragma unroll
                                for (int j = 0; j < 4; ++j) { a[j] = fast_sigmoid(v0[j]); b2[j] = fast_sigmoid(v1[j]); }
                                float* d = Gt + (size_t)row * 32 + cc; *(f32x4*)d = a; *(f32x4*)(d + 4) = b2; }
                        }
                    }
                }
            }
    }
};
struct EpiTB {
    static constexpr bool PERM = false, AFTER_DRAIN = false;
    float* C;
    __device__ __forceinline__ void operator()(const f32x4 (&acc)[2][2][4][2], const Unit& u, int wr, int wc, int fr, int fq) const {
#pragma unroll
        for (int ai = 0; ai < 2; ++ai)
#pragma unroll
            for (int m = 0; m < 4; ++m) { float* rowp = C + (size_t)(u.pm * BM + ai * HALF + wr * 64 + m * 16 + fr) * 256 + wc * 32 + 4 * fq;
#pragma unroll
                for (int bj = 0; bj < 2; ++bj)
#pragma unroll
                    for (int n = 0; n < 2; ++n) *(f32x4*)(rowp + bj * HALF + n * 16) = acc[ai][bj][m][n]; }
    }
};
struct EpiGlu {
    static constexpr bool PERM = true, AFTER_DRAIN = false;
    const bf16_t* Z; bf16_t* Y;
    __device__ __forceinline__ void operator()(const f32x4 (&acc)[2][2][4][2], const Unit& u, int wr, int wc, int fr, int fq) const {
#pragma unroll
        for (int ai = 0; ai < 2; ++ai) { u32x4 zz[4][2];
#pragma unroll
            for (int m = 0; m < 4; ++m) { const size_t off = (size_t)(u.pm * BM + ai * HALF + wr * 64 + m * 16 + fr) * 1024 + u.pn * BM + wc * 32 + 8 * fq; zz[m][0] = *(const u32x4*)(Z + off); zz[m][1] = *(const u32x4*)(Z + off + HALF); }
#pragma unroll
            for (int m = 0; m < 4; ++m) { const size_t off = (size_t)(u.pm * BM + ai * HALF + wr * 64 + m * 16 + fr) * 1024 + u.pn * BM + wc * 32 + 8 * fq;
#pragma unroll
                for (int bj = 0; bj < 2; ++bj) { const u32x4 z = zz[m][bj]; const f32x4 v0 = acc[ai][bj][m][0], v1 = acc[ai][bj][m][1];
                    float zf[8];
#pragma unroll
                    for (int j = 0; j < 4; ++j) { zf[2 * j] = __uint_as_float(z[j] << 16); zf[2 * j + 1] = __uint_as_float(z[j] & 0xffff0000u); }
                    u32x4 w; w.x = cvt_pk_bf16(zf[0] * fast_sigmoid(v0[0]), zf[1] * fast_sigmoid(v0[1])); w.y = cvt_pk_bf16(zf[2] * fast_sigmoid(v0[2]), zf[3] * fast_sigmoid(v0[3]));
                    w.z = cvt_pk_bf16(zf[4] * fast_sigmoid(v1[0]), zf[5] * fast_sigmoid(v1[1])); w.w = cvt_pk_bf16(zf[6] * fast_sigmoid(v1[2]), zf[7] * fast_sigmoid(v1[3]));
                    *(u32x4*)(Y + off + bj * HALF) = w; } } }
    }
};
template <bool BF32, bool OF32> struct EpiRes {
    static constexpr bool PERM = true, AFTER_DRAIN = false;
    const void* base; void* out; float* PS;
    __device__ __forceinline__ void operator()(const f32x4 (&acc)[2][2][4][2], const Unit& u, int wr, int wc, int fr, int fq) const {
        const int col0 = u.pn * BM + wc * 32 + 8 * fq;
        constexpr int MG = BF32 ? 2 : 4;
#pragma unroll
        for (int ai = 0; ai < 2; ++ai)
#pragma unroll
            for (int m0 = 0; m0 < 4; m0 += MG) {
                f32x4 bf[MG][2][2]; u32x4 bh[MG][2];
#pragma unroll
                for (int mm = 0; mm < MG; ++mm) { const size_t off = (size_t)(u.pm * BM + ai * HALF + wr * 64 + (m0 + mm) * 16 + fr) * 2048 + col0;
#pragma unroll
                    for (int bj = 0; bj < 2; ++bj) { if (BF32) { bf[mm][bj][0] = *(const f32x4*)((const float*)base + off + bj * HALF); bf[mm][bj][1] = *(const f32x4*)((const float*)base + off + bj * HALF + 4); }
                                                     else bh[mm][bj] = *(const u32x4*)((const bf16_t*)base + off + bj * HALF); } }
#pragma unroll
                for (int mm = 0; mm < MG; ++mm) { const int m = m0 + mm; const int row = u.pm * BM + ai * HALF + wr * 64 + m * 16 + fr; const size_t off = (size_t)row * 2048 + col0; float ss = 0.f;
#pragma unroll
                    for (int bj = 0; bj < 2; ++bj) { f32x4 b0, b1;
                        if (BF32) { b0 = bf[mm][bj][0]; b1 = bf[mm][bj][1]; }
                        else { const u32x4 w = bh[mm][bj];
                            b0 = (f32x4){__uint_as_float(w.x << 16), __uint_as_float(w.x & 0xffff0000u), __uint_as_float(w.y << 16), __uint_as_float(w.y & 0xffff0000u)};
                            b1 = (f32x4){__uint_as_float(w.z << 16), __uint_as_float(w.z & 0xffff0000u), __uint_as_float(w.w << 16), __uint_as_float(w.w & 0xffff0000u)}; }
                        const f32x4 v0 = b0 + acc[ai][bj][m][0], v1 = b1 + acc[ai][bj][m][1];
                        if (OF32) { *(f32x4*)((float*)out + off + bj * HALF) = v0; *(f32x4*)((float*)out + off + bj * HALF + 4) = v1; }
                        else { u32x4 w; w.x = cvt_pk_bf16(v0[0], v0[1]); w.y = cvt_pk_bf16(v0[2], v0[3]); w.z = cvt_pk_bf16(v1[0], v1[1]); w.w = cvt_pk_bf16(v1[2], v1[3]); *(u32x4*)((bf16_t*)out + off + bj * HALF) = w; }
                        if (PS) ss += ((v0[0] * v0[0] + v0[1] * v0[1]) + (v0[2] * v0[2] + v0[3] * v0[3])) + ((v1[0] * v1[0] + v1[1] * v1[1]) + (v1[2] * v1[2] + v1[3] * v1[3])); }
                    if (PS) { ss += __shfl_xor(ss, 16); ss += __shfl_xor(ss, 32); if (fq == 0) PS[(size_t)row * 32 + u.pn * 4 + wc] = ss; } }
                asm volatile("" ::: "memory"); }
    }
};
struct EpiSwiGLU {
    static constexpr bool PERM = true, AFTER_DRAIN = false;
    bf16_t* Hm; const PG8_LAS float* RS; mutable int slot;
    __device__ __forceinline__ void operator()(const f32x4 (&acc)[2][2][4][2], const Unit& u, int wr, int wc, int fr, int fq) const {
        const PG8_LAS float* rsp = RS + slot * 256 + wr * 64 + fr; ++slot;
#pragma unroll
        for (int ai = 0; ai < 2; ++ai)
#pragma unroll
            for (int m = 0; m < 4; ++m) { const float rs = rsp[ai * HALF + m * 16]; bf16_t* d = Hm + (size_t)(u.pm * BM + ai * HALF + wr * 64 + m * 16 + fr) * 5632 + u.pn * HALF + wc * 32 + 8 * fq;
                float h[8];
#pragma unroll
                for (int n = 0; n < 2; ++n)
#pragma unroll
                    for (int j = 0; j < 4; ++j) { const float gt = acc[ai][0][m][n][j] * rs, up = acc[ai][1][m][n][j] * rs;
#ifdef DBG_NOSIG
                        h[4 * n + j] = gt + 0.5f * up; }
#else
                        h[4 * n + j] = gt * fast_sigmoid(gt) * up; }
#endif

                u32x4 w; w.x = cvt_pk_bf16(h[0], h[1]); w.y = cvt_pk_bf16(h[2], h[3]); w.z = cvt_pk_bf16(h[4], h[5]); w.w = cvt_pk_bf16(h[6], h[7]);
                *(u32x4*)d = w; }
    }
};
template <class Epi, class Sched, bool ALIGN_EPI = false, bool SP2 = false>
__device__ __forceinline__ void gemm_phase(PG8_LAS unsigned char* lds, const Gemm g, const Sched& S, const Epi& E) {
    int tid = threadIdx.x; asm volatile("" : "+v"(tid));
    const int wid = __builtin_amdgcn_readfirstlane(tid >> 6), lane = tid & 63, wr = wid >> 2, wc = wid & 3, fr = lane & 15, fq = lane >> 4;
    const int K = g.K, nt = K / BK;
    unsigned voffA[2], voffB[2];
#pragma unroll
    for (int i = 0; i < 2; ++i) { int R, C; stage_rc(tid * 16 + i * 8192, R, C); const int Rb = Epi::PERM ? ((R & ~31) + perm32(R & 31)) : R;
        voffA[i] = (unsigned)(R * K + C) * 2u; voffB[i] = (unsigned)(Rb * K + C) * 2u; }
    const size_t kstep = (size_t)(BK * 2);
    const size_t hstep = (size_t)HALF * K * 2;
    const size_t tstep = 2 * hstep;
    const unsigned ldsw = (unsigned)wid * 1024u;
    const int aoff = lds_byte(wr * 64 + fr, fq * 8), boff = lds_byte(wc * 32 + fr, fq * 8);
#define PG8_SA(b, h) (((b) * 2 + (h)) * HTB)
#define PG8_SB(b, h) ((4 + (b) * 2 + (h)) * HTB)
#define PG8_STAGE(bufoff, gbase, voff) do { _Pragma("unroll") for (int _i = 0; _i < 2; ++_i) \
        __builtin_amdgcn_global_load_lds((const unsigned*)((const char*)(gbase) + (voff)[_i]), (PG8_LAS unsigned*)(lds + (bufoff) + ldsw + _i * 8192), 16, 0, 0); } while (0)
#define PG8_LDA(dst, b, h) do { _Pragma("unroll") for (int m = 0; m < 4; ++m) _Pragma("unroll") for (int k = 0; k < 2; ++k) dst[m][k] = *(const PG8_LAS bf16x8*)(lds + PG8_SA(b, h) + aoff + m * 2048 + k * 1024); } while (0)
#define PG8_LDB(dst, b, h) do { _Pragma("unroll") for (int n = 0; n < 2; ++n) _Pragma("unroll") for (int k = 0; k < 2; ++k) dst[n][k] = *(const PG8_LAS bf16x8*)(lds + PG8_SB(b, h) + boff + n * 2048 + k * 1024); } while (0)
#define PG8_MMA(ai, bj, At, Bt) do { __builtin_amdgcn_s_setprio(1); _Pragma("unroll") for (int m = 0; m < 4; ++m) _Pragma("unroll") for (int n = 0; n < 2; ++n) _Pragma("unroll") for (int k = 0; k < 2; ++k) \
        acc[ai][bj][m][n] = __builtin_amdgcn_mfma_f32_16x16x32_bf16(Bt[n][k], At[m][k], acc[ai][bj][m][n], 0, 0, 0); __builtin_amdgcn_s_setprio(0); } while (0)
#define PG8_WAIT_V(n) asm volatile("s_waitcnt vmcnt(" #n ")" ::: "memory")
#define PG8_WAIT_L(n) asm volatile("s_waitcnt lgkmcnt(" #n ")" ::: "memory")
#define PG8_BAR __builtin_amdgcn_s_barrier()
#define PG8_SCHED __builtin_amdgcn_sched_barrier(0)
    Unit cur, nxt; int ui = 0;
    if (!S.next(0, cur)) return;
    f32x4 acc[2][2][4][2];
#pragma unroll
    for (int a = 0; a < 2; ++a)
#pragma unroll
        for (int b = 0; b < 2; ++b)
#pragma unroll
            for (int m = 0; m < 4; ++m)
#pragma unroll
                for (int n = 0; n < 2; ++n) acc[a][b][m][n] = (f32x4){0.f, 0.f, 0.f, 0.f};
    bf16x8 At[4][2], B0[2][2], B1[2][2];
    const char* cA = (const char*)g.A + (size_t)cur.pm * tstep; const char* cB = (const char*)g.Bt + (size_t)cur.pn * tstep;
    S.a_ready(cur);
    if constexpr (SP2) {
        PG8_STAGE(PG8_SB(0, 0), cB, voffB); PG8_STAGE(PG8_SB(0, 1), cB + hstep, voffB); PG8_STAGE(PG8_SA(0, 0), cA, voffA); PG8_STAGE(PG8_SA(0, 1), cA + hstep, voffA);
        if (wr == 1) PG8_BAR;
        PG8_WAIT_V(2); PG8_BAR;
        PG8_STAGE(PG8_SB(1, 0), cB + kstep, voffB); PG8_STAGE(PG8_SA(1, 0), cA + kstep, voffA); PG8_STAGE(PG8_SB(1, 1), cB + hstep + kstep, voffB);
        PG8_WAIT_V(6); PG8_BAR;
    } else {
        PG8_STAGE(PG8_SB(0, 0), cB, voffB); PG8_STAGE(PG8_SA(0, 0), cA, voffA); PG8_STAGE(PG8_SB(0, 1), cB + hstep, voffB); PG8_STAGE(PG8_SA(0, 1), cA + hstep, voffA);
        if (wr == 1) PG8_BAR;
        PG8_WAIT_V(4); PG8_BAR;
        PG8_STAGE(PG8_SB(1, 0), cB + kstep, voffB); PG8_STAGE(PG8_SA(1, 0), cA + kstep, voffA); PG8_STAGE(PG8_SB(1, 1), cB + hstep + kstep, voffB);
        PG8_WAIT_V(6); PG8_BAR;
    }
    for (;;) {
        const bool has_next = S.next(ui + 1, nxt);
        const char* nA = has_next ? (const char*)g.A + (size_t)nxt.pm * tstep : cA; const char* nB = has_next ? (const char*)g.Bt + (size_t)nxt.pn * tstep : cB;
        for (int t = 0; t < nt; t += 2) {
            const bool last = (t == nt - 2);
            const char* a1 = cA + (size_t)(t + 1) * kstep;
            const char* a2 = last ? nA : cA + (size_t)(t + 2) * kstep; const char* b2 = last ? nB : cB + (size_t)(t + 2) * kstep;
            const char* a3 = a2 + kstep; const char* b3 = b2 + kstep;
            if (last && has_next) S.a_ready(nxt);
            if constexpr (SP2) {
            PG8_LDB(B0, 0, 0); PG8_LDB(B1, 0, 1); PG8_SCHED; PG8_LDA(At, 0, 0); PG8_STAGE(PG8_SA(1, 1), a1 + hstep, voffA);
            PG8_WAIT_V(8); PG8_WAIT_L(0); PG8_BAR; PG8_MMA(0, 0, At, B0); PG8_MMA(0, 1, At, B1); PG8_BAR; PG8_SCHED;
            PG8_LDA(At, 0, 1); PG8_STAGE(PG8_SB(0, 0), b2, voffB); PG8_STAGE(PG8_SB(0, 1), b2 + hstep, voffB); PG8_STAGE(PG8_SA(0, 0), a2, voffA);
            PG8_WAIT_V(8); PG8_WAIT_L(0); PG8_BAR; PG8_MMA(1, 0, At, B0); PG8_MMA(1, 1, At, B1); PG8_BAR; PG8_SCHED;
            PG8_LDB(B0, 1, 0); PG8_LDB(B1, 1, 1); PG8_SCHED; PG8_LDA(At, 1, 0); PG8_STAGE(PG8_SA(0, 1), a2 + hstep, voffA);
            PG8_WAIT_V(8); PG8_WAIT_L(0); PG8_BAR; PG8_MMA(0, 0, At, B0); PG8_MMA(0, 1, At, B1); PG8_BAR; PG8_SCHED;
            PG8_LDA(At, 1, 1); PG8_STAGE(PG8_SB(1, 0), b3, voffB); PG8_STAGE(PG8_SB(1, 1), b3 + hstep, voffB); PG8_STAGE(PG8_SA(1, 0), a3, voffA);
            PG8_WAIT_V(8); PG8_WAIT_L(0); PG8_BAR; PG8_MMA(1, 0, At, B0); PG8_MMA(1, 1, At, B1); PG8_BAR; PG8_SCHED;
            } else {
            PG8_LDB(B0, 0, 0); PG8_SCHED; PG8_LDA(At, 0, 0); PG8_STAGE(PG8_SA(1, 1), a1 + hstep, voffA);
            PG8_WAIT_L(8); PG8_BAR; PG8_WAIT_L(0); PG8_MMA(0, 0, At, B0); PG8_BAR; PG8_SCHED;
            PG8_LDB(B1, 0, 1); PG8_STAGE(PG8_SB(0, 0), b2, voffB);
            PG8_BAR; PG8_WAIT_L(0); PG8_MMA(0, 1, At, B1); PG8_BAR;
            PG8_LDA(At, 0, 1); PG8_STAGE(PG8_SA(0, 0), a2, voffA);
            PG8_BAR; PG8_WAIT_L(0); PG8_MMA(1, 0, At, B0); PG8_BAR; PG8_SCHED;
            PG8_STAGE(PG8_SB(0, 1), b2 + hstep, voffB);
            PG8_WAIT_V(6); PG8_BAR; PG8_MMA(1, 1, At, B1); PG8_BAR;
            PG8_LDB(B0, 1, 0); PG8_SCHED; PG8_LDA(At, 1, 0); PG8_STAGE(PG8_SA(0, 1), a2 + hstep, voffA);
            PG8_WAIT_L(8); PG8_BAR; PG8_WAIT_L(0); PG8_MMA(0, 0, At, B0); PG8_BAR; PG8_SCHED;
            PG8_LDB(B1, 1, 1); PG8_STAGE(PG8_SB(1, 0), b3, voffB);
            PG8_BAR; PG8_WAIT_L(0); PG8_MMA(0, 1, At, B1); PG8_BAR;
            PG8_LDA(At, 1, 1); PG8_STAGE(PG8_SA(1, 0), a3, voffA);
            PG8_BAR; PG8_WAIT_L(0); PG8_MMA(1, 0, At, B0); PG8_BAR; PG8_SCHED;
            PG8_STAGE(PG8_SB(1, 1), b3 + hstep, voffB);
            PG8_WAIT_V(6); PG8_BAR; PG8_MMA(1, 1, At, B1); PG8_BAR;
            }
        }
        if constexpr (ALIGN_EPI) { if (wr == 0) PG8_BAR; }
        if constexpr (!Epi::AFTER_DRAIN) { E(acc, cur, wr, wc, fr, fq); S.done(cur); }
        if (!has_next) break;
#pragma unroll
        for (int a = 0; a < 2; ++a)
#pragma unroll
            for (int b = 0; b < 2; ++b)
#pragma unroll
                for (int m = 0; m < 4; ++m)
#pragma unroll
                    for (int n = 0; n < 2; ++n) acc[a][b][m][n] = (f32x4){0.f, 0.f, 0.f, 0.f};
        cur = nxt; cA = nA; cB = nB; ++ui;
        if constexpr (ALIGN_EPI) { if (wr == 1) PG8_BAR; }
    }
    PG8_WAIT_V(0);
    if constexpr (!ALIGN_EPI) { if (wr == 0) PG8_BAR; }
    PG8_BAR;
    if constexpr (Epi::AFTER_DRAIN) { E.fused(acc, cur, wr, wc, fr, fq, lds, wid, lane); S.done(cur); }
#undef PG8_SA
#undef PG8_SB
#undef PG8_STAGE
#undef PG8_LDA
#undef PG8_LDB
#undef PG8_MMA
#undef PG8_WAIT_V
#undef PG8_WAIT_L
#undef PG8_BAR
#undef PG8_SCHED
}
}
#define GAS __attribute__((address_space(1)))
typedef unsigned short bf16;
typedef short bf16x8 __attribute__((ext_vector_type(8)));
typedef short s16x4 __attribute__((ext_vector_type(4)));
typedef float f32x2 __attribute__((ext_vector_type(2)));
typedef float f32x4 __attribute__((ext_vector_type(4)));
typedef float f32x16 __attribute__((ext_vector_type(16)));
typedef unsigned u32x2 __attribute__((ext_vector_type(2)));
typedef unsigned u32x4 __attribute__((ext_vector_type(4)));
using pg8::cvt_pk_bf16; using pg8::fast_sigmoid; using pg8::gelu_tanh;
#define LDS_WAIT() asm volatile("s_waitcnt lgkmcnt(0)" ::: "memory")
#define VM_WAIT() asm volatile("s_waitcnt vmcnt(0)" ::: "memory")

constexpr int DM = 2048, NB = 4, SEQ = 2048, MP = NB * SEQ  , SB = 8, ST = 4, MS = SB * ST  , MR = MP + MS  , MPAD = 8448;
constexpr int PAST = 16384, NPOOL = 1280, INW = 3608, INWP = 3840, DFF = 5632, NG = 64  ;
constexpr float EPS = 1e-6f, SM_SCALE = 0.08838834764831845f;
constexpr int NIN = 35;
enum { I_XP = 0, I_XS, I_CCMP, I_CSLC, I_SWIN, I_SSSM, I_PT, I_NMIX, I_WIN, I_ARE, I_AIM, I_LDT, I_BRE, I_BIM, I_CRE, I_CIM, I_D, I_WGLU, I_QN, I_KNC, I_KNS, I_KNW,
       I_W1K, I_B1K, I_W2K, I_W1V, I_B1V, I_W2V, I_NSSM, I_NATT, I_WOUT, I_NFFN, I_WG, I_WU, I_WD };
constexpr size_t O_YP = 0, O_YS = O_YP + (size_t)MP * DM, O_CMPP = O_YS + (size_t)MS * DM, O_SLCP = O_CMPP + 2ull * MP * 512, O_WINP = O_SLCP + 2ull * MP * 512,
                 O_SSMP = O_WINP + 2ull * NB * 512 * 512, O_CMPS = O_SSMP + 2ull * NB * 64 * 128, O_SLCS = O_CMPS + 2ull * MS * 512, O_WINS = O_SLCS + 2ull * MS * 512,
                 O_SSMS = O_WINS + 2ull * SB * 512 * 512, O_END = O_SSMS + 2ull * SB * 64 * 128;
constexpr size_t WS_CTL = 0, CTL_BYTES = 1u << 20;
constexpr size_t WS_WIN = CTL_BYTES;
constexpr size_t WS_WGLU = WS_WIN + 2ull * INWP * DM * 2;
constexpr size_t WS_WOUT = WS_WGLU + 2ull * 1024 * 1024 * 2;
constexpr size_t WS_WGU = WS_WOUT + 2ull * DM * DM * 2;
constexpr size_t WS_WDN = WS_WGU + 2ull * 2 * DFF * DM * 2;
constexpr size_t WS_W1C = WS_WDN + 2ull * DM * DFF * 2;
constexpr size_t WS_W2T = WS_W1C + 2ull * 2 * 256 * 2048 * 2;
constexpr size_t WS_TG = WS_W2T + 2ull * 2 * 128 * 128 * 2;
constexpr size_t WS_EG = WS_TG + 2ull * 64 * 256 * 256 * 2;
constexpr size_t WS_FG = WS_EG + 2ull * 64 * 128 * 256 * 2;
constexpr size_t WS_LAM1 = WS_FG + 2ull * 64 * 256 * 128 * 2;
constexpr size_t WS_LAM16 = WS_LAM1 + 2ull * 64 * 64 * 2 * 4;
constexpr size_t WS_BBAR = WS_LAM16 + 2ull * 64 * 64 * 2 * 4;
constexpr size_t WS_CA = WS_BBAR + 2ull * 64 * 64 * 16 * 2 * 4;
constexpr size_t WS_TBS = WS_CA + 2ull * 2 * 8 * 2 * 16384 * 128 * 2;
constexpr size_t WS_TBP = WS_TBS + 4ull * 16384 * 256 * 4;
constexpr size_t WS_CKVS = WS_TBP + 2048ull * 256 * 4;
constexpr size_t WS_CKVP = WS_CKVS + 2ull * 2 * 8 * 2 * 1024 * 128 * 2;
constexpr size_t WS_XN = WS_CKVP + 2ull * 4 * 2 * 128 * 128 * 2;
constexpr size_t WS_U = WS_XN + (size_t)MPAD * DM * 2;
constexpr size_t WS_US = WS_U + 4ull * 64 * 2048 * 16 * 2;
constexpr size_t WS_Q = WS_US + 32ull * 1024 * 2;
constexpr size_t WS_KVRAW = WS_Q + (size_t)MPAD * 1024 * 2;
constexpr size_t WS_KVC = WS_KVRAW + (size_t)MPAD * 1536 * 4;
constexpr size_t WS_KVS = WS_KVC + 2ull * 4 * 2 * 2048 * 128 * 2;
constexpr size_t WS_KVW = WS_KVS + 2ull * 4 * 2 * 2048 * 128 * 2;
constexpr size_t WS_GT = WS_KVW + 2ull * 4 * 2 * 2048 * 128 * 2;
constexpr size_t WS_Z = WS_GT + (size_t)MPAD * 32 * 4;
constexpr size_t WS_SSMY = WS_Z + (size_t)MPAD * 1024 * 2;
constexpr size_t WS_ATT = WS_SSMY + (size_t)MPAD * 1024 * 2;
constexpr size_t WS_H = WS_ATT + (size_t)MPAD * 1024 * 4;
constexpr size_t WS_YA = WS_H + (size_t)MPAD * DM * 2;
constexpr size_t WS_YB = WS_YA + (size_t)MPAD * DM * 4;
constexpr size_t WS_HN = WS_YB + (size_t)MPAD * DM * 4;
constexpr size_t WS_HMID = WS_HN + (size_t)MPAD * DM * 2;
constexpr size_t WS_PS = WS_HMID + (size_t)MPAD * DFF * 2;
constexpr size_t WS_PSS = WS_PS + (size_t)MPAD * 32 * 4;
constexpr size_t WS_END = WS_PSS + 32ull * 128 * 4;
static_assert(WS_END < 1500ull * 1024 * 1024, "ws map");
constexpr int CW_BAR = 4096;
constexpr int LDS_BYTES = 159744, MISC_OFF = LDS_BYTES - 64, LDS_RS = 131072;

#define LAS __attribute__((address_space(3)))
#define XB_TMO      128
#define XB_XCNT(j)  (256  + 64 * (j))
#define XB_XSUB(j)  (1280 + 64 * (j))
#define XB_XGEN(j)  (2304 + 64 * (j))
#define XB_TOP      3328
#define XB_TOPGEN   3392
#define XCD_BAR_WORDS 3456
#define XB_SPIN_CAP (1u << 18)
#define LAS __attribute__((address_space(3)))

__device__ __forceinline__ unsigned xb_ld(unsigned* p)              { return __hip_atomic_load(p, __ATOMIC_RELAXED, __HIP_MEMORY_SCOPE_AGENT); }
__device__ __forceinline__ unsigned xb_add(unsigned* p, unsigned v) { return __hip_atomic_fetch_add(p, v, __ATOMIC_RELAXED, __HIP_MEMORY_SCOPE_AGENT); }
__device__ __forceinline__ unsigned xb_xcc_id() { return (unsigned)__builtin_amdgcn_s_getreg((3 << 11) | 20) & 0xFu; }
#define XB_SPIN(cond, bar) do { unsigned _sp = 0; while (cond) { __builtin_amdgcn_s_sleep(1); \
    if ((++_sp & 255u) == 0u) { if (xb_ld(&(bar)[XB_TMO])) break; if (_sp > XB_SPIN_CAP) { atomicAdd(&(bar)[XB_TMO], 1u); break; } } } } while (0)

struct XcdBarrier {
    unsigned* bar; unsigned x;
    volatile LAS unsigned* st;
};

__device__ __forceinline__ XcdBarrier xcd_barrier_post(unsigned* bar, volatile LAS unsigned* st) {
    XcdBarrier b; b.bar = bar; b.x = xb_xcc_id(); b.st = st;
    if (threadIdx.x == 0) (void)xb_add(&bar[XB_XCNT(b.x)], 1u);
    return b;
}
__device__ __forceinline__ void xcd_barrier_complete(unsigned* bar, unsigned x, unsigned& nloc, unsigned& nx) {
    const unsigned G = gridDim.x * gridDim.y * gridDim.z;
    unsigned sum, cnt, mine, sp = 0u;
    for (;;) {
        sum = 0u; cnt = 0u; mine = 0u;
#pragma unroll
        for (unsigned j = 0; j < 16; ++j) { const unsigned c = xb_ld(&bar[XB_XCNT(j)]); sum += c; cnt += (c > 0u) ? 1u : 0u; mine = (j == x) ? c : mine; }
        if (sum == G) break;
        __builtin_amdgcn_s_sleep(1);
        if ((++sp & 255u) == 0u) { if (xb_ld(&bar[XB_TMO])) break; if (sp > XB_SPIN_CAP) { atomicAdd(&bar[XB_TMO], 1u); break; } }
    }
    nloc = mine > 0u ? mine : 1u; nx = cnt > 0u ? cnt : 1u;
}

__device__ __forceinline__ void xcd_barrier(const XcdBarrier& b) {
    asm volatile("s_waitcnt vmcnt(0)" ::: "memory");
    __syncthreads();
    if (threadIdx.x == 0) {
        unsigned* bar = b.bar;
        __builtin_amdgcn_s_waitcnt(0);
        unsigned nloc = b.st[0], nx = b.st[1];
        if (nloc == 0u) { xcd_barrier_complete(bar, b.x, nloc, nx); b.st[0] = nloc; b.st[1] = nx; }
        const unsigned old = xb_add(&bar[XB_XSUB(b.x)], 1u);
        const unsigned gen = old / nloc;
        if (old + 1u == (gen + 1u) * nloc) {
            __builtin_amdgcn_fence(__ATOMIC_RELEASE, "agent");
            asm volatile("s_waitcnt vmcnt(0)" ::: "memory");
            const unsigned og = xb_add(&bar[XB_TOP], 1u);
            const unsigned tg = og / nx;
            if (og + 1u == (tg + 1u) * nx) xb_add(&bar[XB_TOPGEN], 1u);
            else XB_SPIN(xb_ld(&bar[XB_TOPGEN]) == tg, bar);
            __builtin_amdgcn_fence(__ATOMIC_ACQUIRE, "agent");
            xb_add(&bar[XB_XGEN(b.x)], 1u);
            asm volatile("s_waitcnt vmcnt(0)" ::: "memory");
        } else {
            XB_SPIN(xb_ld(&bar[XB_XGEN(b.x)]) == gen, bar);
            __builtin_amdgcn_fence(__ATOMIC_ACQUIRE, "agent");
            asm volatile("s_waitcnt vmcnt(0)" ::: "memory");
        }
    }
    __syncthreads();
}


struct Args { const float* in[NIN]; float* out; unsigned char* ws; int ph_lo, ph_hi; };
typedef const GAS float* cfp_t; typedef const cfp_t __attribute__((address_space(4)))* InArr;
struct InTab { InArr p; __device__ __forceinline__ const float* operator[](int i) const { return (const float*)p[i]; } };
struct Ctx {
    LAS unsigned char* lds; int tid, lane, wid, G, wg;
    InTab in; float* out; unsigned char* ws;
};
__device__ __forceinline__ float wave_sum(float v) {
#pragma unroll
    for (int o = 1; o < 64; o <<= 1) v += __shfl_xor(v, o);
    return v;
}
__device__ __forceinline__ float wave_max(float v) {
#pragma unroll
    for (int o = 1; o < 64; o <<= 1) v = fmaxf(v, __shfl_xor(v, o));
    return v;
}
__device__ __forceinline__ float bf2f(unsigned short b) { return __uint_as_float(((unsigned)b) << 16); }
__device__ __forceinline__ float bflo(unsigned w) { return __uint_as_float(w << 16); }
__device__ __forceinline__ float bfhi(unsigned w) { return __uint_as_float(w & 0xffff0000u); }
__device__ __forceinline__ unsigned short f2bf(float f) { return (unsigned short)(cvt_pk_bf16(f, 0.f) & 0xffffu); }

__device__ __forceinline__ void transpose_item(const float* W, int ldw, int nvalid, bf16* WT, int ldt, int k0, int n0, int drow0, LAS float* scr, int lane, const float* kg = nullptr) {
    const int nn = lane & 31;
    float wv[32];
#pragma unroll
    for (int i = 0; i < 32; ++i) { const int kk = 2 * i + (lane >> 5); wv[i] = (nn < nvalid) ? W[(size_t)(k0 + kk) * ldw + n0 + nn] : 0.f; }
#pragma unroll
    for (int i = 0; i < 32; ++i) { const int kk = 2 * i + (lane >> 5); scr[kk * 33 + nn] = kg ? wv[i] * kg[k0 + kk] : wv[i]; }
    LDS_WAIT(); asm volatile("" ::: "memory");
    const int c = lane & 7;
#pragma unroll
    for (int j = 0; j < 4; ++j) { const int n = (lane >> 3) + 8 * j; const LAS float* s = scr + (8 * c) * 33 + n;
        u32x4 o; o.x = cvt_pk_bf16(s[0 * 33], s[1 * 33]); o.y = cvt_pk_bf16(s[2 * 33], s[3 * 33]); o.z = cvt_pk_bf16(s[4 * 33], s[5 * 33]); o.w = cvt_pk_bf16(s[6 * 33], s[7 * 33]);
        *(u32x4*)(WT + (size_t)(drow0 + n) * ldt + k0 + 8 * c) = o; }
    LDS_WAIT(); asm volatile("" ::: "memory");
}
constexpr int TI_IN = 32 * 113, TI_GLU = 16 * 32, TI_OUT = 32 * 64, TI_G = 32 * 176, TI_DN = 88 * 64, TI_W1 = 4 * 32 * 4, TI_W2 = 2 * 2 * 4;
constexpr int TI_LAYER = TI_IN + TI_GLU + TI_OUT + 2 * TI_G + TI_DN + TI_W1 + TI_W2;
constexpr int TI_IN_DEF = 2048;
__device__ __forceinline__ void weight_item(const Ctx& C, int item, LAS float* scr) {
    const int l = item / TI_LAYER; int r = item % TI_LAYER; unsigned char* ws = C.ws; const int lane = C.lane;
    if (r < TI_IN) { const int kb = r / 113, nb = r % 113, n0 = 32 * nb; const int nv = (INW - n0) < 32 ? (INW - n0) : 32;
        transpose_item(C.in[I_WIN] + (size_t)l * DM * INW, INW, nv, (bf16*)(ws + WS_WIN) + (size_t)l * INWP * DM, DM, 64 * kb, n0, n0, scr, lane, l == 1 ? C.in[I_NMIX] + DM : nullptr); return; } r -= TI_IN;
    if (r < TI_GLU) { const int kb = r / 32, nb = r % 32;
        transpose_item(C.in[I_WGLU] + (size_t)l * 1024 * 1024, 1024, 32, (bf16*)(ws + WS_WGLU) + (size_t)l * 1024 * 1024, 1024, 64 * kb, 32 * nb, 32 * nb, scr, lane); return; } r -= TI_GLU;
    if (r < TI_OUT) { const int kb = r / 64, nb = r % 64;
        transpose_item(C.in[I_WOUT] + (size_t)l * DM * DM, DM, 32, (bf16*)(ws + WS_WOUT) + (size_t)l * DM * DM, DM, 64 * kb, 32 * nb, 32 * nb, scr, lane); return; } r -= TI_OUT;
    if (r < 2 * TI_G) { const int up = r / TI_G; r %= TI_G; const int kb = r / 176, nb = r % 176, n0 = 32 * nb;
        transpose_item(C.in[up ? I_WU : I_WG] + (size_t)l * DM * DFF, DFF, 32, (bf16*)(ws + WS_WGU) + (size_t)l * 2 * DFF * DM, DM, 64 * kb, n0, 256 * (n0 >> 7) + (n0 & 127) + 128 * up, scr, lane, C.in[I_NFFN] + l * DM); return; } r -= 2 * TI_G;
    if (r < TI_DN) { const int kb = r / 64, nb = r % 64;
        transpose_item(C.in[I_WD] + (size_t)l * DFF * DM, DM, 32, (bf16*)(ws + WS_WDN) + (size_t)l * DM * DFF, DFF, 64 * kb, 32 * nb, 32 * nb, scr, lane); return; } r -= TI_DN;
    if (r < TI_W1) { const int which = r / 128, rr = r % 128, kb = rr / 4, nb = rr % 4;
        transpose_item(C.in[which < 2 ? I_W1K : I_W1V] + (size_t)l * 4096 * 128 + (size_t)(which & 1) * 2048 * 128, 128, 32,
                       (bf16*)(ws + WS_W1C) + (size_t)(l * 2 + (which >> 1)) * 256 * 2048, 2048, 64 * kb, 32 * nb, (which & 1) * 128 + 32 * nb, scr, lane); return; } r -= TI_W1;
    { const int which = r / 8, rr = r % 8, kb = rr / 4, nb = rr % 4;
        transpose_item(C.in[which ? I_W2V : I_W2K] + (size_t)l * 128 * 128, 128, 32, (bf16*)(ws + WS_W2T) + (size_t)(l * 2 + which) * 128 * 128, 128, 64 * kb, 32 * nb, 32 * nb, scr, lane); }
}
__device__ __forceinline__ void norm_row_2048(const float* x, const float* g, bf16* o, int lane) {
    f32x4 v[8], gv[8]; float s = 0.f;
#pragma unroll
    for (int j = 0; j < 8; ++j) { v[j] = *(const f32x4*)(x + 4 * lane + 256 * j); gv[j] = *(const f32x4*)(g + 4 * lane + 256 * j); }
#pragma unroll
    for (int j = 0; j < 8; ++j) s += (v[j][0] * v[j][0] + v[j][1] * v[j][1]) + (v[j][2] * v[j][2] + v[j][3] * v[j][3]);
    const float rstd = 1.0f / sqrtf(wave_sum(s) * (1.0f / 2048.0f) + EPS);
#pragma unroll
    for (int j = 0; j < 8; ++j) { const f32x4 gg = gv[j]; u32x2 w; w.x = cvt_pk_bf16(v[j][0] * rstd * gg[0], v[j][1] * rstd * gg[1]); w.y = cvt_pk_bf16(v[j][2] * rstd * gg[2], v[j][3] * rstd * gg[3]);
        *(u32x2*)(o + 4 * lane + 256 * j) = w; }
}
__device__ __forceinline__ void norm_pass(const Ctx& C, const float* xp, const float* xs, const float* g, bf16* XO) {
    const int gw = C.wg * 8 + C.wid, NGW = C.G * 8;
    for (int r = gw; r < MR; r += NGW) norm_row_2048(r < MP ? xp + (size_t)r * DM : xs + (size_t)(r - MP) * DM, g, XO + (size_t)r * DM, C.lane);
}
__device__ __forceinline__ double exp_d(double x) {
    int m = 0; while (fabs(x) > 0.5) { x *= 0.5; ++m; }
    double t = 1.0, s = 1.0;
#pragma unroll
    for (int i = 1; i <= 18; ++i) { t *= x * (1.0 / (double)i); s += t; }
    for (int i = 0; i < m; ++i) s *= s;
    return s;
}
__device__ __forceinline__ void sincos_d(double x, double& sn, double& cs) {
    const double k = rint(x * 0.63661977236758134308);
    double r = fma(-k, 1.57079632679489655800, x); r = fma(-k, 6.12323399573676603587e-17, r);
    const int q = (int)((long long)k & 3ll);
    const double r2 = r * r;
    double sp = 1.0 / 6227020800.0; sp = sp * r2 - 1.0 / 39916800.0; sp = sp * r2 + 1.0 / 362880.0; sp = sp * r2 - 1.0 / 5040.0; sp = sp * r2 + 1.0 / 120.0; sp = sp * r2 - 1.0 / 6.0; sp = sp * r2 + 1.0; sp *= r;
    double cp = -1.0 / 87178291200.0; cp = cp * r2 + 1.0 / 479001600.0; cp = cp * r2 - 1.0 / 3628800.0; cp = cp * r2 + 1.0 / 40320.0; cp = cp * r2 - 1.0 / 720.0; cp = cp * r2 + 1.0 / 24.0; cp = cp * r2 - 0.5; cp = cp * r2 + 1.0;
    sn = (q == 0) ? sp : (q == 1) ? cp : (q == 2) ? -sp : -cp;
    cs = (q == 0) ? cp : (q == 1) ? -sp : (q == 2) ? -cp : sp;
}
__device__ __forceinline__ void ssm_precompute(const Ctx& C, int l, int g) {
    LAS float* lpr = (LAS float*)C.lds;
    LAS float* lpi = lpr + 17 * 64;
    LAS float* Bbr = lpi + 17 * 64;
    LAS float* Bbi = Bbr + 1024;
    LAS float* Ccr = Bbi + 1024;
    LAS float* Cci = Ccr + 1024;
    LAS float* Kt = Cci + 1024;
    LAS float* CTr = Kt + 4096;
    LAS float* CTi = CTr + 1024;
    const int tid = C.tid; const int lg = l * NG + g;
    for (int idx = tid; idx < 17 * 64; idx += 512) { const int tau = idx >> 6, n = idx & 63;
        const double are = (double)C.in[I_ARE][lg * 64 + n], aim = (double)C.in[I_AIM][lg * 64 + n], dt = exp_d((double)C.in[I_LDT][lg]);
        const double mag = exp_d(are * dt * tau), ang = aim * dt * tau; double sn, cs; sincos_d(ang, sn, cs);
        lpr[tau * 64 + n] = (float)(mag * cs); lpi[tau * 64 + n] = (float)(mag * sn); }
    if (tid < 64) { const int n = tid;
        const double are = (double)C.in[I_ARE][lg * 64 + n], aim = (double)C.in[I_AIM][lg * 64 + n], dt = exp_d((double)C.in[I_LDT][lg]);
        f32x4 brv[4], biv[4];
#pragma unroll
        for (int q = 0; q < 4; ++q) { brv[q] = *(const f32x4*)(C.in[I_BRE] + (size_t)(lg * 64 + n) * 16 + 4 * q); biv[q] = *(const f32x4*)(C.in[I_BIM] + (size_t)(lg * 64 + n) * 16 + 4 * q); }
        const double mag = exp_d(are * dt), ang = aim * dt; double sn, cs; sincos_d(ang, sn, cs); const double l1r = mag * cs, l1i = mag * sn;
        const double nr = l1r - 1.0, ni = l1i, den = are * are + aim * aim; const double cfr = (nr * are + ni * aim) / den, cfi = (ni * are - nr * aim) / den;
        float* bb = (float*)(C.ws + WS_BBAR) + (size_t)(lg * 64 + n) * 32;
#pragma unroll
        for (int p = 0; p < 16; ++p) { const double br = (double)brv[p >> 2][p & 3], bi = (double)biv[p >> 2][p & 3];
            const float xr = (float)(cfr * br - cfi * bi), xi = (float)(cfr * bi + cfi * br); Bbr[n * 16 + p] = xr; Bbi[n * 16 + p] = xi; bb[2 * p] = xr; bb[2 * p + 1] = xi; }
        float* o1 = (float*)(C.ws + WS_LAM1) + (size_t)(lg * 64 + n) * 2; o1[0] = (float)l1r; o1[1] = (float)l1i;
        { const double m16 = exp_d(are * dt * 16.0), a16 = aim * dt * 16.0; double s16, c16; sincos_d(a16, s16, c16); float* o16 = (float*)(C.ws + WS_LAM16) + (size_t)(lg * 64 + n) * 2; o16[0] = (float)(m16 * c16); o16[1] = (float)(m16 * s16); }
    }
    for (int i = tid; i < 1024; i += 512) { const float cr = C.in[I_CRE][(size_t)lg * 1024 + i], ci = C.in[I_CIM][(size_t)lg * 1024 + i]; Ccr[i] = cr; Cci[i] = ci; CTr[(i & 63) * 16 + (i >> 6)] = cr; CTi[(i & 63) * 16 + (i >> 6)] = ci; }
    __syncthreads();
    {
        const int tau = tid >> 5, p = (tid >> 1) & 15, h = tid & 1; float s8[8];
#pragma unroll
        for (int j = 0; j < 8; ++j) s8[j] = 0.f;
        for (int n = 0; n < 64; ++n) { const float cr = CTr[n * 16 + p], ci = CTi[n * 16 + p], lr = lpr[tau * 64 + n], li = lpi[tau * 64 + n]; const float wr = cr * lr - ci * li, wi = cr * li + ci * lr;
            const f32x4 b0 = *(const LAS f32x4*)(Bbr + n * 16 + 8 * h), b1 = *(const LAS f32x4*)(Bbr + n * 16 + 8 * h + 4), c0 = *(const LAS f32x4*)(Bbi + n * 16 + 8 * h), c1 = *(const LAS f32x4*)(Bbi + n * 16 + 8 * h + 4);
#pragma unroll
            for (int j = 0; j < 4; ++j) { s8[j] += wr * b0[j] - wi * c0[j]; s8[4 + j] += wr * b1[j] - wi * c1[j]; } }
        const float dsk = C.in[I_D][lg * 16 + p];
#pragma unroll
        for (int j = 0; j < 8; ++j) { if (tau == 0 && p == 8 * h + j) s8[j] += dsk; }
        *(LAS f32x4*)(Kt + (tau << 8) + p * 16 + 8 * h) = (f32x4){s8[0], s8[1], s8[2], s8[3]}; *(LAS f32x4*)(Kt + (tau << 8) + p * 16 + 8 * h + 4) = (f32x4){s8[4], s8[5], s8[6], s8[7]};
    }
    __syncthreads();
    bf16* TG = (bf16*)(C.ws + WS_TG) + (size_t)lg * 65536; bf16* EG = (bf16*)(C.ws + WS_EG) + (size_t)lg * 32768; bf16* FG = (bf16*)(C.ws + WS_FG) + (size_t)lg * 32768;
    for (int i8 = tid; i8 < 8192; i8 += 512) { const int row = i8 >> 5, c8 = i8 & 31, tq = row >> 4, p = row & 15, s = c8 >> 1, pp0 = (c8 & 1) * 8; u32x4 w = (u32x4){0u, 0u, 0u, 0u};
        if (tq >= s) { const LAS float* kp = Kt + ((tq - s) << 8) + p * 16 + pp0; const f32x4 k0 = *(const LAS f32x4*)kp, k1 = *(const LAS f32x4*)(kp + 4);
            w.x = cvt_pk_bf16(k0[0], k0[1]); w.y = cvt_pk_bf16(k0[2], k0[3]); w.z = cvt_pk_bf16(k1[0], k1[1]); w.w = cvt_pk_bf16(k1[2], k1[3]); }
        *(u32x4*)(TG + (size_t)i8 * 8) = w; }
    for (int i8 = tid; i8 < 4096; i8 += 512) { const int n2 = i8 >> 5, c8 = i8 & 31, s = c8 >> 1, pp0 = (c8 & 1) * 8, n = n2 & 63; const int tau = 15 - s;
        const float lr = lpr[tau * 64 + n], li = lpi[tau * 64 + n]; const LAS float* bp = Bbr + n * 16 + pp0; const LAS float* cp = Bbi + n * 16 + pp0;
        const f32x4 b0 = *(const LAS f32x4*)bp, b1 = *(const LAS f32x4*)(bp + 4), c0 = *(const LAS f32x4*)cp, c1 = *(const LAS f32x4*)(cp + 4); float e[8];
#pragma unroll
        for (int j = 0; j < 4; ++j) { e[j] = n2 < 64 ? (lr * b0[j] - li * c0[j]) : (lr * c0[j] + li * b0[j]); e[4 + j] = n2 < 64 ? (lr * b1[j] - li * c1[j]) : (lr * c1[j] + li * b1[j]); }
        u32x4 w; w.x = cvt_pk_bf16(e[0], e[1]); w.y = cvt_pk_bf16(e[2], e[3]); w.z = cvt_pk_bf16(e[4], e[5]); w.w = cvt_pk_bf16(e[6], e[7]);
        *(u32x4*)(EG + (size_t)i8 * 8) = w; }
    for (int i8 = tid; i8 < 4096; i8 += 512) { const int row = i8 >> 4, q0 = (i8 & 15) * 8, n0 = q0 & 63, tq = row >> 4, p = row & 15; const int tau = tq + 1;
        const LAS float* a0 = Ccr + p * 64 + n0; const LAS float* a1 = Cci + p * 64 + n0; const LAS float* a2 = lpr + tau * 64 + n0; const LAS float* a3 = lpi + tau * 64 + n0;
        const f32x4 cr0 = *(const LAS f32x4*)a0, cr1 = *(const LAS f32x4*)(a0 + 4), ci0 = *(const LAS f32x4*)a1, ci1 = *(const LAS f32x4*)(a1 + 4), lr0 = *(const LAS f32x4*)a2, lr1 = *(const LAS f32x4*)(a2 + 4), li0 = *(const LAS f32x4*)a3, li1 = *(const LAS f32x4*)(a3 + 4); float e[8];
#pragma unroll
        for (int j = 0; j < 4; ++j) { e[j] = q0 < 64 ? (cr0[j] * lr0[j] - ci0[j] * li0[j]) : -(cr0[j] * li0[j] + ci0[j] * lr0[j]); e[4 + j] = q0 < 64 ? (cr1[j] * lr1[j] - ci1[j] * li1[j]) : -(cr1[j] * li1[j] + ci1[j] * lr1[j]); }
        u32x4 w; w.x = cvt_pk_bf16(e[0], e[1]); w.y = cvt_pk_bf16(e[2], e[3]); w.z = cvt_pk_bf16(e[4], e[5]); w.w = cvt_pk_bf16(e[6], e[7]);
        *(u32x4*)(FG + (size_t)i8 * 8) = w; }
    __syncthreads();
}
__device__ __forceinline__ void p0_prologue(const Ctx& C) {
    const int gw = C.wg * 8 + C.wid, NGW = C.G * 8, lane = C.lane;
    for (int u = C.wg; u < 2 * NG; u += C.G) ssm_precompute(C, u / NG, u % NG);
    __syncthreads();
    LAS float* scr = (LAS float*)(C.lds + C.wid * 16384);
    if (C.G == 256) {
        for (int idx = gw; idx < 2 * TI_LAYER - (TI_GLU + TI_OUT + TI_DN + TI_IN_DEF); idx += NGW) { int it = idx;
            if (idx >= TI_LAYER) { const int j = idx - TI_LAYER + TI_IN_DEF; it = TI_LAYER + (j < TI_IN ? j : (j < TI_IN + 2 * TI_G ? j + TI_GLU + TI_OUT : j + TI_GLU + TI_OUT + TI_DN)); }
            weight_item(C, it, scr); }
    } else
    for (int it = gw; it < 2 * TI_LAYER; it += NGW) weight_item(C, it, scr);
    norm_pass(C, C.in[I_XP], C.in[I_XS], C.in[I_NMIX], (bf16*)(C.ws + WS_XN));
    { const size_t gt = (size_t)C.wg * 512 + C.tid, NT = (size_t)C.G * 512; const size_t per = 508ull * 512 / 4;
        const float* swin = C.in[I_SWIN];
        for (size_t i0 = gt; i0 < 2ull * SB * per; i0 += 8 * NT) { f32x4 v[8];
#pragma unroll
            for (int k = 0; k < 8; ++k) { const size_t i = i0 + (size_t)k * NT; if (i < 2ull * SB * per) { const size_t ls = i / per, j = i % per; v[k] = *(const f32x4*)(swin + ls * 512 * 512 + 4 * 512 + 4 * j); } }
#pragma unroll
            for (int k = 0; k < 8; ++k) { const size_t i = i0 + (size_t)k * NT; if (i < 2ull * SB * per) { const size_t ls = i / per, j = i % per; *(f32x4*)(C.out + O_WINS + ls * 512 * 512 + 4 * j) = v[k]; } } } }
}

__device__ __forceinline__ void cmp1_sample_unit(const Ctx& C, int u, int variant = 0) {
    constexpr int BP = 136;
    const int blk = u & 7, kvh = (u >> 3) & 1, sb = (u >> 4) & 7, kv = (u >> 7) & 1, l = u >> 8;
    int tid = C.tid; asm volatile("" : "+v"(tid)); const int lane = tid & 63, wid = C.wid, fr = lane & 15, fq = lane >> 4;
    LAS bf16* Bl = (LAS bf16*)C.lds;
    const bf16* W = (const bf16*)(C.ws + WS_W1C) + (size_t)(l * 2 + kv) * 256 * 2048;
    const int* pt = (const int*)C.in[I_PT];
    const int irow = blk * 128 + 8 * fr + wid;
    const float* rp = C.in[I_CCMP] + ((((size_t)l * NPOOL + pt[sb * 128 + (irow >> 3)]) * 128 + ((16 * irow) & 127)) * 2 + kvh) * 256 + kv * 128 + 8 * fq;
    f32x4 acc[16];
#pragma unroll
    for (int nb = 0; nb < 16; ++nb) acc[nb] = (f32x4){0.f, 0.f, 0.f, 0.f};
    u32x4 breg[8];
#pragma unroll
    for (int j = 0; j < 8; ++j) { const int p = tid + 512 * j; breg[j] = *(const u32x4*)(W + (size_t)(p >> 4) * 2048 + (p & 15) * 8); }
#pragma unroll
    for (int j = 0; j < 8; ++j) { const int p = tid + 512 * j; *(LAS u32x4*)(Bl + (p >> 4) * BP + (p & 15) * 8) = breg[j]; }
    __syncthreads();
    f32x4 arA[4][2], arB[4][2]; bf16x8 acur[4];
#define CMP1_LOADA(S_, r_) do { if (variant != 7) { _Pragma("unroll") for (int ks = 0; ks < 4; ++ks) { const float* p = rp + (size_t)(r_) * 512 + 32 * ks; S_[ks][0] = *(const f32x4*)p; S_[ks][1] = *(const f32x4*)(p + 4); } } } while (0)
#define CMP1_CVTA(S_) do { _Pragma("unroll") for (int ks = 0; ks < 4; ++ks) { const f32x4 v0 = S_[ks][0], v1 = S_[ks][1]; u32x4 w; \
        w.x = cvt_pk_bf16(v0[0], v0[1]); w.y = cvt_pk_bf16(v0[2], v0[3]); w.z = cvt_pk_bf16(v1[0], v1[1]); w.w = cvt_pk_bf16(v1[2], v1[3]); acur[ks] = __builtin_bit_cast(bf16x8, w); } } while (0)
#define CMP1_STEP(r_, SNEXT_, rload_) do { const int buf = (r_) & 1; \
        if ((r_) + 1 < 16 && variant != 8) { _Pragma("unroll") for (int j = 0; j < 8; ++j) { const int p = tid + 512 * j; breg[j] = *(const u32x4*)(W + (size_t)(p >> 4) * 2048 + ((r_) + 1) * 128 + (p & 15) * 8); } } \
        if (variant != 8) { _Pragma("unroll") for (int ks = 0; ks < 4; ++ks) { _Pragma("unroll") for (int nb = 0; nb < 16; ++nb) { \
            const bf16x8 x = *(const LAS bf16x8*)(Bl + (size_t)buf * 256 * BP + (16 * nb + fr) * BP + 32 * ks + 8 * fq); acc[nb] = __builtin_amdgcn_mfma_f32_16x16x32_bf16(x, acur[ks], acc[nb], 0, 0, 0); \
            if ((nb & 7) == 7) asm volatile("" ::: "memory"); } } } \
        if ((r_) + 1 < 16) { _Pragma("unroll") for (int j = 0; j < 8; ++j) { const int p = tid + 512 * j; *(LAS u32x4*)(Bl + (size_t)(buf ^ 1) * 256 * BP + (p >> 4) * BP + (p & 15) * 8) = breg[j]; } \
            CMP1_CVTA(SNEXT_); if ((rload_) < 16) CMP1_LOADA(SNEXT_, (rload_)); } \
        __syncthreads(); } while (0)
    if (variant == 7) { _Pragma("unroll") for (int ks = 0; ks < 4; ++ks) { arA[ks][0] = (f32x4){0.f, 0.f, 0.f, 0.f}; arA[ks][1] = arA[ks][0]; arB[ks][0] = arA[ks][0]; arB[ks][1] = arA[ks][0]; } }
    CMP1_LOADA(arA, 0); CMP1_CVTA(arA); CMP1_LOADA(arA, 1); CMP1_LOADA(arB, 2);
#pragma unroll 1
    for (int r = 0; r < 16; r += 2) {
        CMP1_STEP(r, arA, r + 3);
        CMP1_STEP(r + 1, arB, r + 4);
    }
#undef CMP1_LOADA
#undef CMP1_CVTA
#undef CMP1_STEP
    float* TB = (float*)(C.ws + WS_TBS) + ((size_t)((((l * 2 + kv) * 8 + sb) * 2 + kvh) * 1024) + irow) * 256 + 4 * fq;
#pragma unroll
    for (int nb = 0; nb < 16; ++nb) *(f32x4*)(TB + 16 * nb) = acc[nb];
}
__device__ __forceinline__ void cmp_stage2_unit(const Ctx& C, const float* TB, size_t tb0, int i0, int imax, const float* b1, const bf16* W2t, const float* gain  , bf16* out0) {
    LAS bf16* Hs = (LAS bf16*)C.lds;
    LAS bf16* Ws = Hs + 128 * 136;
    int tid = C.tid; asm volatile("" : "+v"(tid)); const int lane = tid & 63, wid = C.wid, fr = lane & 15, fq = lane >> 4;
    {   const int c4 = (tid & 31) * 4; const f32x4 bb = *(const f32x4*)(b1 + c4);
        f32x4 tp[8], bt[8];
#pragma unroll
        for (int k = 0; k < 8; ++k) { const int i = i0 + (tid >> 5) + 16 * k; const int i1 = (i + 1 < imax) ? i + 1 : imax;
            tp[k] = *(const f32x4*)(TB + (tb0 + (i < imax ? i : imax)) * 256 + c4); bt[k] = *(const f32x4*)(TB + (tb0 + i1) * 256 + 128 + c4); }
#pragma unroll
        for (int k = 0; k < 8; ++k) { const int r = (tid >> 5) + 16 * k; const f32x4 a = tp[k], b = bt[k];
            u32x2 w; w.x = cvt_pk_bf16(gelu_tanh(a[0] + b[0] + bb[0]), gelu_tanh(a[1] + b[1] + bb[1])); w.y = cvt_pk_bf16(gelu_tanh(a[2] + b[2] + bb[2]), gelu_tanh(a[3] + b[3] + bb[3]));
            *(LAS u32x2*)(Hs + r * 136 + c4) = w; } }
    {   u32x4 wv[4];
#pragma unroll
        for (int k = 0; k < 4; ++k) { const int idx = tid + 512 * k; wv[k] = *(const u32x4*)(W2t + (idx >> 4) * 128 + (idx & 15) * 8); }
#pragma unroll
        for (int k = 0; k < 4; ++k) { const int idx = tid + 512 * k; *(LAS u32x4*)(Ws + (idx >> 4) * 136 + (idx & 15) * 8) = wv[k]; } }
    __syncthreads();
    f32x4 acc[8];
#pragma unroll
    for (int n = 0; n < 8; ++n) acc[n] = (f32x4){0.f, 0.f, 0.f, 0.f};
#pragma unroll
    for (int ks = 0; ks < 4; ++ks) { const bf16x8 y = *(const LAS bf16x8*)(Hs + (16 * wid + fr) * 136 + 32 * ks + 8 * fq);
#pragma unroll
        for (int n = 0; n < 8; ++n) { const bf16x8 x = *(const LAS bf16x8*)(Ws + (16 * n + fr) * 136 + 32 * ks + 8 * fq); acc[n] = __builtin_amdgcn_mfma_f32_16x16x32_bf16(x, y, acc[n], 0, 0, 0); } }
    float rstd = 1.f;
    if (gain) { float ss = 0.f;
#pragma unroll
        for (int n = 0; n < 8; ++n) ss += (acc[n][0] * acc[n][0] + acc[n][1] * acc[n][1]) + (acc[n][2] * acc[n][2] + acc[n][3] * acc[n][3]);
        ss += __shfl_xor(ss, 16); ss += __shfl_xor(ss, 32); rstd = 1.0f / sqrtf(ss * (1.0f / 128.0f) + EPS); }
    bf16* orow = out0 + (size_t)(16 * wid + fr) * 128;
    f32x4 ggv[8];
#pragma unroll
    for (int n = 0; n < 8; ++n) ggv[n] = gain ? *(const f32x4*)(gain + 16 * n + 4 * fq) : (f32x4){1.f, 1.f, 1.f, 1.f};
#pragma unroll
    for (int n = 0; n < 8; ++n) { f32x4 v = acc[n] * rstd; if (gain) { v = v * ggv[n]; }
        u32x2 w; w.x = cvt_pk_bf16(v[0], v[1]); w.y = cvt_pk_bf16(v[2], v[3]); *(u32x2*)(orow + 16 * n + 4 * fq) = w; }
    __syncthreads();
}

__device__ __forceinline__ void kvfix_row(const Ctx& C, int l, int row) {
    const int lane = C.lane; const float* src = (const float*)(C.ws + WS_KVRAW) + (size_t)row * 1536 + 2 * lane;
    const float* gs = C.in[I_KNS] + l * 128 + 2 * lane; const float* gwn = C.in[I_KNW] + l * 128 + 2 * lane;
    bf16* KVS = (bf16*)(C.ws + WS_KVS); bf16* KVW = (bf16*)(C.ws + WS_KVW);
    const bool prompt = row < MP; const int b = row >> 11, t = row & 2047, sb = (row - MP) >> 2, st = (row - MP) & 3;
    f32x2 vin[6][2];
#pragma unroll
    for (int part = 0; part < 6; ++part)
#pragma unroll
        for (int kvh = 0; kvh < 2; ++kvh) vin[part][kvh] = *(const f32x2*)(src + part * 256 + kvh * 128);
    const f32x2 ggs = *(const f32x2*)gs, ggw = *(const f32x2*)gwn;
#pragma unroll
    for (int part = 0; part < 6; ++part)
#pragma unroll
        for (int kvh = 0; kvh < 2; ++kvh) {
            f32x2 v = vin[part][kvh]; const int kv = part & 1, br = part >> 1;
            if (part == 2 || part == 4) { const float ss = wave_sum(v[0] * v[0] + v[1] * v[1]); const float rstd = 1.0f / sqrtf(ss * (1.0f / 128.0f) + EPS); const f32x2 gg = (br == 1) ? ggs : ggw; v = v * rstd * gg; }
            const size_t o512 = (size_t)kvh * 256 + kv * 128 + 2 * lane;
            if (prompt) {
                if (br != 0) { bf16* kb = (br == 1 ? KVS : KVW) + ((size_t)((kv * 4 + b) * 2 + kvh) * 2048 + t) * 128 + 2 * lane; *(unsigned*)kb = cvt_pk_bf16(v[0], v[1]); }
                if (br == 0) *(f32x2*)(C.out + O_CMPP + ((size_t)(l * NB + b) * 2048 + t) * 512 + o512) = v;
                else if (br == 1) *(f32x2*)(C.out + O_SLCP + ((size_t)(l * NB + b) * 2048 + t) * 512 + o512) = v;
                else if (t >= 1536) *(f32x2*)(C.out + O_WINP + ((size_t)(l * NB + b) * 512 + (t - 1536)) * 512 + o512) = v;
            } else {
                if (br == 0) *(f32x2*)(C.out + O_CMPS + ((size_t)(l * SB + sb) * 4 + st) * 512 + o512) = v;
                else if (br == 1) *(f32x2*)(C.out + O_SLCS + ((size_t)(l * SB + sb) * 4 + st) * 512 + o512) = v;
                else *(f32x2*)(C.out + O_WINS + ((size_t)(l * SB + sb) * 512 + 508 + st) * 512 + o512) = v;
            }
        }
}
template <int NR>
__device__ __forceinline__ void mixnorm_rows(const Ctx& C, int l, int row0, int rstride, int nvalid) {
    const int lane = C.lane; const float* g1 = C.in[I_NSSM] + l * 1024; const float* g2 = C.in[I_NATT] + l * 1024;
    f32x4 a[NR][4]; u32x2 sw[NR][4];
#pragma unroll
    for (int i = 0; i < NR; ++i) { const int row = row0 + (i < nvalid ? i : 0) * rstride; const bf16* sy = (const bf16*)(C.ws + WS_SSMY) + (size_t)row * 1024; const float* at = (const float*)(C.ws + WS_ATT) + (size_t)row * 1024;
#pragma unroll
        for (int j = 0; j < 4; ++j) { sw[i][j] = *(const u32x2*)(sy + 4 * lane + 256 * j); a[i][j] = *(const f32x4*)(at + 4 * lane + 256 * j); } }
    f32x4 ga[4], gb[4];
#pragma unroll
    for (int j = 0; j < 4; ++j) { ga[j] = *(const f32x4*)(g1 + 4 * lane + 256 * j); gb[j] = *(const f32x4*)(g2 + 4 * lane + 256 * j); }
#pragma unroll
    for (int i = 0; i < NR; ++i) { if (i < nvalid) { const int row = row0 + i * rstride; bf16* H = (bf16*)(C.ws + WS_H) + (size_t)row * DM; f32x4 s[4]; float s1 = 0.f, s2 = 0.f;
#pragma unroll
        for (int j = 0; j < 4; ++j) { const u32x2 w = sw[i][j]; s[j] = (f32x4){bflo(w.x), bfhi(w.x), bflo(w.y), bfhi(w.y)};
            s1 += (s[j][0] * s[j][0] + s[j][1] * s[j][1]) + (s[j][2] * s[j][2] + s[j][3] * s[j][3]); s2 += (a[i][j][0] * a[i][j][0] + a[i][j][1] * a[i][j][1]) + (a[i][j][2] * a[i][j][2] + a[i][j][3] * a[i][j][3]); }
        const float r1 = 1.0f / sqrtf(wave_sum(s1) * (1.0f / 1024.0f) + EPS), r2 = 1.0f / sqrtf(wave_sum(s2) * (1.0f / 1024.0f) + EPS);
#pragma unroll
        for (int j = 0; j < 4; ++j) { u32x2 w; w.x = cvt_pk_bf16(s[j][0] * r1 * ga[j][0], s[j][1] * r1 * ga[j][1]); w.y = cvt_pk_bf16(s[j][2] * r1 * ga[j][2], s[j][3] * r1 * ga[j][3]); *(u32x2*)(H + 4 * lane + 256 * j) = w;
            w.x = cvt_pk_bf16(a[i][j][0] * r2 * gb[j][0], a[i][j][1] * r2 * gb[j][1]); w.y = cvt_pk_bf16(a[i][j][2] * r2 * gb[j][2], a[i][j][3] * r2 * gb[j][3]); *(u32x2*)(H + 1024 + 4 * lane + 256 * j) = w; } } }
}
template <bool BF32, bool OF32>
__device__ __forceinline__ void sample_gemm_res(const Ctx& C, const bf16* A, const bf16* Bt, int K, const void* base, void* out, int first, int stride, float* PSS) {
    LAS f32x4* red = (LAS f32x4*)C.lds;
    const int lane = C.lane, wid = C.wid, fr = lane & 15, fq = lane >> 4, kw = K / 8;
    for (int cb = first; cb < DM / 16; cb += stride) {
        f32x4 acc0 = (f32x4){0.f, 0.f, 0.f, 0.f}, acc1 = acc0;
        const bf16* bp = Bt + (size_t)(16 * cb + fr) * K + wid * kw + 8 * fq; const bf16* ap0 = A + (size_t)fr * K + wid * kw + 8 * fq; const bf16* ap1 = ap0 + (size_t)16 * K;
        int k = 0;
        for (; k + 128 <= kw; k += 128) { bf16x8 x[4], y0[4], y1[4];
#pragma unroll
            for (int j = 0; j < 4; ++j) { x[j] = *(const bf16x8*)(bp + k + 32 * j); y0[j] = *(const bf16x8*)(ap0 + k + 32 * j); y1[j] = *(const bf16x8*)(ap1 + k + 32 * j); }
#pragma unroll
            for (int j = 0; j < 4; ++j) { acc0 = __builtin_amdgcn_mfma_f32_16x16x32_bf16(x[j], y0[j], acc0, 0, 0, 0); acc1 = __builtin_amdgcn_mfma_f32_16x16x32_bf16(x[j], y1[j], acc1, 0, 0, 0); } }
        for (; k < kw; k += 32) { const bf16x8 x = *(const bf16x8*)(bp + k), y0 = *(const bf16x8*)(ap0 + k), y1 = *(const bf16x8*)(ap1 + k);
            acc0 = __builtin_amdgcn_mfma_f32_16x16x32_bf16(x, y0, acc0, 0, 0, 0); acc1 = __builtin_amdgcn_mfma_f32_16x16x32_bf16(x, y1, acc1, 0, 0, 0); }
        red[(wid * 2 + 0) * 64 + lane] = acc0; red[(wid * 2 + 1) * 64 + lane] = acc1;
        __syncthreads();
        if (C.tid < 128) { const int mb = C.tid >> 6; f32x4 s = red[mb * 64 + lane];
#pragma unroll
            for (int w = 1; w < 8; ++w) s = s + red[(w * 2 + mb) * 64 + lane];
            const size_t off = (size_t)(16 * mb + fr) * DM + 16 * cb + 4 * fq; f32x4 b;
            if (BF32) b = *(const f32x4*)((const float*)base + off); else { const u32x2 w = *(const u32x2*)((const bf16*)base + off); b = (f32x4){bflo(w.x), bfhi(w.x), bflo(w.y), bfhi(w.y)}; }
            const f32x4 v = b + s;
            if (OF32) *(f32x4*)((float*)out + off) = v; else { u32x2 w; w.x = cvt_pk_bf16(v[0], v[1]); w.y = cvt_pk_bf16(v[2], v[3]); *(u32x2*)((bf16*)out + off) = w; }
            if (PSS) { float ss = (v[0] * v[0] + v[1] * v[1]) + (v[2] * v[2] + v[3] * v[3]); ss += __shfl_xor(ss, 16); ss += __shfl_xor(ss, 32); if (fq == 0) PSS[(16 * mb + fr) * 128 + cb] = ss; } }
        __syncthreads();
    }
}

__device__ __forceinline__ void ssm_unit(const Ctx& C, int l, int b, int g) {
    constexpr int UP = 264, SP = 132;
    LAS bf16* Ul = (LAS bf16*)C.lds;
    LAS float* Sl = (LAS float*)(C.lds + 128 * UP * 2);
    int tid = C.tid; asm volatile("" : "+v"(tid)); const int lane = tid & 63, wid = C.wid, fr = lane & 15, fq = lane >> 4, lg = l * NG + g;
    const bf16* Ug = (const bf16*)(C.ws + WS_U) + (size_t)(b * NG + g) * 2048 * 16;
    for (int idx = tid; idx < 4096; idx += 512) { const int c = idx >> 5, o = (idx & 31) * 8; *(LAS u32x4*)(Ul + c * UP + o) = *(const u32x4*)(Ug + c * 256 + o); }
    __syncthreads();
    const bf16* EG = (const bf16*)(C.ws + WS_EG) + (size_t)lg * 32768; const bf16* TG = (const bf16*)(C.ws + WS_TG) + (size_t)lg * 65536; const bf16* FG = (const bf16*)(C.ws + WS_FG) + (size_t)lg * 32768;
    bf16x8 tg0[8], tg1[8];
#pragma unroll
    for (int ks = 0; ks < 8; ++ks) { if (ks <= wid) { tg0[ks] = *(const bf16x8*)(TG + (size_t)(32 * wid + fr) * 256 + 32 * ks + 8 * fq); tg1[ks] = *(const bf16x8*)(TG + (size_t)(32 * wid + 16 + fr) * 256 + 32 * ks + 8 * fq); }
                                     else { tg0[ks] = (bf16x8){0, 0, 0, 0, 0, 0, 0, 0}; tg1[ks] = tg0[ks]; } }
    {
        f32x4 acc[8];
#pragma unroll
        for (int nb = 0; nb < 8; ++nb) acc[nb] = (f32x4){0.f, 0.f, 0.f, 0.f};
#pragma unroll
        for (int ks = 0; ks < 8; ++ks) { const bf16x8 x = *(const bf16x8*)(EG + (size_t)(16 * wid + fr) * 256 + 32 * ks + 8 * fq);
#pragma unroll
            for (int nb = 0; nb < 8; ++nb) { const bf16x8 y = *(const LAS bf16x8*)(Ul + (16 * nb + fr) * UP + 32 * ks + 8 * fq); acc[nb] = __builtin_amdgcn_mfma_f32_16x16x32_bf16(x, y, acc[nb], 0, 0, 0); } }
#pragma unroll
        for (int nb = 0; nb < 8; ++nb) *(LAS f32x4*)(Sl + (16 * nb + fr) * SP + 16 * wid + 4 * fq) = acc[nb];
    }
    __syncthreads();
#ifdef DBG_DUMP_S
    { float* dbg = (float*)(C.ws + WS_ATT) + (size_t)((l * 0 + b) * NG + g) * 16384;
      for (int i = tid; i < 16384; i += 512) dbg[i] = Sl[(i >> 7) * SP + (i & 127)];
      __syncthreads(); }
#endif
    if (wid == 0) {
        const float* lm = (const float*)(C.ws + WS_LAM16) + (size_t)(lg * 64 + lane) * 2; const float lr = lm[0], li = lm[1]; float hr = 0.f, hi = 0.f;
#pragma unroll 1
        for (int c0 = 0; c0 < 128; c0 += 8) {
            float sr[8], si[8], pr[8], pi[8];
#pragma unroll
            for (int j = 0; j < 8; ++j) { sr[j] = Sl[(c0 + j) * SP + lane]; si[j] = Sl[(c0 + j) * SP + 64 + lane]; }
            LDS_WAIT();
#pragma unroll
            for (int j = 0; j < 8; ++j) { pr[j] = hr; pi[j] = hi; float nr = __builtin_fmaf(lr, hr, -(li * hi)) + sr[j], ni = __builtin_fmaf(lr, hi, li * hr) + si[j]; asm volatile("" : "+v"(nr), "+v"(ni)); hr = nr; hi = ni; }
#pragma unroll
            for (int j = 0; j < 8; ++j) { Sl[(c0 + j) * SP + lane] = pr[j]; Sl[(c0 + j) * SP + 64 + lane] = pi[j]; }
            LDS_WAIT();
        }
        float* ho = C.out + O_SSMP + ((size_t)(l * NB + b) * NG + g) * 128 + 2 * lane; ho[0] = hr; ho[1] = hi;
#ifdef DBG_DUMP_S
        { float* d2 = (float*)(C.ws + WS_ATT) + 4194304 + ((size_t)(b) * NG + g) * 128 + 2 * lane; d2[0] = hr; d2[1] = hi; }
#endif
    }
    f32x4 ya[2][8];
#pragma unroll
    for (int mb = 0; mb < 2; ++mb)
#pragma unroll
        for (int nb = 0; nb < 8; ++nb) ya[mb][nb] = (f32x4){0.f, 0.f, 0.f, 0.f};
#pragma unroll
    for (int ks = 0; ks < 8; ++ks) { if (ks <= wid) {
#pragma unroll
        for (int nb = 0; nb < 8; ++nb) { const bf16x8 y = *(const LAS bf16x8*)(Ul + (16 * nb + fr) * UP + 32 * ks + 8 * fq);
            ya[0][nb] = __builtin_amdgcn_mfma_f32_16x16x32_bf16(tg0[ks], y, ya[0][nb], 0, 0, 0); ya[1][nb] = __builtin_amdgcn_mfma_f32_16x16x32_bf16(tg1[ks], y, ya[1][nb], 0, 0, 0); } } }
    __syncthreads();
#ifndef DBG_NOCARRY
#pragma unroll
    for (int ks = 0; ks < 4; ++ks) {
        const bf16x8 x0 = *(const bf16x8*)(FG + (size_t)(32 * wid + fr) * 128 + 32 * ks + 8 * fq), x1 = *(const bf16x8*)(FG + (size_t)(32 * wid + 16 + fr) * 128 + 32 * ks + 8 * fq);
#pragma unroll
        for (int nb = 0; nb < 8; ++nb) { const LAS float* hp = Sl + (16 * nb + fr) * SP + 32 * ks + 8 * fq; const f32x4 h0 = *(const LAS f32x4*)hp, h1 = *(const LAS f32x4*)(hp + 4);
            u32x4 w; w.x = cvt_pk_bf16(h0[0], h0[1]); w.y = cvt_pk_bf16(h0[2], h0[3]); w.z = cvt_pk_bf16(h1[0], h1[1]); w.w = cvt_pk_bf16(h1[2], h1[3]); const bf16x8 y = __builtin_bit_cast(bf16x8, w);
            ya[0][nb] = __builtin_amdgcn_mfma_f32_16x16x32_bf16(x0, y, ya[0][nb], 0, 0, 0); ya[1][nb] = __builtin_amdgcn_mfma_f32_16x16x32_bf16(x1, y, ya[1][nb], 0, 0, 0); } }
#endif
    bf16* Z = (bf16*)(C.ws + WS_Z);
#pragma unroll
    for (int mb = 0; mb < 2; ++mb)
#pragma unroll
        for (int nb = 0; nb < 8; ++nb) { const f32x4 y = ya[mb][nb]; u32x2 w; w.x = cvt_pk_bf16(gelu_tanh(y[0]), gelu_tanh(y[1])); w.y = cvt_pk_bf16(gelu_tanh(y[2]), gelu_tanh(y[3]));
            *(u32x2*)(Z + (size_t)(b * 2048 + 16 * (16 * nb + fr) + 2 * wid + mb) * 1024 + 16 * g + 4 * fq) = w; }
    __syncthreads();
}
__device__ __forceinline__ void ssm_sample_item(const Ctx& C, int l, int sb, int g) {
    const int lane = C.lane, lg = l * NG + g;
    const float* lm = (const float*)(C.ws + WS_LAM1) + (size_t)(lg * 64 + lane) * 2; const float lr = lm[0], li = lm[1];
    const float* h0 = C.in[I_SSSM] + (((size_t)(l * SB + sb) * NG + g) * 64 + lane) * 2; float hr = h0[0], hi = h0[1];
    const float* bb = (const float*)(C.ws + WS_BBAR) + (size_t)(lg * 64 + lane) * 32;
    f32x4 bq[8];
#pragma unroll
    for (int j = 0; j < 8; ++j) bq[j] = *(const f32x4*)(bb + 4 * j);
    const float* cre = C.in[I_CRE] + (size_t)lg * 1024 + lane; const float* cim = C.in[I_CIM] + (size_t)lg * 1024 + lane;
    const float dsk = (lane < 16) ? C.in[I_D][lg * 16 + lane] : 0.f;
    bf16* Z = (bf16*)(C.ws + WS_Z);
    float crv[16], civ[16];
#pragma unroll
    for (int p = 0; p < 16; ++p) { crv[p] = cre[p * 64]; civ[p] = cim[p * 64]; }
    for (int st = 0; st < ST; ++st) {
        const bf16* up = (const bf16*)(C.ws + WS_US) + (size_t)(sb * ST + st) * 1024 + 16 * g;
        const u32x4 u0 = *(const u32x4*)up, u1 = *(const u32x4*)(up + 8); float uf[16];
#pragma unroll
        for (int j = 0; j < 4; ++j) { uf[2 * j] = bflo(u0[j]); uf[2 * j + 1] = bfhi(u0[j]); uf[8 + 2 * j] = bflo(u1[j]); uf[8 + 2 * j + 1] = bfhi(u1[j]); }
        float br = 0.f, bi = 0.f;
#pragma unroll
        for (int j = 0; j < 8; ++j) { br += bq[j][0] * uf[2 * j] + bq[j][2] * uf[2 * j + 1]; bi += bq[j][1] * uf[2 * j] + bq[j][3] * uf[2 * j + 1]; }
        const float nr = lr * hr - li * hi + br, ni = lr * hi + li * hr + bi; hr = nr; hi = ni;
        float ymine = 0.f;
#pragma unroll
        for (int p = 0; p < 16; ++p) { const float y = wave_sum(crv[p] * hr - civ[p] * hi); if (lane == p) ymine = y + dsk * uf[p]; }
        if (lane < 16) Z[(size_t)(MP + sb * ST + st) * 1024 + 16 * g + lane] = f2bf(gelu_tanh(ymine));
    }
    float* ho = C.out + O_SSMS + (((size_t)(l * SB + sb) * NG + g) * 64 + lane) * 2; ho[0] = hr; ho[1] = hi;
}

#define KSWZ(row, colB) ((row) * 256 + ((colB) ^ (((row) & 7) << 4)))
#define SBAR() __builtin_amdgcn_sched_barrier(0)
constexpr int AL_V = 0, AL_K = 32768, AL_WS = 65536, AL_PC = 67584, AL_SC = 133120, AL_SM = 141312;
constexpr float CL2 = SM_SCALE * 1.4426950408889634f;
__device__ __forceinline__ int crow(int r, int hi) { return (r & 3) + 8 * (r >> 2) + 4 * hi; }
__device__ __forceinline__ int v_st(int k, int c) { const int kk = (k & ~0xC) | ((k & 4) << 1) | ((k & 8) >> 1); return ((kk >> 3) * 4 + (c >> 5)) * 512 + ((kk & 7) * 32 + (c & 31)) * 2; }
__device__ __forceinline__ int v_rd_base(int lane) { return ((lane & 3) << 3) | (((lane >> 2) & 3) << 6) | (((lane >> 4) & 1) << 5) | (((lane >> 5) & 1) << 8); }
constexpr int v_rd_off(int d0, int ks, int half) { return d0 * 512 + ks * 4096 + half * 2048; }
template <int OFF> __device__ __forceinline__ s16x4 tr_read(int vb) {
    s16x4 r; asm volatile("ds_read_b64_tr_b16 %0, %1 offset:%2" : "=&v"(r) : "v"(vb), "i"(OFF) : "memory"); return r;
}
struct PvOp { s16x4 l0, h0, l1, h1, l2, h2, l3, h3; };
template <int D0> __device__ __forceinline__ void pv_rd(PvOp& r, int vb) {
    r.l0 = tr_read<v_rd_off(D0, 0, 0)>(vb); r.h0 = tr_read<v_rd_off(D0, 0, 1)>(vb); r.l1 = tr_read<v_rd_off(D0, 1, 0)>(vb); r.h1 = tr_read<v_rd_off(D0, 1, 1)>(vb);
    r.l2 = tr_read<v_rd_off(D0, 2, 0)>(vb); r.h2 = tr_read<v_rd_off(D0, 2, 1)>(vb); r.l3 = tr_read<v_rd_off(D0, 3, 0)>(vb); r.h3 = tr_read<v_rd_off(D0, 3, 1)>(vb);
}
__device__ __forceinline__ void pv_mm(f32x16& od, const PvOp& r, bf16x8 pa0, bf16x8 pa1, bf16x8 pa2, bf16x8 pa3) {
#define PKV(L, H) (bf16x8){L[0], L[1], L[2], L[3], H[0], H[1], H[2], H[3]}
    od = __builtin_amdgcn_mfma_f32_32x32x16_bf16(pa0, PKV(r.l0, r.h0), od, 0, 0, 0);
    od = __builtin_amdgcn_mfma_f32_32x32x16_bf16(pa1, PKV(r.l1, r.h1), od, 0, 0, 0);
    od = __builtin_amdgcn_mfma_f32_32x32x16_bf16(pa2, PKV(r.l2, r.h2), od, 0, 0, 0);
    od = __builtin_amdgcn_mfma_f32_32x32x16_bf16(pa3, PKV(r.l3, r.h3), od, 0, 0, 0);
#undef PKV
}
__device__ __forceinline__ void pv_d0(f32x16* o, int vb, bf16x8 pa0, bf16x8 pa1, bf16x8 pa2, bf16x8 pa3) {
    PvOp ra, rb;
    pv_rd<0>(ra, vb); pv_rd<1>(rb, vb);
    asm volatile("s_waitcnt lgkmcnt(8)" ::: "memory"); SBAR(); pv_mm(o[0], ra, pa0, pa1, pa2, pa3); SBAR();
    pv_rd<2>(ra, vb);
    asm volatile("s_waitcnt lgkmcnt(8)" ::: "memory"); SBAR(); pv_mm(o[1], rb, pa0, pa1, pa2, pa3); SBAR();
    pv_rd<3>(rb, vb);
    asm volatile("s_waitcnt lgkmcnt(8)" ::: "memory"); SBAR(); pv_mm(o[2], ra, pa0, pa1, pa2, pa3); SBAR();
    asm volatile("s_waitcnt lgkmcnt(0)" ::: "memory"); SBAR(); pv_mm(o[3], rb, pa0, pa1, pa2, pa3);
}
__device__ __forceinline__ void qkt(f32x16& p0, f32x16& p1, const LAS unsigned char* Ks, const bf16x8* qr, int r32, int hi) {
    p0 = f32x16{}; p1 = f32x16{};
#pragma unroll
    for (int d0 = 0; d0 < 8; ++d0) { const int cb = (d0 * 16 + hi * 8) * 2;
        const bf16x8 b0 = *(const LAS bf16x8*)(Ks + KSWZ(r32, cb)); const bf16x8 b1 = *(const LAS bf16x8*)(Ks + KSWZ(32 + r32, cb));
        p0 = __builtin_amdgcn_mfma_f32_32x32x16_bf16(b0, qr[d0], p0, 0, 0, 0); p1 = __builtin_amdgcn_mfma_f32_32x32x16_bf16(b1, qr[d0], p1, 0, 0, 0); }
}
__device__ __forceinline__ float softmax_tile(f32x16& p0, f32x16& p1, float bc, float a2, int mode, int lim, int hi_in, float& m_reg, float& l_reg, bf16x8& pa0, bf16x8& pa1, bf16x8& pa2, bf16x8& pa3) {
    const float ninf = -__builtin_inff();
    int hi = hi_in; asm volatile("" : "+v"(lim), "+v"(hi));
    const float a2l = a2 + bc * (float)(4 * hi);
#pragma unroll
    for (int r = 0; r < 16; ++r) { const float cr = (float)((r & 3) + 8 * (r >> 2)); p0[r] = fmaf(bc, cr, p0[r]); p1[r] = fmaf(bc, cr, p1[r]); }
    if (mode != 0) {
#pragma unroll
        for (int r = 0; r < 16; ++r) { const int kk = (r & 3) + 8 * (r >> 2) + 4 * hi; const bool v0 = (mode == 1) ? (kk <= lim) : (kk > lim), v1 = (mode == 1) ? (kk + 32 <= lim) : (kk + 32 > lim);
            p0[r] = v0 ? p0[r] : ninf; p1[r] = v1 ? p1[r] : ninf; }
    }
    float m0 = p0[0], m1 = p1[0];
#pragma unroll
    for (int r = 1; r < 16; ++r) { m0 = fmaxf(m0, p0[r]); m1 = fmaxf(m1, p1[r]); }
    float pm = fmaxf(m0 + a2l, m1 + (a2l + 32.f * bc));
    { auto rr = __builtin_amdgcn_permlane32_swap(__float_as_uint(pm), __float_as_uint(pm), false, false); pm = fmaxf(__uint_as_float(rr[0]), __uint_as_float(rr[1])); }
    const float mn = fmaxf(m_reg, pm); const float alpha = __builtin_amdgcn_exp2f((m_reg - mn) * CL2); m_reg = mn;
    const float o0 = (a2l - mn) * CL2, o1 = (a2l + 32.f * bc - mn) * CL2;
#pragma unroll
    for (int r = 0; r < 16; ++r) { p0[r] = __builtin_amdgcn_exp2f(fmaf(p0[r], CL2, o0)); p1[r] = __builtin_amdgcn_exp2f(fmaf(p1[r], CL2, o1)); }
    float ps = 0.f;
#pragma unroll
    for (int r = 0; r < 16; ++r) ps += p0[r] + p1[r];
    { auto rr = __builtin_amdgcn_permlane32_swap(__float_as_uint(ps), __float_as_uint(ps), false, false); ps = __uint_as_float(rr[0]) + __uint_as_float(rr[1]); }
    l_reg = l_reg * alpha + ps;
#define PK4(P, BASE, OUT) do { unsigned a0 = cvt_pk_bf16(P[BASE + 0], P[BASE + 1]), a1 = cvt_pk_bf16(P[BASE + 2], P[BASE + 3]);   \
    unsigned b0 = cvt_pk_bf16(P[BASE + 4], P[BASE + 5]), b1 = cvt_pk_bf16(P[BASE + 6], P[BASE + 7]);                              \
    auto r0 = __builtin_amdgcn_permlane32_swap(a0, b0, false, false); auto r1 = __builtin_amdgcn_permlane32_swap(a1, b1, false, false); \
    u32x4 w = {r0[0], r1[0], r0[1], r1[1]}; OUT = __builtin_bit_cast(bf16x8, w); } while (0)
    PK4(p0, 0, pa0); PK4(p0, 8, pa1); PK4(p1, 0, pa2); PK4(p1, 8, pa3);
#undef PK4
    return alpha;
}
struct AttnSt { bf16x8 v0, v1, k0, k1; };
#define ATT_SLOAD(S, Kp, Vp, krow) do { (S).v0 = *(const bf16x8*)((Vp) + (size_t)((krow) + sr) * 128 + sc); (S).v1 = *(const bf16x8*)((Vp) + (size_t)((krow) + 32 + sr) * 128 + sc); \
    (S).k0 = *(const bf16x8*)((Kp) + (size_t)((krow) + sr) * 128 + sc); (S).k1 = *(const bf16x8*)((Kp) + (size_t)((krow) + 32 + sr) * 128 + sc); } while (0)
#define ATT_SWRITE(S, b) do { *(LAS bf16x8*)(lds + AL_V + (b) * 16384 + vst0) = (S).v0; *(LAS bf16x8*)(lds + AL_V + (b) * 16384 + vst1) = (S).v1; \
    *(LAS bf16x8*)(lds + AL_K + (b) * 16384 + KSWZ(sr, sc * 2)) = (S).k0; *(LAS bf16x8*)(lds + AL_K + (b) * 16384 + KSWZ(32 + sr, sc * 2)) = (S).k1; } while (0)
#define ATT_RESC(a) do { if (__any((a) < 1.f)) { if (hi == 0) al_l[r32] = (a); LDS_WAIT(); int hf = hi; asm volatile("" : "+v"(hf)); \
    _Pragma("unroll") for (int r = 0; r < 16; ++r) { const float f = al_l[crow(r, hf)]; _Pragma("unroll") for (int d = 0; d < 4; ++d) o[d][r] *= f; } } } while (0)
#define ATT_FINAL(gate_, first_) do { const float scl = (gate_) / fmaxf(l_reg, 1e-30f); if (hi == 0) li_l[r32] = scl; LDS_WAIT(); \
    int hf = hi, rf = r32; asm volatile("" : "+v"(hf), "+v"(rf)); \
    _Pragma("unroll") for (int rg = 0; rg < 4; ++rg) { \
    _Pragma("unroll") for (int r2 = 0; r2 < 4; ++r2) { const int r = 4 * rg + r2; const float f = li_l[crow(r, hf)]; float* op = ATTw + (size_t)crow(r, hf) * 1024 + rf; \
        _Pragma("unroll") for (int d = 0; d < 4; ++d) { const float val = o[d][r] * f; op[32 * d] = (first_) ? val : op[32 * d] + val; } } \
    if (rg & 1) asm volatile("" ::: "memory"); } } while (0)

__device__ __forceinline__ void attn_prompt_unit(const Ctx& C, int l, int b, int kvh, int qb) {
    LAS unsigned char* lds = C.lds;
    int lane = C.lane; asm volatile("" : "+v"(lane));
    const int tid = C.tid, wid = C.wid, r32 = lane & 31, hi = lane >> 5;
    if (wid < 4) __builtin_amdgcn_s_setprio(3);
    const int head = kvh * 4 + (wid >> 1), qloc = 32 * (wid & 1) + r32, t = 64 * qb + qloc, row = b * 2048 + t;
    LAS float* al_l = (LAS float*)(lds + AL_WS) + wid * 64; LAS float* li_l = al_l + 32;
    LAS _Float16* Pst = (LAS _Float16*)(lds + AL_PC); LAS float* Sc = (LAS float*)(lds + AL_SC); LAS unsigned* Sm = (LAS unsigned*)(lds + AL_SM);
    const float slope = __builtin_amdgcn_exp2f(-(float)(head + 1)), bck = slope * (1.0f / SM_SCALE);
    bf16x8 qr[8];
    {   const bf16* Qp = (const bf16*)(C.ws + WS_Q) + (size_t)row * 1024 + head * 128 + hi * 8; const float* qg = C.in[I_QN] + l * 128 + hi * 8;
        u32x4 raw[8]; float ss = 0.f;
#pragma unroll
        for (int d0 = 0; d0 < 8; ++d0) { raw[d0] = *(const u32x4*)(Qp + d0 * 16);
#pragma unroll
            for (int j = 0; j < 4; ++j) { const float a = bflo(raw[d0][j]), c = bfhi(raw[d0][j]); ss += a * a + c * c; } }
        ss += __shfl_xor(ss, 32); const float rstd = 1.0f / sqrtf(ss * (1.0f / 128.0f) + EPS);
#pragma unroll
        for (int d0 = 0; d0 < 8; ++d0) { const f32x4 g0 = *(const f32x4*)(qg + d0 * 16), g1 = *(const f32x4*)(qg + d0 * 16 + 4); u32x4 w;
            w.x = cvt_pk_bf16(bflo(raw[d0][0]) * rstd * g0[0], bfhi(raw[d0][0]) * rstd * g0[1]); w.y = cvt_pk_bf16(bflo(raw[d0][1]) * rstd * g0[2], bfhi(raw[d0][1]) * rstd * g0[3]);
            w.z = cvt_pk_bf16(bflo(raw[d0][2]) * rstd * g1[0], bfhi(raw[d0][2]) * rstd * g1[1]); w.w = cvt_pk_bf16(bflo(raw[d0][3]) * rstd * g1[2], bfhi(raw[d0][3]) * rstd * g1[3]);
            qr[d0] = __builtin_bit_cast(bf16x8, w); } }
    const float* grow = (const float*)(C.ws + WS_GT) + (size_t)row * 32 + head * 3;
    const float g_cmp = grow[0], g_slc = grow[1], g_win = grow[2];
    float* ATTw = (float*)(C.ws + WS_ATT) + (size_t)(b * 2048 + 64 * qb + 32 * (wid & 1)) * 1024 + head * 128;
    const int sr = tid >> 4, sc = (tid & 15) * 8, vst0 = v_st(sr, sc), vst1 = v_st(32 + sr, sc);
    const int vb0 = (int)(uintptr_t)(lds + AL_V) + v_rd_base(lane);
    if (tid < 64) Sm[tid] = 0u;
    f32x16 o[4]; float m_reg, l_reg; bf16x8 pa0, pa1, pa2, pa3; AttnSt stg;
    {   const bf16* Kp = (const bf16*)(C.ws + WS_CKVP) + (size_t)((0 * 4 + b) * 2 + kvh) * 128 * 128; const bf16* Vp = (const bf16*)(C.ws + WS_CKVP) + (size_t)((1 * 4 + b) * 2 + kvh) * 128 * 128;
        ATT_SLOAD(stg, Kp, Vp, 0); ATT_SWRITE(stg, 0); ATT_SLOAD(stg, Kp, Vp, 64); ATT_SWRITE(stg, 1);
        __syncthreads();
        m_reg = -1e30f; l_reg = 0.f;
        const int cmax = (t - 31) >> 4; const float bcc = 16.f * bck;
        {   f32x16 pA0, pA1, pB0, pB1; bf16x8 pb0, pb1, pb2, pb3;
            qkt(pA0, pA1, lds + AL_K, qr, r32, hi);
            (void)softmax_tile(pA0, pA1, bcc, 0.f, 1, cmax, hi, m_reg, l_reg, pa0, pa1, pa2, pa3);
            qkt(pB0, pB1, lds + AL_K + 16384, qr, r32, hi);
            const float al1 = softmax_tile(pB0, pB1, bcc, 64.f * bcc, 1, cmax - 64, hi, m_reg, l_reg, pb0, pb1, pb2, pb3);
            const float il = 1.0f / fmaxf(l_reg, 1e-30f), ia = al1 * il;
            LAS _Float16* prow = Pst + ((wid >> 1) * 64 + qloc) * 128;
#pragma unroll
            for (int r = 0; r < 16; ++r) { const int kk = crow(r, hi);
                prow[kk] = (_Float16)(pA0[r] * ia); prow[32 + kk] = (_Float16)(pA1[r] * ia); prow[64 + kk] = (_Float16)(pB0[r] * il); prow[96 + kk] = (_Float16)(pB1[r] * il); }
#pragma unroll
            for (int d = 0; d < 4; ++d) o[d] = f32x16{};
            pv_d0(o, vb0, pa0, pa1, pa2, pa3);
            ATT_RESC(al1);
            pv_d0(o, vb0 + 16384, pb0, pb1, pb2, pb3);
        }
        ATT_FINAL(g_cmp, true);
    }
    __syncthreads();
    {   int tid2 = tid; asm volatile("" : "+v"(tid2)); const int qi = tid2 >> 3, sub = tid2 & 7; const LAS _Float16* pq = Pst + qi * 128;
        float pc[17];
#pragma unroll
        for (int i = 0; i < 17; ++i) { const int c = 16 * sub - 1 + i; float v = 0.f; if (c >= 0) v = ((float)pq[c] + (float)pq[64 * 128 + c]) + ((float)pq[2 * 64 * 128 + c] + (float)pq[3 * 64 * 128 + c]); pc[i] = v; }
#pragma unroll
        for (int jj = 0; jj < 4; ++jj) { const int j = 4 * sub + jj; Sc[qi * 32 + j] = pc[4 * jj] + 2.f * (pc[4 * jj + 1] + pc[4 * jj + 2] + pc[4 * jj + 3]) + pc[4 * jj + 4]; }
        __syncthreads();
        if (qb >= 16) {
            for (int jj = 0; jj < 4; ++jj) { const int j = 4 * sub + jj; bool sel;
                if (j == 0 || j == qb || j == qb - 1) sel = true; else if (j > qb) sel = false;
                else { const float v = Sc[qi * 32 + j]; int rank = 0; for (int jp = 1; jp <= qb - 2; ++jp) { const float vp = Sc[qi * 32 + jp]; rank += (vp > v || (vp == v && jp < j)) ? 1 : 0; } sel = rank < 13; }
                if (sel) __hip_atomic_fetch_or(Sm + qi, 1u << j, __ATOMIC_RELAXED, __HIP_MEMORY_SCOPE_WORKGROUP); }
        } else if (sub == 0) Sm[qi] = (2u << qb) - 1u;
        __syncthreads();
    }
    const unsigned rowmask = Sm[qloc];
    const float ninf = -__builtin_inff();
    {   const bf16* Kp = (const bf16*)(C.ws + WS_KVS) + (size_t)((0 * 4 + b) * 2 + kvh) * 2048 * 128; const bf16* Vp = (const bf16*)(C.ws + WS_KVS) + (size_t)((1 * 4 + b) * 2 + kvh) * 2048 * 128;
#pragma unroll
        for (int d = 0; d < 4; ++d) o[d] = f32x16{};
        m_reg = -1e30f; l_reg = 0.f;
        ATT_SLOAD(stg, Kp, Vp, 64 * qb); ATT_SWRITE(stg, 0); __syncthreads();
        for (int j = qb; j >= 0; --j) { const int bf = (qb - j) & 1;
            if (j > 0) ATT_SLOAD(stg, Kp, Vp, 64 * (j - 1));
            if (__any((rowmask >> j) & 1u)) {
                f32x16 p0, p1; qkt(p0, p1, lds + AL_K + bf * 16384, qr, r32, hi);
                const float a2 = ((rowmask >> j) & 1u) ? bck * (float)(64 * (j - qb)) : ninf;
                const float al = softmax_tile(p0, p1, bck, a2, (j == qb) ? 1 : 0, qloc, hi, m_reg, l_reg, pa0, pa1, pa2, pa3);
                ATT_RESC(al);
                pv_d0(o, vb0 + bf * 16384, pa0, pa1, pa2, pa3); }
            if (j > 0) ATT_SWRITE(stg, bf ^ 1);
            __syncthreads(); }
        ATT_FINAL(g_slc, false);
    }
    {   const bf16* Kp = (const bf16*)(C.ws + WS_KVW) + (size_t)((0 * 4 + b) * 2 + kvh) * 2048 * 128; const bf16* Vp = (const bf16*)(C.ws + WS_KVW) + (size_t)((1 * 4 + b) * 2 + kvh) * 2048 * 128;
#pragma unroll
        for (int d = 0; d < 4; ++d) o[d] = f32x16{};
        m_reg = -1e30f; l_reg = 0.f;
        const int jlo = qb > 8 ? qb - 8 : 0;
        ATT_SLOAD(stg, Kp, Vp, 64 * qb); ATT_SWRITE(stg, 0); __syncthreads();
        for (int j = qb; j >= jlo; --j) { const int bf = (qb - j) & 1;
            if (j > jlo) ATT_SLOAD(stg, Kp, Vp, 64 * (j - 1));
            f32x16 p0, p1; qkt(p0, p1, lds + AL_K + bf * 16384, qr, r32, hi);
            const int mode = (j == qb) ? 1 : ((j == qb - 8) ? 2 : 0);
            const float al = softmax_tile(p0, p1, bck, bck * (float)(64 * (j - qb)), mode, qloc, hi, m_reg, l_reg, pa0, pa1, pa2, pa3);
            ATT_RESC(al);
            pv_d0(o, vb0 + bf * 16384, pa0, pa1, pa2, pa3);
            if (j > jlo) ATT_SWRITE(stg, bf ^ 1);
            __syncthreads(); }
        ATT_FINAL(g_win, false);
    }
    __builtin_amdgcn_s_setprio(0);
    __syncthreads();
}

constexpr int SA_SCP = 2576;
constexpr int SA_Q = 0, SA_SC = 2048, SA_PC = SA_SC + 4 * SA_SCP * 4, SA_BS = SA_PC + 4096, SA_RED = SA_BS + 1088, SA_SEL = SA_RED + 128, SA_KOFF = SA_SEL + 64, SA_PV = SA_KOFF + 8192, SA_END = SA_PV + 8 * 4 * 128 * 4;
static_assert(SA_END <= MISC_OFF, "sample attention LDS map");
__device__ __forceinline__ void dot4_f32(const float* k, const LAS float* qs, float (&s)[4]) {
    s[0] = s[1] = s[2] = s[3] = 0.f;
#pragma unroll 8
    for (int d = 0; d < 128; d += 4) { const f32x4 kv = *(const f32x4*)(k + d);
#pragma unroll
        for (int h = 0; h < 4; ++h) { const f32x4 q = *(const LAS f32x4*)(qs + h * 128 + d); s[h] += (kv[0] * q[0] + kv[1] * q[1]) + (kv[2] * q[2] + kv[3] * q[3]); } }
}
__device__ __forceinline__ void dot4_bf16(const bf16* k, const LAS float* qs, float (&s)[4]) {
    s[0] = s[1] = s[2] = s[3] = 0.f;
#pragma unroll 8
    for (int d = 0; d < 128; d += 8) { const u32x4 kw = *(const u32x4*)(k + d); float kf[8];
#pragma unroll
        for (int j = 0; j < 4; ++j) { kf[2 * j] = bflo(kw[j]); kf[2 * j + 1] = bfhi(kw[j]); }
#pragma unroll
        for (int h = 0; h < 4; ++h) { const f32x4 q0 = *(const LAS f32x4*)(qs + h * 128 + d), q1 = *(const LAS f32x4*)(qs + h * 128 + d + 4);
            s[h] += (kf[0] * q0[0] + kf[1] * q0[1]) + (kf[2] * q0[2] + kf[3] * q0[3]) + (kf[4] * q1[0] + kf[5] * q1[1]) + (kf[6] * q1[2] + kf[7] * q1[3]); } }
}
__device__ __forceinline__ void sample_softmax(int wid, int lane, LAS float* sc, LAS float* red, int n) {
    const int h = wid >> 1, c0 = (wid & 1) * 64 + lane; LAS float* row = sc + h * SA_SCP;
    float mx = -__builtin_inff(); for (int c = c0; c < n; c += 128) mx = fmaxf(mx, row[c]);
    mx = wave_max(mx); if (lane == 0) red[wid] = mx;
    __syncthreads();
    float m = fmaxf(red[2 * h], red[2 * h + 1]); if (!(m > -1e37f)) m = 0.f;
    float sm = 0.f; for (int c = c0; c < n; c += 128) { const float e = __builtin_amdgcn_exp2f((row[c] - m) * 1.4426950408889634f); row[c] = e; sm += e; }
    sm = wave_sum(sm); if (lane == 0) red[8 + wid] = sm;
    __syncthreads();
    const float inv = 1.0f / fmaxf(red[8 + 2 * h] + red[8 + 2 * h + 1], 1e-37f);
    for (int c = c0; c < n; c += 128) row[c] *= inv;
    __syncthreads();
}
__device__ __forceinline__ void attn_sample_unit(const Ctx& C, int l, int sb, int kvh, int st) {
    LAS unsigned char* lds = C.lds; int tid = C.tid; asm volatile("" : "+v"(tid)); const int lane = tid & 63, wid = C.wid;
    LAS float* qs = (LAS float*)(lds + SA_Q); LAS float* sc = (LAS float*)(lds + SA_SC); LAS float* pc = (LAS float*)(lds + SA_PC); LAS float* bs = (LAS float*)(lds + SA_BS);
    LAS float* red = (LAS float*)(lds + SA_RED); LAS int* selj = (LAS int*)(lds + SA_SEL); LAS unsigned long long* koff = (LAS unsigned long long*)(lds + SA_KOFF); LAS float* pvr = (LAS float*)(lds + SA_PV);
    const int pos = PAST + st, row = MP + sb * ST + st; const int* pt = (const int*)C.in[I_PT];
    if (wid < 4) { const int h = wid; const unsigned w = *(const unsigned*)((const bf16*)(C.ws + WS_Q) + (size_t)row * 1024 + (kvh * 4 + h) * 128 + 2 * lane); const float x0 = bflo(w), x1 = bfhi(w);
        const float rstd = 1.0f / sqrtf(wave_sum(x0 * x0 + x1 * x1) * (1.0f / 128.0f) + EPS); const f32x2 g = *(const f32x2*)(C.in[I_QN] + l * 128 + 2 * lane);
        qs[h * 128 + 2 * lane] = x0 * rstd * g[0]; qs[h * 128 + 2 * lane + 1] = x1 * rstd * g[1]; }
    __syncthreads();
    float slope[4];
#pragma unroll
    for (int h = 0; h < 4; ++h) slope[h] = __builtin_amdgcn_exp2f(-(float)(kvh * 4 + h + 1));
    const bf16* CK = (const bf16*)(C.ws + WS_CKVS) + (size_t)(((l * 2 + 0) * 8 + sb) * 2 + kvh) * 1024 * 128; const bf16* CV = (const bf16*)(C.ws + WS_CKVS) + (size_t)(((l * 2 + 1) * 8 + sb) * 2 + kvh) * 1024 * 128;
    const float* WB = C.in[I_SWIN] + ((((size_t)l * SB + sb) * 512) * 2 + kvh) * 256;
    const float* WN = C.out + O_WINS + ((((size_t)l * SB + sb) * 512 + 508) * 2 + kvh) * 256;
    for (int c = tid; c < 1023; c += 512) { float s[4]; dot4_bf16(CK + (size_t)c * 128, qs, s); const float dist = (float)(pos - 16 * c) - 15.5f;
#pragma unroll
        for (int h = 0; h < 4; ++h) sc[h * SA_SCP + c] = s[h] * SM_SCALE - slope[h] * dist; }
    __syncthreads();
    sample_softmax(wid, lane, sc, red, 1023);
    for (int c = tid; c < 1024; c += 512) pc[c] = (c < 1023) ? (sc[c] + sc[SA_SCP + c]) + (sc[2 * SA_SCP + c] + sc[3 * SA_SCP + c]) : 0.f;
    __syncthreads();
    for (int j = tid; j < 257; j += 512) { float s = 0.f; if (j < 256) s = 2.f * (pc[4 * j] + pc[4 * j + 1] + pc[4 * j + 2]) + pc[4 * j + 3]; if (j > 0) s += pc[4 * j - 1]; bs[j] = s; }
    if (tid == 0) { selj[0] = 0; selj[1] = 255; selj[2] = 256; }
    __syncthreads();
    if (tid < 254) { const int j = tid + 1; const float v = bs[j]; int rank = 0; for (int jp = 1; jp <= 254; ++jp) { const float vp = bs[jp]; rank += (vp > v || (vp == v && jp < j)) ? 1 : 0; } if (rank < 13) selj[3 + rank] = j; }
    __syncthreads();
    for (int idx = tid; idx < 1024 + 516; idx += 512) {
        const float* base; bool valid = true; int kpos;
        if (idx < 1024) { const int j = selj[idx >> 6], r = idx & 63; kpos = 64 * j + r;
            if (j < 256) { const int page = pt[sb * 128 + (j >> 1)]; base = C.in[I_CSLC] + ((((size_t)l * NPOOL + page) * 128 + (j & 1) * 64 + r) * 2 + kvh) * 256; }
            else { valid = (r <= st); base = C.out + O_SLCS + ((((size_t)l * SB + sb) * 4 + (r < 4 ? r : 0)) * 2 + kvh) * 256; }
            koff[idx] = (unsigned long long)(uintptr_t)base;
        } else { const int i = idx - 1024;
            if (i < 512) { base = WB + (size_t)i * 512; valid = i > st; kpos = PAST - 512 + i; } else { const int r = i - 512; base = WN + (size_t)r * 512; valid = r <= st; kpos = PAST + r; } }
        float s[4]; dot4_f32(base, qs, s); const float dist = (float)(pos - kpos);
#pragma unroll
        for (int h = 0; h < 4; ++h) sc[h * SA_SCP + 1024 + idx] = valid ? (s[h] * SM_SCALE - slope[h] * dist) : -__builtin_inff(); }
    __syncthreads();
    sample_softmax(wid, lane, sc + 1024, red, 1024);
    sample_softmax(wid, lane, sc + 2048, red, 516);
    float acc[3][4][2];
#pragma unroll
    for (int b3 = 0; b3 < 3; ++b3)
#pragma unroll
        for (int h = 0; h < 4; ++h) { acc[b3][h][0] = 0.f; acc[b3][h][1] = 0.f; }
    {
        const bf16* vp = CV + 2 * lane;
#pragma unroll 1
        for (int i0 = 0; i0 < 128; i0 += 16) { unsigned v[16];
#pragma unroll
            for (int j = 0; j < 16; ++j) { const int c = wid + 8 * (i0 + j); v[j] = *(const unsigned*)(vp + (size_t)(c < 1023 ? c : 1022) * 128); }
#pragma unroll
            for (int j = 0; j < 16; ++j) { const int c = wid + 8 * (i0 + j); const float v0 = (c < 1023) ? bflo(v[j]) : 0.f, v1 = (c < 1023) ? bfhi(v[j]) : 0.f;
#pragma unroll
                for (int h = 0; h < 4; ++h) { const float p = sc[h * SA_SCP + (c < 1023 ? c : 1022)]; acc[0][h][0] += p * v0; acc[0][h][1] += p * v1; } } }
    }
    {
#pragma unroll 1
        for (int i0 = 0; i0 < 128; i0 += 16) { f32x2 v[16];
#pragma unroll
            for (int j = 0; j < 16; ++j) { const int k = wid + 8 * (i0 + j); v[j] = *(const GAS f32x2*)((const GAS float*)(uintptr_t)koff[k] + 128 + 2 * lane); }
#pragma unroll
            for (int j = 0; j < 16; ++j) { const int k = wid + 8 * (i0 + j);
#pragma unroll
                for (int h = 0; h < 4; ++h) { const float p = sc[h * SA_SCP + 1024 + k]; acc[1][h][0] += p * v[j][0]; acc[1][h][1] += p * v[j][1]; } } }
    }
    {
#pragma unroll 1
        for (int i0 = 0; i0 < 65; i0 += 13) { f32x2 v[13];
#pragma unroll
            for (int j = 0; j < 13; ++j) { const int i = wid + 8 * (i0 + j); const int ic = i < 516 ? i : 515; const float* p = (ic < 512) ? WB + (size_t)ic * 512 : WN + (size_t)(ic - 512) * 512; v[j] = *(const f32x2*)(p + 128 + 2 * lane); }
#pragma unroll
            for (int j = 0; j < 13; ++j) { const int i = wid + 8 * (i0 + j); const int ic = i < 516 ? i : 515; const float m = i < 516 ? 1.f : 0.f;
#pragma unroll
                for (int h = 0; h < 4; ++h) { const float p = sc[h * SA_SCP + 2048 + ic] * m; acc[2][h][0] += p * v[j][0]; acc[2][h][1] += p * v[j][1]; } } }
    }
    const float* grow = (const float*)(C.ws + WS_GT) + (size_t)row * 32 + kvh * 12;
#pragma unroll
    for (int h = 0; h < 4; ++h) { const float g0 = grow[h * 3], g1 = grow[h * 3 + 1], g2 = grow[h * 3 + 2];
        *(LAS f32x2*)(pvr + (wid * 4 + h) * 128 + 2 * lane) = (f32x2){g0 * acc[0][h][0] + g1 * acc[1][h][0] + g2 * acc[2][h][0], g0 * acc[0][h][1] + g1 * acc[1][h][1] + g2 * acc[2][h][1]}; }
    __syncthreads();
    { float t = 0.f;
#pragma unroll
      for (int w = 0; w < 8; ++w) t += pvr[w * 512 + tid];
      ((float*)(C.ws + WS_ATT))[(size_t)row * 1024 + kvh * 512 + tid] = t; }
    __syncthreads();
}
template <class Sched>
__device__ __forceinline__ void prenorm_prologue(const Ctx& C, const Sched& S, const float* PS, const float* PSS) {
    LAS float* RS = (LAS float*)(C.lds + LDS_RS);
    const int rr = C.tid >> 1, half = C.tid & 1;
    int pms[8];
#pragma unroll
    for (int i = 0; i < 8; ++i) { pg8::Unit u; pms[i] = S.next(i, u) ? u.pm : -1; }
#pragma unroll 4
    for (int i = 0; i < 8; ++i) { if (pms[i] >= 0) { float rs = 1.0f;
        if (PS) { const int grow = pms[i] * 256 + rr;
            if (grow < MP) { const float* p = PS + (size_t)grow * 32 + half * 16; float s = 0.f;
#pragma unroll
                for (int k = 0; k < 4; ++k) { const f32x4 v = *(const f32x4*)(p + 4 * k); s += (v[0] + v[1]) + (v[2] + v[3]); }
                s += __shfl_xor(s, 1); rs = 1.0f / sqrtf(s * (1.0f / 2048.0f) + EPS); }
            else if (grow < MR) { const float* p = PSS + (size_t)(grow - MP) * 128 + half * 64; float s = 0.f;
#pragma unroll
                for (int k = 0; k < 16; ++k) { const f32x4 v = *(const f32x4*)(p + 4 * k); s += (v[0] + v[1]) + (v[2] + v[3]); }
                s += __shfl_xor(s, 1); rs = 1.0f / sqrtf(s * (1.0f / 2048.0f) + EPS); } }
        if (half == 0) RS[i * 256 + rr] = rs; } }
    __syncthreads();
}

#ifndef PHMASK
#define PHMASK 0x1fff
#endif
#define SITE(i) ((PHMASK >> (i)) & 1)
#ifndef DBG_GU_A
#define DBG_GU_A WS_HN
#endif
constexpr int NPH = 16;
__global__ void __launch_bounds__(512, 2) hymba_fwd(Args a) {
    extern __shared__ __attribute__((aligned(16))) unsigned char lds_raw[];
    Ctx C0; C0.lds = (LAS unsigned char*)lds_raw; C0.tid = threadIdx.x; C0.lane = C0.tid & 63; C0.wid = __builtin_amdgcn_readfirstlane(C0.tid >> 6); C0.G = gridDim.x; C0.wg = blockIdx.x;
    C0.in.p = (InArr)__builtin_amdgcn_kernarg_segment_ptr(); C0.out = a.out; C0.ws = a.ws;
    LAS unsigned char* lds = C0.lds;
    volatile LAS unsigned* misc = (volatile LAS unsigned*)(lds + MISC_OFF);
    if (C0.tid < 4) misc[C0.tid] = 0u;
    __syncthreads();
#if !MK_MULTI
    XcdBarrier bar = xcd_barrier_post((unsigned*)(a.ws + WS_CTL) + CW_BAR, misc);
#endif
    const int lo = a.ph_lo, hi = a.ph_hi % 1000, variant = a.ph_hi / 1000;
#define IN(k) (lo <= (k) && (k) < hi)
#if MK_MULTI
#define SEAM(k) do { } while (0)
#else
#define SEAM(k) do { if (IN(k) && IN((k) + 1)) xcd_barrier(bar); } while (0)
#endif
#define SITE_BEGIN() Ctx Cs = C0; GAS unsigned char* wsg_ = (GAS unsigned char*)C0.ws; GAS float* outg_ = (GAS float*)C0.out; asm volatile("" : "+s"(wsg_), "+s"(outg_), "+s"(Cs.in.p), "+s"(Cs.G), "+s"(Cs.wg), "+s"(Cs.wid), "+v"(Cs.tid), "+v"(Cs.lane)); Cs.ws = (unsigned char*)wsg_; Cs.out = (float*)outg_; unsigned char* ws = Cs.ws; const Ctx& C = Cs; const int G = Cs.G, wg = Cs.wg, NGW = G * 8, gw = wg * 8 + C.wid; (void)gw; (void)ws; (void)NGW

    if (SITE(0) && IN(0)) { SITE_BEGIN(); p0_prologue(C); }
    SEAM(0);
    if (SITE(1) && IN(1)) { SITE_BEGIN();
        for (int u = wg; u < 512; u += G) cmp1_sample_unit(C, u, variant);
    }
    SEAM(1);
    {
        constexpr int l = 0, pb = 2 + 7 * l;
        if (SITE(3) && IN(pb + 0)) { SITE_BEGIN();
            if (l == 0) {
            for (int u = wg; u < 512; u += G) { const int seq = u >> 3, blk = u & 7, lk = seq >> 4, l = lk >> 1, kv = lk & 1;
                cmp_stage2_unit(C, (const float*)(ws + WS_TBS), (size_t)seq * 1024, blk * 128, 1023, C.in[kv ? I_B1V : I_B1K] + l * 128, (const bf16*)(ws + WS_W2T) + (size_t)lk * 128 * 128,
                                kv ? nullptr : C.in[I_KNC] + l * 128, (bf16*)(ws + WS_CKVS) + ((size_t)seq * 1024 + blk * 128) * 128); }

                __syncthreads(); }
            pg8::Gemm g{(const pg8::bf16_t*)(ws + WS_XN), (const pg8::bf16_t*)(ws + WS_WIN) + (size_t)l * INWP * DM, MPAD, INWP, DM}; pg8::StaticOrder S; S.init(MPAD, INWP, G, wg);
            if (l == 0) prenorm_prologue(C, S, nullptr, nullptr); else prenorm_prologue(C, S, (const float*)(ws + WS_PS), (const float*)(ws + WS_PSS));
            pg8::EpiIn E{(pg8::bf16_t*)(ws + WS_U), (pg8::bf16_t*)(ws + WS_US), (pg8::bf16_t*)(ws + WS_Q), (float*)(ws + WS_KVRAW), (float*)(ws + WS_GT), (pg8::bf16_t*)(ws + WS_KVC), (const PG8_LAS float*)(lds + LDS_RS), 0};
            pg8::gemm_phase<pg8::EpiIn, pg8::StaticOrder, true, true>(lds, g, S, E);
            if (l == 0 && G == 256 && wg >= 239) {
                __syncthreads(); LAS float* scr = (LAS float*)(C.lds + C.wid * 16384);
                for (int i = (wg - 239) * 8 + C.wid; i < TI_OUT; i += 17 * 8) weight_item(C, TI_LAYER + TI_IN + TI_GLU + i, scr); }
        }
        SEAM(pb + 0);
        if (SITE(4) && IN(pb + 1)) { SITE_BEGIN();
            const bool fast = (G == 256);
            if (variant == 0 || variant == 1) {
            if (fast) { if (wg >= 8 && wg < 248) for (int r = (wg - 8) * 8 + C.wid; r < MR; r += 240 * 8) kvfix_row(C, l, r);
                        if (wg >= 128 && wg < 192) { const int i = (wg - 128) * 8 + C.wid; ssm_sample_item(C, l, i / NG, i % NG); } }
            else { for (int r = gw; r < MR; r += NGW) kvfix_row(C, l, r);
                   for (int i = gw; i < SB * NG; i += NGW) ssm_sample_item(C, l, i / NG, i % NG); } }
            __syncthreads();
            const int nss = G > 16 ? G - 8 : G, ncm = G > 16 ? 8 : G, ccm = G > 16 ? wg - nss : wg;
            if ((variant == 0 || variant == 2) && wg < nss) for (int u = wg; u < NB * NG; u += nss) ssm_unit(C, l, u / NG, u % NG);
            {   pg8::Gemm g{(const pg8::bf16_t*)(ws + WS_KVC), (const pg8::bf16_t*)(ws + WS_W1C) + (size_t)l * 2 * 256 * 2048, 0, 0, 2048};
                pg8::GroupOrder S{8, ncm, (variant == 0 || variant == 3) ? ccm : -1, 4}; pg8::EpiTB E{(float*)(ws + WS_TBP)};
                pg8::gemm_phase<pg8::EpiTB, pg8::GroupOrder, true, true>(lds, g, S, E); }
            if (ccm >= 0 && (variant == 0 || variant == 3)) { VM_WAIT(); __syncthreads();
                for (int L = ccm; L < 8; L += ncm) for (int h2 = 0; h2 < 2; ++h2) { const int u = 2 * L + h2, kv = u >> 3;
                    cmp_stage2_unit(C, (const float*)(ws + WS_TBP), (size_t)u * 128, 0, 127, C.in[kv ? I_B1V : I_B1K] + l * 128, (const bf16*)(ws + WS_W2T) + (size_t)(l * 2 + kv) * 128 * 128,
                                    kv ? nullptr : C.in[I_KNC] + l * 128, (bf16*)(ws + WS_CKVP) + (size_t)u * 128 * 128); } }
        }
        SEAM(pb + 1);
        if (SITE(5) && IN(pb + 2)) { SITE_BEGIN();
            const bool fast = (G == 256);
            int gc = wg, gG = G;
            if (fast) { gG = 1 << 20; gc = 1 << 20;
                if (wg < 64) gc = wg; else if (wg >= 128) { const int p = wg - 128, j = p >> 3; if (j < 9) gc = 64 + 8 * j + (p & 7); } }
            {   pg8::Gemm g{(const pg8::bf16_t*)(ws + WS_Z), (const pg8::bf16_t*)(ws + WS_WGLU) + (size_t)l * 1024 * 1024, MPAD, 1024, 1024}; if (!(variant == 0 || variant == 4)) { gc = 1 << 20; gG = 1 << 20; }
                pg8::StaticOrder S; S.init(MPAD, 1024, gG, gc);
                pg8::EpiGlu E{(const pg8::bf16_t*)(ws + WS_Z), (pg8::bf16_t*)(ws + WS_SSMY)};
                pg8::gemm_phase<pg8::EpiGlu, pg8::StaticOrder, true, true>(lds, g, S, E); }
            __syncthreads();
#ifndef NO_SA
            if (fast) { if (wg < 64 && (variant == 0 || variant == 5)) attn_sample_unit(C, l, wg >> 3, (wg >> 2) & 1, wg & 3); }
            else for (int s = wg; s < 64; s += G) attn_sample_unit(C, l, s >> 3, (s >> 2) & 1, s & 3);
#endif
#ifndef NO_PA
            if (fast && (variant == 0 || variant == 6)) {
                if (wg >= 128) { const int p = wg - 128, bk = p & 7; attn_prompt_unit(C, l, bk >> 1, bk & 1, 16 + (p >> 3)); }
                else if (wg >= 64) { const int p = wg - 64, bk = p & 7, k = p >> 3;
                    for (int t2 = 0; t2 < 2; ++t2) attn_prompt_unit(C, l, bk >> 1, bk & 1, t2 == 0 ? 15 - k : k); }
            } else if (!fast) for (int u = wg; u < 256; u += G) { const int qb = u & 31, bk = u >> 5; attn_prompt_unit(C, l, bk >> 1, bk & 1, qb); }
#endif
        }
        SEAM(pb + 2);
        if (SITE(6) && IN(pb + 3)) { SITE_BEGIN(); for (int r = gw; r < MR; r += 4 * NGW) { const int left = (MR - r + NGW - 1) / NGW; mixnorm_rows<4>(C, l, r, NGW, left < 4 ? left : 4); } }
        SEAM(pb + 3);
        if (SITE(7) && IN(pb + 4)) { SITE_BEGIN();
            const void* bp = l == 0 ? (const void*)C.in[I_XP] : (const void*)(ws + WS_XN); const void* bs = l == 0 ? (const void*)C.in[I_XS] : (const void*)((const bf16*)(ws + WS_XN) + (size_t)MP * DM);
            const pg8::bf16_t* Wt = (const pg8::bf16_t*)(ws + WS_WOUT) + (size_t)l * DM * DM;
            {   pg8::Gemm g{(const pg8::bf16_t*)(ws + WS_H), Wt, MP, DM, DM}; pg8::StaticOrder S; S.init(MP, DM, G, wg); pg8::EpiRes<(l == 0), false> E{bp, (void*)(ws + WS_HN), (float*)(ws + WS_PS)};
                pg8::gemm_phase<pg8::EpiRes<(l == 0), false>, pg8::StaticOrder, true, true>(lds, g, S, E); }
            __syncthreads();
            sample_gemm_res<(l == 0), false>(C, (const bf16*)(ws + WS_H) + (size_t)MP * DM, Wt, DM, bs, (void*)((bf16*)(ws + WS_HN) + (size_t)MP * DM), wg, G, (float*)(ws + WS_PSS));
        }
        SEAM(pb + 4);
        if (SITE(8) && IN(pb + 5)) { SITE_BEGIN();
            pg8::Gemm g{(const pg8::bf16_t*)(ws + DBG_GU_A), (const pg8::bf16_t*)(ws + WS_WGU) + (size_t)l * 2 * DFF * DM, MPAD, 2 * DFF, DM}; pg8::StaticOrder S; S.init(MPAD, 2 * DFF, G, wg);
            prenorm_prologue(C, S, (const float*)(ws + WS_PS), (const float*)(ws + WS_PSS));
            pg8::EpiSwiGLU E{(pg8::bf16_t*)(ws + WS_HMID), (const PG8_LAS float*)(lds + LDS_RS), 0};
#ifdef DBG_ONEUNIT
            for (int ui = 0; ui < 6; ++ui) { pg8::OneUnitOrder S1{S, ui}; pg8::gemm_phase<pg8::EpiSwiGLU, pg8::OneUnitOrder, true, true>(lds, g, S1, E); __syncthreads(); }
#else
            pg8::gemm_phase<pg8::EpiSwiGLU, pg8::StaticOrder, true, true>(lds, g, S, E);
#endif
            if (l == 0 && G == 256 && wg >= 172) {
                __syncthreads(); LAS float* scr = (LAS float*)(C.lds + C.wid * 16384);
                for (int i = (wg - 172) * 8 + C.wid; i < TI_DN + TI_GLU + TI_IN_DEF; i += 84 * 8)
                    weight_item(C, TI_LAYER + (i < TI_DN ? TI_IN + TI_GLU + TI_OUT + 2 * TI_G + i : (i < TI_DN + TI_GLU ? TI_IN + (i - TI_DN) : i - TI_DN - TI_GLU)), scr); }
        }
        SEAM(pb + 5);
        if (SITE(9) && IN(pb + 6)) { SITE_BEGIN();
            void* op = l == 0 ? (void*)(ws + WS_XN) : (void*)(C.out + O_YP); void* os = l == 0 ? (void*)((bf16*)(ws + WS_XN) + (size_t)MP * DM) : (void*)(C.out + O_YS);
            const pg8::bf16_t* Wt = (const pg8::bf16_t*)(ws + WS_WDN) + (size_t)l * DM * DFF;
            {   pg8::Gemm g{(const pg8::bf16_t*)(ws + WS_HMID), Wt, MP, DM, DFF}; pg8::StaticOrder S; S.init(MP, DM, G, wg); pg8::EpiRes<false, (l == 1)> E{(const void*)(ws + WS_HN), op, l == 0 ? (float*)(ws + WS_PS) : nullptr};
                pg8::gemm_phase<pg8::EpiRes<false, (l == 1)>, pg8::StaticOrder, true, true>(lds, g, S, E); }
            __syncthreads();
            sample_gemm_res<false, (l == 1)>(C, (const bf16*)(ws + WS_HMID) + (size_t)MP * DFF, Wt, DFF, (const void*)((const bf16*)(ws + WS_HN) + (size_t)MP * DM), os, wg, G, l == 0 ? (float*)(ws + WS_PSS) : nullptr);
        }
        SEAM(pb + 6);
    }
    {
        constexpr int l = 1, pb = 2 + 7 * l;
        if (SITE(3) && IN(pb + 0)) { SITE_BEGIN();
            if (l == 0) {
            for (int u = wg; u < 512; u += G) { const int seq = u >> 3, blk = u & 7, lk = seq >> 4, l = lk >> 1, kv = lk & 1;
                cmp_stage2_unit(C, (const float*)(ws + WS_TBS), (size_t)seq * 1024, blk * 128, 1023, C.in[kv ? I_B1V : I_B1K] + l * 128, (const bf16*)(ws + WS_W2T) + (size_t)lk * 128 * 128,
                                kv ? nullptr : C.in[I_KNC] + l * 128, (bf16*)(ws + WS_CKVS) + ((size_t)seq * 1024 + blk * 128) * 128); }

                __syncthreads(); }
            pg8::Gemm g{(const pg8::bf16_t*)(ws + WS_XN), (const pg8::bf16_t*)(ws + WS_WIN) + (size_t)l * INWP * DM, MPAD, INWP, DM}; pg8::StaticOrder S; S.init(MPAD, INWP, G, wg);
            if (l == 0) prenorm_prologue(C, S, nullptr, nullptr); else prenorm_prologue(C, S, (const float*)(ws + WS_PS), (const float*)(ws + WS_PSS));
            pg8::EpiIn E{(pg8::bf16_t*)(ws + WS_U), (pg8::bf16_t*)(ws + WS_US), (pg8::bf16_t*)(ws + WS_Q), (float*)(ws + WS_KVRAW), (float*)(ws + WS_GT), (pg8::bf16_t*)(ws + WS_KVC), (const PG8_LAS float*)(lds + LDS_RS), 0};
            pg8::gemm_phase<pg8::EpiIn, pg8::StaticOrder, true, true>(lds, g, S, E);
            if (l == 0 && G == 256 && wg >= 239) {
                __syncthreads(); LAS float* scr = (LAS float*)(C.lds + C.wid * 16384);
                for (int i = (wg - 239) * 8 + C.wid; i < TI_OUT; i += 17 * 8) weight_item(C, TI_LAYER + TI_IN + TI_GLU + i, scr); }
        }
        SEAM(pb + 0);
        if (SITE(4) && IN(pb + 1)) { SITE_BEGIN();
            const bool fast = (G == 256);
            if (variant == 0 || variant == 1) {
            if (fast) { if (wg >= 8 && wg < 248) for (int r = (wg - 8) * 8 + C.wid; r < MR; r += 240 * 8) kvfix_row(C, l, r);
                        if (wg >= 128 && wg < 192) { const int i = (wg - 128) * 8 + C.wid; ssm_sample_item(C, l, i / NG, i % NG); } }
            else { for (int r = gw; r < MR; r += NGW) kvfix_row(C, l, r);
                   for (int i = gw; i < SB * NG; i += NGW) ssm_sample_item(C, l, i / NG, i % NG); } }
            __syncthreads();
            const int nss = G > 16 ? G - 8 : G, ncm = G > 16 ? 8 : G, ccm = G > 16 ? wg - nss : wg;
            if ((variant == 0 || variant == 2) && wg < nss) for (int u = wg; u < NB * NG; u += nss) ssm_unit(C, l, u / NG, u % NG);
            {   pg8::Gemm g{(const pg8::bf16_t*)(ws + WS_KVC), (const pg8::bf16_t*)(ws + WS_W1C) + (size_t)l * 2 * 256 * 2048, 0, 0, 2048};
                pg8::GroupOrder S{8, ncm, (variant == 0 || variant == 3) ? ccm : -1, 4}; pg8::EpiTB E{(float*)(ws + WS_TBP)};
                pg8::gemm_phase<pg8::EpiTB, pg8::GroupOrder, true, true>(lds, g, S, E); }
            if (ccm >= 0 && (variant == 0 || variant == 3)) { VM_WAIT(); __syncthreads();
                for (int L = ccm; L < 8; L += ncm) for (int h2 = 0; h2 < 2; ++h2) { const int u = 2 * L + h2, kv = u >> 3;
                    cmp_stage2_unit(C, (const float*)(ws + WS_TBP), (size_t)u * 128, 0, 127, C.in[kv ? I_B1V : I_B1K] + l * 128, (const bf16*)(ws + WS_W2T) + (size_t)(l * 2 + kv) * 128 * 128,
                                    kv ? nullptr : C.in[I_KNC] + l * 128, (bf16*)(ws + WS_CKVP) + (size_t)u * 128 * 128); } }
        }
        SEAM(pb + 1);
        if (SITE(5) && IN(pb + 2)) { SITE_BEGIN();
            const bool fast = (G == 256);
            int gc = wg, gG = G;
            if (fast) { gG = 1 << 20; gc = 1 << 20;
                if (wg < 64) gc = wg; else if (wg >= 128) { const int p = wg - 128, j = p >> 3; if (j < 9) gc = 64 + 8 * j + (p & 7); } }
            {   pg8::Gemm g{(const pg8::bf16_t*)(ws + WS_Z), (const pg8::bf16_t*)(ws + WS_WGLU) + (size_t)l * 1024 * 1024, MPAD, 1024, 1024}; if (!(variant == 0 || variant == 4)) { gc = 1 << 20; gG = 1 << 20; }
                pg8::StaticOrder S; S.init(MPAD, 1024, gG, gc);
                pg8::EpiGlu E{(const pg8::bf16_t*)(ws + WS_Z), (pg8::bf16_t*)(ws + WS_SSMY)};
                pg8::gemm_phase<pg8::EpiGlu, pg8::StaticOrder, true, true>(lds, g, S, E); }
            __syncthreads();
#ifndef NO_SA
            if (fast) { if (wg < 64 && (variant == 0 || variant == 5)) attn_sample_unit(C, l, wg >> 3, (wg >> 2) & 1, wg & 3); }
            else for (int s = wg; s < 64; s += G) attn_sample_unit(C, l, s >> 3, (s >> 2) & 1, s & 3);
#endif
#ifndef NO_PA
            if (fast && (variant == 0 || variant == 6)) {
                if (wg >= 128) { const int p = wg - 128, bk = p & 7; attn_prompt_unit(C, l, bk >> 1, bk & 1, 16 + (p >> 3)); }
                else if (wg >= 64) { const int p = wg - 64, bk = p & 7, k = p >> 3;
                    for (int t2 = 0; t2 < 2; ++t2) attn_prompt_unit(C, l, bk >> 1, bk & 1, t2 == 0 ? 15 - k : k); }
            } else if (!fast) for (int u = wg; u < 256; u += G) { const int qb = u & 31, bk = u >> 5; attn_prompt_unit(C, l, bk >> 1, bk & 1, qb); }
#endif
        }
        SEAM(pb + 2);
        if (SITE(6) && IN(pb + 3)) { SITE_BEGIN(); for (int r = gw; r < MR; r += 4 * NGW) { const int left = (MR - r + NGW - 1) / NGW; mixnorm_rows<4>(C, l, r, NGW, left < 4 ? left : 4); } }
        SEAM(pb + 3);
        if (SITE(7) && IN(pb + 4)) { SITE_BEGIN();
            const void* bp = l == 0 ? (const void*)C.in[I_XP] : (const void*)(ws + WS_XN); const void* bs = l == 0 ? (const void*)C.in[I_XS] : (const void*)((const bf16*)(ws + WS_XN) + (size_t)MP * DM);
            const pg8::bf16_t* Wt = (const pg8::bf16_t*)(ws + WS_WOUT) + (size_t)l * DM * DM;
            {   pg8::Gemm g{(const pg8::bf16_t*)(ws + WS_H), Wt, MP, DM, DM}; pg8::StaticOrder S; S.init(MP, DM, G, wg); pg8::EpiRes<(l == 0), false> E{bp, (void*)(ws + WS_HN), (float*)(ws + WS_PS)};
                pg8::gemm_phase<pg8::EpiRes<(l == 0), false>, pg8::StaticOrder, true, true>(lds, g, S, E); }
            __syncthreads();
            sample_gemm_res<(l == 0), false>(C, (const bf16*)(ws + WS_H) + (size_t)MP * DM, Wt, DM, bs, (void*)((bf16*)(ws + WS_HN) + (size_t)MP * DM), wg, G, (float*)(ws + WS_PSS));
        }
        SEAM(pb + 4);
        if (SITE(8) && IN(pb + 5)) { SITE_BEGIN();
            pg8::Gemm g{(const pg8::bf16_t*)(ws + DBG_GU_A), (const pg8::bf16_t*)(ws + WS_WGU) + (size_t)l * 2 * DFF * DM, MPAD, 2 * DFF, DM}; pg8::StaticOrder S; S.init(MPAD, 2 * DFF, G, wg);
            prenorm_prologue(C, S, (const float*)(ws + WS_PS), (const float*)(ws + WS_PSS));
            pg8::EpiSwiGLU E{(pg8::bf16_t*)(ws + WS_HMID), (const PG8_LAS float*)(lds + LDS_RS), 0};
#ifdef DBG_ONEUNIT
            for (int ui = 0; ui < 6; ++ui) { pg8::OneUnitOrder S1{S, ui}; pg8::gemm_phase<pg8::EpiSwiGLU, pg8::OneUnitOrder, true, true>(lds, g, S1, E); __syncthreads(); }
#else
            pg8::gemm_phase<pg8::EpiSwiGLU, pg8::StaticOrder, true, true>(lds, g, S, E);
#endif
            if (l == 0 && G == 256 && wg >= 172) {
                __syncthreads(); LAS float* scr = (LAS float*)(C.lds + C.wid * 16384);
                for (int i = (wg - 172) * 8 + C.wid; i < TI_DN + TI_GLU + TI_IN_DEF; i += 84 * 8)
                    weight_item(C, TI_LAYER + (i < TI_DN ? TI_IN + TI_GLU + TI_OUT + 2 * TI_G + i : (i < TI_DN + TI_GLU ? TI_IN + (i - TI_DN) : i - TI_DN - TI_GLU)), scr); }
        }
        SEAM(pb + 5);
        if (SITE(9) && IN(pb + 6)) { SITE_BEGIN();
            void* op = l == 0 ? (void*)(ws + WS_XN) : (void*)(C.out + O_YP); void* os = l == 0 ? (void*)((bf16*)(ws + WS_XN) + (size_t)MP * DM) : (void*)(C.out + O_YS);
            const pg8::bf16_t* Wt = (const pg8::bf16_t*)(ws + WS_WDN) + (size_t)l * DM * DFF;
            {   pg8::Gemm g{(const pg8::bf16_t*)(ws + WS_HMID), Wt, MP, DM, DFF}; pg8::StaticOrder S; S.init(MP, DM, G, wg); pg8::EpiRes<false, (l == 1)> E{(const void*)(ws + WS_HN), op, l == 0 ? (float*)(ws + WS_PS) : nullptr};
                pg8::gemm_phase<pg8::EpiRes<false, (l == 1)>, pg8::StaticOrder, true, true>(lds, g, S, E); }
            __syncthreads();
            sample_gemm_res<false, (l == 1)>(C, (const bf16*)(ws + WS_HMID) + (size_t)MP * DFF, Wt, DFF, (const void*)((const bf16*)(ws + WS_HN) + (size_t)MP * DM), os, wg, G, l == 0 ? (float*)(ws + WS_PSS) : nullptr);
        }
        SEAM(pb + 6);
    }
#ifdef DBG_DUMP_OFF
    if (IN(99)) { const size_t gt = (size_t)blockIdx.x * 512 + threadIdx.x, NT = (size_t)gridDim.x * 512;
#ifdef DBG_DUMP_BF16
        const bf16* src = (const bf16*)(a.ws + (size_t)(DBG_DUMP_OFF));
        const float marker = a.out[O_SSMS];
        for (size_t i = gt; i < (size_t)(DBG_DUMP_N); i += NT) { float* d = i < (size_t)MP * DM ? a.out + O_YP + i : a.out + O_YS + (i - (size_t)MP * DM); float v = bf2f(src[i]);
#ifdef DBG_LOWBITS
            v = (float)(src[i] & 0xFFu);
#endif
#ifdef DBG_PERTURB
            if (marker != 1.0f && i >= 1000 && i < 1000 + DBG_PERTURB) v = v * 2.0f + 1.0f;
#endif
            *d = v; }
        __syncthreads();
        if (gt == 0) { __builtin_amdgcn_s_sleep(100); a.out[O_SSMS] = 1.0f; }
#else
#ifdef DBG_DUMP_FROM_OUT
        const float* src = (const float*)(a.out + (size_t)(DBG_DUMP_OFF));
#else
        const float* src = (const float*)(a.ws + (size_t)(DBG_DUMP_OFF));
#endif
        for (size_t i = gt; i < (size_t)(DBG_DUMP_N) / 4; i += NT) { const size_t o = 4 * i; float* d = o < (size_t)MP * DM ? a.out + O_YP + o : a.out + O_YS + (o - (size_t)MP * DM); f32x4 vv = *(const f32x4*)(src + o);
#ifdef DBG_LOWBITS
            for (int q = 0; q < 4; ++q) vv[q] = (float)(__float_as_uint(vv[q]) & 0xFFu);
#endif
            *(f32x4*)d = vv; }
#endif
    }
#endif
#undef IN
#undef SEAM
}

extern "C" void kernel_launch(void* const* d_in, const int* in_sizes, int n_in, void* d_out, int out_size, void* d_ws, size_t ws_size, hipStream_t stream) {
    static int grid = 0;
    if (grid == 0) {
        if (n_in != NIN || (size_t)out_size != O_END || ws_size < WS_END) { fprintf(stderr, "kernel_launch: shape mismatch: n_in %d out %d ws %zu (need %d, %zu, >= %zu)\n", n_in, out_size, ws_size, NIN, (size_t)O_END, (size_t)WS_END); grid = -1; return; }
        int dev = 0, cus = 0, per_cu = 0;
        if (hipGetDevice(&dev) != hipSuccess || hipDeviceGetAttribute(&cus, hipDeviceAttributeMultiprocessorCount, dev) != hipSuccess) { fprintf(stderr, "kernel_launch: device query failed\n"); grid = -1; return; }
        if (hipFuncSetAttribute((const void*)hymba_fwd, hipFuncAttributeMaxDynamicSharedMemorySize, LDS_BYTES) != hipSuccess) { fprintf(stderr, "kernel_launch: hipFuncSetAttribute(%d) failed\n", LDS_BYTES); grid = -1; return; }
        if (hipOccupancyMaxActiveBlocksPerMultiprocessor(&per_cu, (const void*)hymba_fwd, 512, LDS_BYTES) != hipSuccess || per_cu < 1) fprintf(stderr, "kernel_launch: occupancy query says %d\n", per_cu);
        (void)hipGetLastError();
        grid = cus;
    }
    if (grid < 0) return;
#ifdef DBG_MEMSET_WS
    (void)hipMemsetAsync((char*)d_ws + CTL_BYTES, 0x11, WS_END - CTL_BYTES, stream);
#endif
    if (hipMemsetAsync((char*)d_ws + WS_CTL, 0, CTL_BYTES, stream) != hipSuccess) { fprintf(stderr, "kernel_launch: memset failed\n"); return; }
    Args a{};
    for (int i = 0; i < NIN; ++i) a.in[i] = (const float*)d_in[i];
    a.out = (float*)d_out; a.ws = (unsigned char*)d_ws;
#if MK_MULTI
#ifdef DBG_STOP
    for (int ph = 0; ph < DBG_STOP; ++ph) { a.ph_lo = ph; a.ph_hi = ph + 1; hipLaunchKernelGGL(hymba_fwd, dim3(grid), dim3(512), LDS_BYTES, stream, a); }
#ifdef DBG_EXTRA_PHASE
    a.ph_lo = DBG_EXTRA_PHASE; a.ph_hi = DBG_EXTRA_PHASE + 1; hipLaunchKernelGGL(hymba_fwd, dim3(grid), dim3(512), LDS_BYTES, stream, a);
#endif
#ifdef DBG_REPEAT12
    for (int rr = 0; rr < DBG_REPEAT12; ++rr) { a.ph_lo = 12; a.ph_hi = 13; hipLaunchKernelGGL(hymba_fwd, dim3(grid), dim3(512), LDS_BYTES, stream, a); }
#endif
#ifdef DBG_DUMP_OFF
    a.ph_lo = 99; a.ph_hi = 100; hipLaunchKernelGGL(hymba_fwd, dim3(grid), dim3(512), LDS_BYTES, stream, a);
#endif
#else
    for (int ph = 0; ph < NPH; ++ph) { a.ph_lo = ph; a.ph_hi = ph + 1; hipLaunchKernelGGL(hymba_fwd, dim3(grid), dim3(512), LDS_BYTES, stream, a); }
#endif
#else
    a.ph_lo = 0; a.ph_hi = NPH; hipLaunchKernelGGL(hymba_fwd, dim3(grid), dim3(512), LDS_BYTES, stream, a);
#ifndef PROBE_VARIANT
#define PROBE_VARIANT 0
#endif
#ifdef PROBE_EXTRA_PHASE
    (void)hipMemsetAsync((char*)d_ws + WS_CTL, 0, CTL_BYTES, stream);
    a.ph_lo = PROBE_EXTRA_PHASE; a.ph_hi = PROBE_EXTRA_PHASE + 1 + 1000 * PROBE_VARIANT; hipLaunchKernelGGL(hymba_fwd, dim3(grid), dim3(512), LDS_BYTES, stream, a);
#endif
#endif
    const hipError_t le = hipPeekAtLastError();
    if (le != hipSuccess) fprintf(stderr, "kernel_launch: launch failed: %s\n", hipGetErrorName(le));
}
```
